# Optimizing an MI355X kernel written in HIP

```python
import math
import jax, jax.numpy as jnp
from jax import lax
import numpy as np

D_MODEL = 1024
BATCH = 8
SEQ = 4096
DEPTH = 4

D_MIX = D_MODEL
N_HEADS = 8
N_KV_HEADS = 2
HEAD_DIM = 64
D_ATTN = N_HEADS * HEAD_DIM
D_KV = N_KV_HEADS * HEAD_DIM
D_SSM = D_MIX - D_ATTN
SSM_GROUP = 16
N_SSM_GROUPS = D_SSM // SSM_GROUP
SSM_STATE = 64
N_DIR = 2
WINDOW = 128
BLOCK = 128
N_BUCKETS = 32
MAX_DISTANCE = 128
D_FF = 2816
D_IN = D_ATTN + 2 * D_KV + D_SSM
EPS = 1e-6
NEG_INF = -1e30

kernel_name = "hymba_swa_s5_macaron_encoder"


def rms_norm(x, g):
    xf = x.astype(jnp.float32)
    y = xf * lax.rsqrt(jnp.mean(xf * xf, axis=-1, keepdims=True) + EPS)
    return (y * g.astype(jnp.float32)).astype(x.dtype)


def swiglu(x, w_gate, w_up, w_down):
    return (jax.nn.silu(x @ w_gate) * (x @ w_up)) @ w_down


def t5_bucket(rel):
    half = N_BUCKETS // 2
    max_exact = half // 2
    ret = jnp.where(rel > 0, half, 0)
    n = jnp.abs(rel)
    nf = jnp.maximum(n, 1).astype(jnp.float32)
    large = max_exact + (jnp.log(nf / max_exact) / math.log(MAX_DISTANCE / max_exact)
                         * (half - max_exact)).astype(jnp.int32)
    large = jnp.minimum(large, half - 1)
    return ret + jnp.where(n < max_exact, n, large)


def banded_attention(q, k, v, sink, bias):
    b, l = q.shape[0], q.shape[1]
    nb = l // BLOCK
    grp = N_HEADS // N_KV_HEADS
    qb = q.reshape(b, nb, BLOCK, N_KV_HEADS, grp, HEAD_DIM)

    def windows(t):
        tb = t.reshape(b, nb, BLOCK, N_KV_HEADS, HEAD_DIM)
        pad = jnp.pad(tb, ((0, 0), (1, 1), (0, 0), (0, 0), (0, 0)))
        return jnp.concatenate([pad[:, :-2], pad[:, 1:-1], pad[:, 2:]], axis=2)

    kw, vw = windows(k), windows(v)
    s = jnp.einsum('bnqkgd,bnskd->bnkgqs', qb, kw).astype(jnp.float32) * (HEAD_DIM ** -0.5)
    s = s + bias.astype(jnp.float32).reshape(N_KV_HEADS, grp, BLOCK, 3 * BLOCK)
    qpos = jnp.arange(BLOCK)[:, None]
    kpos = jnp.arange(3 * BLOCK)[None, :] - BLOCK
    in_band = jnp.abs(kpos - qpos) <= WINDOW
    kabs = jnp.arange(nb)[:, None] * BLOCK + kpos
    k_valid = (kabs >= 0) & (kabs < l)
    mask = in_band[None] & k_valid[:, None, :]
    s = jnp.where(mask[None, :, None, None], s, NEG_INF)
    sink_b = sink.astype(jnp.float32).reshape(N_KV_HEADS, grp, 1, 1)
    m = jnp.maximum(jnp.max(s, axis=-1, keepdims=True), sink_b)
    p = jnp.exp(s - m)
    denom = jnp.sum(p, axis=-1, keepdims=True) + jnp.exp(sink_b - m)
    p = (p / denom).astype(v.dtype)
    o = jnp.einsum('bnkgqs,bnskd->bnqkgd', p, vw)
    return o.reshape(b, l, D_ATTN)


def _scan_combine(e1, e2):
    a1r, a1i, b1r, b1i = e1
    a2r, a2i, b2r, b2i = e2
    return (a2r * a1r - a2i * a1i,
            a2r * a1i + a2i * a1r,
            a2r * b1r - a2i * b1i + b2r,
            a2r * b1i + a2i * b1r + b2i)


def s5_direction(u, a_re, a_im, log_dt, b_re, b_im, c_re, c_im, reverse):
    dt = jnp.exp(log_dt)[:, None]
    mag = jnp.exp(dt * a_re)
    ab_re = mag * jnp.cos(dt * a_im)
    ab_im = mag * jnp.sin(dt * a_im)
    den = a_re * a_re + a_im * a_im
    nr, ni = ab_re - 1.0, ab_im
    k_re = (nr * a_re + ni * a_im) / den
    k_im = (ni * a_re - nr * a_im) / den
    bb_re = k_re[..., None] * b_re - k_im[..., None] * b_im
    bb_im = k_re[..., None] * b_im + k_im[..., None] * b_re
    x_re = jnp.einsum('blgh,gph->blgp', u, bb_re)
    x_im = jnp.einsum('blgh,gph->blgp', u, bb_im)
    shape = x_re.shape
    elems = (jnp.broadcast_to(ab_re, shape), jnp.broadcast_to(ab_im, shape), x_re, x_im)
    _, _, s_re, s_im = lax.associative_scan(_scan_combine, elems, reverse=reverse, axis=1)
    return jnp.einsum('blgp,ghp->blgh', s_re, c_re) - jnp.einsum('blgp,ghp->blgh', s_im, c_im)


def s5_mixer(u, a_re, a_im, log_dt, b_re, b_im, c_re, c_im, d, w_glu, b_glu):
    bsz, l = u.shape[0], u.shape[1]
    f32 = jnp.float32
    uf = u.astype(f32)
    ug = uf.reshape(bsz, l, N_SSM_GROUPS, SSM_GROUP)
    y = jnp.zeros_like(ug)
    for di, rev in ((0, False), (1, True)):
        y = y + s5_direction(ug, a_re[di].astype(f32), a_im[di].astype(f32), log_dt[di].astype(f32),
                             b_re[di].astype(f32), b_im[di].astype(f32),
                             c_re[di].astype(f32), c_im[di].astype(f32), rev)
    y = y.reshape(bsz, l, D_SSM) + d.astype(f32) * uf
    z = jax.nn.gelu(y)
    out = z * jax.nn.sigmoid(z @ w_glu.astype(f32) + b_glu.astype(f32))
    return out.astype(u.dtype)


def setup_inputs(seed: int = 0) -> dict:
    key = jax.random.key(seed)
    ks = iter(jax.random.split(key, 40))
    f32 = jnp.float32

    def nrm(shape, scale):
        return jax.random.normal(next(ks), shape, f32) * scale

    def gain(shape):
        return 1.0 + 0.02 * jax.random.normal(next(ks), shape, f32)

    L, D, G, P, H = DEPTH, D_MODEL, N_SSM_GROUPS, SSM_STATE, SSM_GROUP
    a_re_init = -0.5 * jnp.ones((L, N_DIR, G, P), f32)
    a_im_init = jnp.broadcast_to(jnp.pi * jnp.arange(P, dtype=f32), (L, N_DIR, G, P))
    return {
        "x": nrm((BATCH, SEQ, D), 1.0),
        "rel_bias_table": nrm((N_BUCKETS, N_HEADS), 0.5),
        "ffn1_norm": gain((L, D)),
        "ffn1_w_gate": nrm((L, D, D_FF), D ** -0.5),
        "ffn1_w_up": nrm((L, D, D_FF), D ** -0.5),
        "ffn1_w_down": nrm((L, D_FF, D), D_FF ** -0.5),
        "mix_norm": gain((L, D)),
        "w_in": nrm((L, D, D_IN), D ** -0.5),
        "attn_sink": nrm((L, N_HEADS), 0.5),
        "ssm_a_re": a_re_init - 0.02 * jnp.abs(jax.random.normal(next(ks), (L, N_DIR, G, P), f32)),
        "ssm_a_im": a_im_init + 0.01 * jax.random.normal(next(ks), (L, N_DIR, G, P), f32),
        "ssm_log_dt": jax.random.uniform(next(ks), (L, N_DIR, G), f32, math.log(1e-3), math.log(1e-1)),
        "ssm_b_re": nrm((L, N_DIR, G, P, H), (2.0 * H) ** -0.5),
        "ssm_b_im": nrm((L, N_DIR, G, P, H), (2.0 * H) ** -0.5),
        "ssm_c_re": nrm((L, N_DIR, G, H, P), (2.0 * P) ** -0.5),
        "ssm_c_im": nrm((L, N_DIR, G, H, P), (2.0 * P) ** -0.5),
        "ssm_d": nrm((L, D_SSM), 1.0),
        "ssm_w_glu": nrm((L, D_SSM, D_SSM), D_SSM ** -0.5),
        "ssm_b_glu": nrm((L, D_SSM), 0.01),
        "attn_out_norm": gain((L, D_ATTN)),
        "ssm_out_norm": gain((L, D_SSM)),
        "w_out": nrm((L, D_MIX, D), D_MIX ** -0.5),
        "ffn2_norm": gain((L, D)),
        "ffn2_w_gate": nrm((L, D, D_FF), D ** -0.5),
        "ffn2_w_up": nrm((L, D, D_FF), D ** -0.5),
        "ffn2_w_down": nrm((L, D_FF, D), D_FF ** -0.5),
        "final_norm": gain((D,)),
    }


def reference(x, rel_bias_table, ffn1_norm, ffn1_w_gate, ffn1_w_up, ffn1_w_down, mix_norm, w_in,
              attn_sink, ssm_a_re, ssm_a_im, ssm_log_dt, ssm_b_re, ssm_b_im, ssm_c_re, ssm_c_im,
              ssm_d, ssm_w_glu, ssm_b_glu, attn_out_norm, ssm_out_norm, w_out, ffn2_norm,
              ffn2_w_gate, ffn2_w_up, ffn2_w_down, final_norm):
    bsz, l = x.shape[0], x.shape[1]
    rel = (jnp.arange(3 * BLOCK)[None, :] - BLOCK) - jnp.arange(BLOCK)[:, None]
    bias = jnp.transpose(rel_bias_table[t5_bucket(rel)], (2, 0, 1))
    split_pts = [D_ATTN, D_ATTN + D_KV, D_ATTN + 2 * D_KV]
    for i in range(DEPTH):
        x = x + 0.5 * swiglu(rms_norm(x, ffn1_norm[i]), ffn1_w_gate[i], ffn1_w_up[i], ffn1_w_down[i])
        h = rms_norm(x, mix_norm[i])
        proj = h @ w_in[i]
        q, k, v, u = jnp.split(proj, split_pts, axis=-1)
        attn = banded_attention(q.reshape(bsz, l, N_HEADS, HEAD_DIM),
                                k.reshape(bsz, l, N_KV_HEADS, HEAD_DIM),
                                v.reshape(bsz, l, N_KV_HEADS, HEAD_DIM),
                                attn_sink[i], bias)
        ssm = s5_mixer(u, ssm_a_re[i], ssm_a_im[i], ssm_log_dt[i], ssm_b_re[i], ssm_b_im[i],
                       ssm_c_re[i], ssm_c_im[i], ssm_d[i], ssm_w_glu[i], ssm_b_glu[i])
        mixed = jnp.concatenate([rms_norm(attn, attn_out_norm[i]), rms_norm(ssm, ssm_out_norm[i])], axis=-1)
        x = x + mixed @ w_out[i]
        x = x + 0.5 * swiglu(rms_norm(x, ffn2_norm[i]), ffn2_w_gate[i], ffn2_w_up[i], ffn2_w_down[i])
    return rms_norm(x, final_norm)
```

```cpp
#include <hip/hip_runtime.h>
#include <hip/hip_cooperative_groups.h>
#include <cstdio>
#include <cstdint>
namespace cg = cooperative_groups;
namespace pg8 {
#define PG8_LAS __attribute__((address_space(3)))
typedef unsigned short bf16_t;
typedef short bf16x8 __attribute__((ext_vector_type(8)));
typedef float f32x4 __attribute__((ext_vector_type(4)));
typedef unsigned u32x4 __attribute__((ext_vector_type(4)));
constexpr int BM = 256, BK = 64, HALF = 128, HTB = HALF * BK * 2  , STAGE_BYTES = 8 * HTB, NXCD = 8, WGM = 8;

__host__ __device__ __forceinline__ int lds_byte(int r, int c) { const int st = (r >> 4) * 2 + (c >> 5), rr = r & 15, cc = c & 31, ob = rr * 64 + cc * 2; return st * 1024 + (ob ^ (((ob >> 9) & 1) << 5)); }
__host__ __device__ __forceinline__ void stage_rc(int b, int& R, int& C) { const int st = b / 1024, sb = b % 1024, swz = sb ^ (((sb >> 9) & 1) << 5); R = (st >> 1) * 16 + swz / 64; C = (st & 1) * 32 + (swz % 64) / 2; }
__host__ __device__ __forceinline__ int perm32(int rho) { const int n = rho >> 4, i = rho & 15; return 8 * (i >> 2) + 4 * n + (i & 3); }

struct Unit { int pm, pn; };
struct Gemm { const bf16_t* A; const bf16_t* Bt; int M, N, K; };

struct StaticOrder {
    int nM, nN, nwg, G, c;
    __host__ __device__ void init(int M, int N, int G_, int c_) { nM = M / BM; nN = N / BM; nwg = nM * nN; G = G_; c = c_; }
    __host__ __device__ bool next(int i, Unit& u) const {
        const long L = (long)i * G + c; if (L >= nwg) return false;
        int wgid = (int)L; { const int q = nwg / NXCD, r = nwg % NXCD, xcd = wgid % NXCD, off = wgid / NXCD; wgid = (xcd < r ? xcd * (q + 1) : r * (q + 1) + (xcd - r) * q) + off; }
        const int nig = WGM * nN, gid = wgid / nig, fm = gid * WGM, gsz = (nM - fm) < WGM ? (nM - fm) : WGM;
        u.pm = fm + ((wgid % nig) % gsz); u.pn = (wgid % nig) / gsz; return true;
    }
    __device__ __forceinline__ void a_ready(const Unit&) const {}
    __device__ __forceinline__ void done(const Unit&) const {}
};

typedef float f32x2 __attribute__((ext_vector_type(2)));
typedef __bf16 bf16x2_t __attribute__((ext_vector_type(2)));
__device__ __forceinline__ unsigned cvt_pk_bf16(float lo, float hi) { const f32x2 v = {lo, hi}; return __builtin_bit_cast(unsigned, __builtin_convertvector(v, bf16x2_t)); }
typedef unsigned u32x2 __attribute__((ext_vector_type(2)));
constexpr float RMS_EPS = 1e-6f;
__device__ __forceinline__ float bf_lo(unsigned w) { return __uint_as_float(w << 16); }
__device__ __forceinline__ float bf_hi(unsigned w) { return __uint_as_float(w & 0xffff0000u); }
__device__ __forceinline__ float fast_sigmoid(float v) { return __builtin_amdgcn_rcpf(1.0f + __builtin_amdgcn_exp2f(-1.4426950408889634f * v)); }
__device__ __forceinline__ float row_rstd16(const float* ssq, int row, int fq) {
    const f32x4 v = *(const f32x4*)(ssq + ((size_t)fq * 32768 + row) * 4);
    float s = (v[0] + v[1]) + (v[2] + v[3]);
    s += __shfl_xor(s, 16); s += __shfl_xor(s, 32);
    return __builtin_amdgcn_rsqf(s * (1.0f / 1024.0f) + RMS_EPS);
}
__device__ __forceinline__ float row_rstd8(const float* ssq2, int row, int fq) {
    const f32x2 v = *(const f32x2*)(ssq2 + ((size_t)(fq & 1) * 32768 + row) * 4 + 2 * (fq >> 1));
    float s = v[0] + v[1];
    s += __shfl_xor(s, 16); s += __shfl_xor(s, 32);
    return __builtin_amdgcn_rsqf(s * (1.0f / 512.0f) + RMS_EPS);
}

struct EpiSwiGLU {
    static constexpr bool PERM = true, AFTER_DRAIN = false;
    bf16_t* H; const float* ssq;
    __device__ __forceinline__ void operator()(const f32x4 (&acc)[2][2][4][2], const Unit& u, int wr, int wc, int fr, int fq) const {
        const int row0 = u.pm * BM + wr * 64 + fr, hc = u.pn * 128 + wc * 32 + 8 * fq;
#pragma unroll
        for (int ai = 0; ai < 2; ++ai)
#pragma unroll
            for (int m = 0; m < 4; ++m) {
                const int row = row0 + ai * HALF + m * 16;
                const float rs = row_rstd16(ssq, row, fq);
                float o[8];
#pragma unroll
                for (int n = 0; n < 2; ++n)
#pragma unroll
                    for (int j = 0; j < 4; ++j) { const float g = acc[ai][0][m][n][j] * rs, up = acc[ai][1][m][n][j] * rs; o[4 * n + j] = g * fast_sigmoid(g) * up; }
                u32x4 w; w.x = cvt_pk_bf16(o[0], o[1]); w.y = cvt_pk_bf16(o[2], o[3]); w.z = cvt_pk_bf16(o[4], o[5]); w.w = cvt_pk_bf16(o[6], o[7]);
                *(u32x4*)(H + (size_t)row * 2816 + hc) = w;
            }
    }
};

template <bool ROWSCALE, bool FINAL> struct EpiResid {
    static constexpr bool PERM = false, AFTER_DRAIN = false;
    float* x; bf16_t* xb; float* ssq; const float* ssq2; float scale;
    __device__ __forceinline__ void operator()(const f32x4 (&acc)[2][2][4][2], const Unit& u, int wr, int wc, int fr, int fq) const {
        const int row0 = u.pm * BM + wr * 64 + fr, col0 = u.pn * BM + wc * 32 + 4 * fq;
#pragma unroll
        for (int ai = 0; ai < 2; ++ai)
#pragma unroll
            for (int m = 0; m < 4; ++m) {
                const int row = row0 + ai * HALF + m * 16;
                float sc = scale; if (ROWSCALE) sc = row_rstd8(ssq2, row, fq);
                float ss = 0.f;
#pragma unroll
                for (int bj = 0; bj < 2; ++bj)
#pragma unroll
                    for (int n = 0; n < 2; ++n) {
                        const size_t off = (size_t)row * 1024 + col0 + bj * HALF + n * 16;
                        const f32x4 xv = *(const f32x4*)(x + off);
                        const f32x4 o = xv + acc[ai][bj][m][n] * sc;
                        *(f32x4*)(x + off) = o;
                        if (FINAL) { u32x2 w; w.x = cvt_pk_bf16(o[0], o[1]); w.y = cvt_pk_bf16(o[2], o[3]); *(u32x2*)(xb + off) = w;
                            ss += (o[0] * o[0] + o[1] * o[1]) + (o[2] * o[2] + o[3] * o[3]); }
                    }
                if (FINAL) { ss += __shfl_xor(ss, 16); ss += __shfl_xor(ss, 32); if (fq == 0) ssq[((size_t)u.pn * 32768 + row) * 4 + wc] = ss; }
            }
    }
};

struct EpiProj {
    static constexpr bool PERM = true, AFTER_DRAIN = false;
    bf16_t* proj; bf16_t* vT; const float* ssq;
    __device__ __forceinline__ void operator()(const f32x4 (&acc)[2][2][4][2], const Unit& u, int wr, int wc, int fr, int fq) const {
        const int row0 = u.pm * BM + wr * 64 + fr;
#pragma unroll
        for (int ai = 0; ai < 2; ++ai)
#pragma unroll
            for (int m = 0; m < 4; ++m) {
                const int row = row0 + ai * HALF + m * 16;
                const float rs = row_rstd16(ssq, row, fq);
#pragma unroll
                for (int bj = 0; bj < 2; ++bj) {
                    const f32x4 v0 = acc[ai][bj][m][0] * rs, v1 = acc[ai][bj][m][1] * rs;
                    u32x4 w; w.x = cvt_pk_bf16(v0[0], v0[1]); w.y = cvt_pk_bf16(v0[2], v0[3]); w.z = cvt_pk_bf16(v1[0], v1[1]); w.w = cvt_pk_bf16(v1[2], v1[3]);
                    if (u.pn == 2 && bj == 1) {
                        const int vc = wc * 32 + 8 * fq, b = row >> 12, t = row & 4095;
                        bf16_t* dst = vT + ((size_t)(b * 2 + (vc >> 6)) * 64 + (vc & 63)) * 4096 + t;
                        dst[0 * 4096] = (bf16_t)(w.x & 0xffffu); dst[1 * 4096] = (bf16_t)(w.x >> 16);
                        dst[2 * 4096] = (bf16_t)(w.y & 0xffffu); dst[3 * 4096] = (bf16_t)(w.y >> 16);
                        dst[4 * 4096] = (bf16_t)(w.z & 0xffffu); dst[5 * 4096] = (bf16_t)(w.z >> 16);
                        dst[6 * 4096] = (bf16_t)(w.w & 0xffffu); dst[7 * 4096] = (bf16_t)(w.w >> 16);
                    } else {
                        *(u32x4*)(proj + (size_t)row * 1280 + u.pn * BM + bj * HALF + wc * 32 + 8 * fq) = w;
                    }
                }
            }
    }
};

struct EpiGlu {
    static constexpr bool PERM = true, AFTER_DRAIN = false;
    const bf16_t* z; bf16_t* s; const float* bglu; float* ssq2;
    __device__ __forceinline__ void operator()(const f32x4 (&acc)[2][2][4][2], const Unit& u, int wr, int wc, int fr, int fq) const {
        const int row0 = u.pm * BM + wr * 64 + fr;
#pragma unroll
        for (int ai = 0; ai < 2; ++ai)
#pragma unroll
            for (int m = 0; m < 4; ++m) {
                const int row = row0 + ai * HALF + m * 16;
                float ss = 0.f;
#pragma unroll
                for (int bj = 0; bj < 2; ++bj) {
                    const int c0 = u.pn * BM + bj * HALF + wc * 32 + 8 * fq;
                    const u32x4 zw = *(const u32x4*)(z + (size_t)row * 512 + c0);
                    const f32x4 b0 = *(const f32x4*)(bglu + c0), b1 = *(const f32x4*)(bglu + c0 + 4);
                    const f32x4 a0 = acc[ai][bj][m][0] + b0, a1 = acc[ai][bj][m][1] + b1;
                    float o[8];
                    o[0] = bf_lo(zw.x) * fast_sigmoid(a0[0]); o[1] = bf_hi(zw.x) * fast_sigmoid(a0[1]);
                    o[2] = bf_lo(zw.y) * fast_sigmoid(a0[2]); o[3] = bf_hi(zw.y) * fast_sigmoid(a0[3]);
                    o[4] = bf_lo(zw.z) * fast_sigmoid(a1[0]); o[5] = bf_hi(zw.z) * fast_sigmoid(a1[1]);
                    o[6] = bf_lo(zw.w) * fast_sigmoid(a1[2]); o[7] = bf_hi(zw.w) * fast_sigmoid(a1[3]);
#pragma unroll
                    for (int j = 0; j < 8; ++j) ss += o[j] * o[j];
                    u32x4 w; w.x = cvt_pk_bf16(o[0], o[1]); w.y = cvt_pk_bf16(o[2], o[3]); w.z = cvt_pk_bf16(o[4], o[5]); w.w = cvt_pk_bf16(o[6], o[7]);
                    *(u32x4*)(s + (size_t)row * 512 + c0) = w;
                }
                ss += __shfl_xor(ss, 16); ss += __shfl_xor(ss, 32); if (fq == 0) ssq2[((size_t)u.pn * 32768 + row) * 4 + wc] = ss;
            }
    }
};
template <class Epi, class Sched, bool ALIGN_EPI = false, bool SP2 = false>
__device__ __forceinline__ void gemm_phase(PG8_LAS unsigned char* lds, const Gemm g, const Sched& S, const Epi& E) {
    int tid_ = threadIdx.x; asm volatile("" : "+v"(tid_));
    const int tid = tid_, wid = __builtin_amdgcn_readfirstlane(tid >> 6), lane = tid & 63, wr = wid >> 2, wc = wid & 3, fr = lane & 15, fq = lane >> 4;
    const int K = g.K, nt = K / BK;
    unsigned voffA[2], voffB[2];
#pragma unroll
    for (int i = 0; i < 2; ++i) { int R, C; stage_rc(tid * 16 + i * 8192, R, C); const int Rb = Epi::PERM ? ((R & ~31) + perm32(R & 31)) : R;
        voffA[i] = (unsigned)(R * K + C) * 2u; voffB[i] = (unsigned)(Rb * K + C) * 2u; }
    const size_t kstep = (size_t)(BK * 2);
    const size_t hstep = (size_t)HALF * K * 2;
    const size_t tstep = 2 * hstep;
    const unsigned ldsw = (unsigned)wid * 1024u;
    const int aoff = lds_byte(wr * 64 + fr, fq * 8), boff = lds_byte(wc * 32 + fr, fq * 8);
#define PG8_SA(b, h) (((b) * 2 + (h)) * HTB)
#define PG8_SB(b, h) ((4 + (b) * 2 + (h)) * HTB)
#define PG8_STAGE(bufoff, gbase, voff) do { _Pragma("unroll") for (int _i = 0; _i < 2; ++_i) \
        __builtin_amdgcn_global_load_lds((const unsigned*)((const char*)(gbase) + (voff)[_i]), (PG8_LAS unsigned*)(lds + (bufoff) + ldsw + _i * 8192), 16, 0, 0); } while (0)
#define PG8_LDA(dst, b, h) do { _Pragma("unroll") for (int m = 0; m < 4; ++m) _Pragma("unroll") for (int k = 0; k < 2; ++k) dst[m][k] = *(const PG8_LAS bf16x8*)(lds + PG8_SA(b, h) + aoff + m * 2048 + k * 1024); } while (0)
#define PG8_LDB(dst, b, h) do { _Pragma("unroll") for (int n = 0; n < 2; ++n) _Pragma("unroll") for (int k = 0; k < 2; ++k) dst[n][k] = *(const PG8_LAS bf16x8*)(lds + PG8_SB(b, h) + boff + n * 2048 + k * 1024); } while (0)
#define PG8_MMA(ai, bj, At, Bt) do { __builtin_amdgcn_s_setprio(1); _Pragma("unroll") for (int m = 0; m < 4; ++m) _Pragma("unroll") for (int n = 0; n < 2; ++n) _Pragma("unroll") for (int k = 0; k < 2; ++k) \
        acc[ai][bj][m][n] = __builtin_amdgcn_mfma_f32_16x16x32_bf16(Bt[n][k], At[m][k], acc[ai][bj][m][n], 0, 0, 0); __builtin_amdgcn_s_setprio(0); } while (0)
#define PG8_WAIT_V(n) asm volatile("s_waitcnt vmcnt(" #n ")" ::: "memory")
#define PG8_WAIT_L(n) asm volatile("s_waitcnt lgkmcnt(" #n ")" ::: "memory")
#define PG8_BAR __builtin_amdgcn_s_barrier()
#define PG8_SCHED __builtin_amdgcn_sched_barrier(0)
    Unit cur, nxt; int ui = 0;
    if (!S.next(0, cur)) return;
    f32x4 acc[2][2][4][2];
#pragma unroll
    for (int a = 0; a < 2; ++a)
#pragma unroll
        for (int b = 0; b < 2; ++b)
#pragma unroll
            for (int m = 0; m < 4; ++m)
#pragma unroll
                for (int n = 0; n < 2; ++n) acc[a][b][m][n] = (f32x4){0.f, 0.f, 0.f, 0.f};
    bf16x8 At[4][2], B0[2][2], B1[2][2];
    const char* cA = (const char*)g.A + (size_t)cur.pm * tstep; const char* cB = (const char*)g.Bt + (size_t)cur.pn * tstep;
    S.a_ready(cur);
    if constexpr (SP2) {
        PG8_STAGE(PG8_SB(0, 0), cB, voffB); PG8_STAGE(PG8_SB(0, 1), cB + hstep, voffB); PG8_STAGE(PG8_SA(0, 0), cA, voffA); PG8_STAGE(PG8_SA(0, 1), cA + hstep, voffA);
        if (wr == 1) PG8_BAR;
        PG8_WAIT_V(2); PG8_BAR;
        PG8_STAGE(PG8_SB(1, 0), cB + kstep, voffB); PG8_STAGE(PG8_SA(1, 0), cA + kstep, voffA); PG8_STAGE(PG8_SB(1, 1), cB + hstep + kstep, voffB);
        PG8_WAIT_V(6); PG8_BAR;
    } else {
        PG8_STAGE(PG8_SB(0, 0), cB, voffB); PG8_STAGE(PG8_SA(0, 0), cA, voffA); PG8_STAGE(PG8_SB(0, 1), cB + hstep, voffB); PG8_STAGE(PG8_SA(0, 1), cA + hstep, voffA);
        if (wr == 1) PG8_BAR;
        PG8_WAIT_V(4); PG8_BAR;
        PG8_STAGE(PG8_SB(1, 0), cB + kstep, voffB); PG8_STAGE(PG8_SA(1, 0), cA + kstep, voffA); PG8_STAGE(PG8_SB(1, 1), cB + hstep + kstep, voffB);
        PG8_WAIT_V(6); PG8_BAR;
    }
    for (;;) {
        const bool has_next = S.next(ui + 1, nxt);
        const char* nA = has_next ? (const char*)g.A + (size_t)nxt.pm * tstep : cA; const char* nB = has_next ? (const char*)g.Bt + (size_t)nxt.pn * tstep : cB;
        for (int t = 0; t < nt; t += 2) {
            const bool last = (t == nt - 2);
            const char* a1 = cA + (size_t)(t + 1) * kstep;
            const char* a2 = last ? nA : cA + (size_t)(t + 2) * kstep; const char* b2 = last ? nB : cB + (size_t)(t + 2) * kstep;
            const char* a3 = a2 + kstep; const char* b3 = b2 + kstep;
            if (last && has_next) S.a_ready(nxt);
            if constexpr (SP2) {
            PG8_LDB(B0, 0, 0); PG8_LDB(B1, 0, 1); PG8_SCHED; PG8_LDA(At, 0, 0); PG8_STAGE(PG8_SA(1, 1), a1 + hstep, voffA);
            PG8_WAIT_V(8); PG8_WAIT_L(0); PG8_BAR; PG8_MMA(0, 0, At, B0); PG8_MMA(0, 1, At, B1); PG8_BAR; PG8_SCHED;
            PG8_LDA(At, 0, 1); PG8_STAGE(PG8_SB(0, 0), b2, voffB); PG8_STAGE(PG8_SB(0, 1), b2 + hstep, voffB); PG8_STAGE(PG8_SA(0, 0), a2, voffA);
            PG8_WAIT_V(8); PG8_WAIT_L(0); PG8_BAR; PG8_MMA(1, 0, At, B0); PG8_MMA(1, 1, At, B1); PG8_BAR; PG8_SCHED;
            PG8_LDB(B0, 1, 0); PG8_LDB(B1, 1, 1); PG8_SCHED; PG8_LDA(At, 1, 0); PG8_STAGE(PG8_SA(0, 1), a2 + hstep, voffA);
            PG8_WAIT_V(8); PG8_WAIT_L(0); PG8_BAR; PG8_MMA(0, 0, At, B0); PG8_MMA(0, 1, At, B1); PG8_BAR; PG8_SCHED;
            PG8_LDA(At, 1, 1); PG8_STAGE(PG8_SB(1, 0), b3, voffB); PG8_STAGE(PG8_SB(1, 1), b3 + hstep, voffB); PG8_STAGE(PG8_SA(1, 0), a3, voffA);
            PG8_WAIT_V(8); PG8_WAIT_L(0); PG8_BAR; PG8_MMA(1, 0, At, B0); PG8_MMA(1, 1, At, B1); PG8_BAR; PG8_SCHED;
            } else {
            PG8_LDB(B0, 0, 0); PG8_SCHED; PG8_LDA(At, 0, 0); PG8_STAGE(PG8_SA(1, 1), a1 + hstep, voffA);
            PG8_WAIT_L(8); PG8_BAR; PG8_WAIT_L(0); PG8_MMA(0, 0, At, B0); PG8_BAR; PG8_SCHED;
            PG8_LDB(B1, 0, 1); PG8_STAGE(PG8_SB(0, 0), b2, voffB);
            PG8_BAR; PG8_WAIT_L(0); PG8_MMA(0, 1, At, B1); PG8_BAR;
            PG8_LDA(At, 0, 1); PG8_STAGE(PG8_SA(0, 0), a2, voffA);
            PG8_BAR; PG8_WAIT_L(0); PG8_MMA(1, 0, At, B0); PG8_BAR; PG8_SCHED;
            PG8_STAGE(PG8_SB(0, 1), b2 + hstep, voffB);
            PG8_WAIT_V(6); PG8_BAR; PG8_MMA(1, 1, At, B1); PG8_BAR;
            PG8_LDB(B0, 1, 0); PG8_SCHED; PG8_LDA(At, 1, 0); PG8_STAGE(PG8_SA(0, 1), a2 + hstep, voffA);
            PG8_WAIT_L(8); PG8_BAR; PG8_WAIT_L(0); PG8_MMA(0, 0, At, B0); PG8_BAR; PG8_SCHED;
            PG8_LDB(B1, 1, 1); PG8_STAGE(PG8_SB(1, 0), b3, voffB);
            PG8_BAR; PG8_WAIT_L(0); PG8_MMA(0, 1, At, B1); PG8_BAR;
            PG8_LDA(At, 1, 1); PG8_STAGE(PG8_SA(1, 0), a3, voffA);
            PG8_BAR; PG8_WAIT_L(0); PG8_MMA(1, 0, At, B0); PG8_BAR; PG8_SCHED;
            PG8_STAGE(PG8_SB(1, 1), b3 + hstep, voffB);
            PG8_WAIT_V(6); PG8_BAR; PG8_MMA(1, 1, At, B1); PG8_BAR;
            }
        }
        if constexpr (ALIGN_EPI) { if (wr == 0) PG8_BAR; }
        if constexpr (!Epi::AFTER_DRAIN) { E(acc, cur, wr, wc, fr, fq); S.done(cur); }
        if (!has_next) break;
#pragma unroll
        for (int a = 0; a < 2; ++a)
#pragma unroll
            for (int b = 0; b < 2; ++b)
#pragma unroll
                for (int m = 0; m < 4; ++m)
#pragma unroll
                    for (int n = 0; n < 2; ++n) acc[a][b][m][n] = (f32x4){0.f, 0.f, 0.f, 0.f};
        cur = nxt; cA = nA; cB = nB; ++ui;
        if constexpr (ALIGN_EPI) { if (wr == 1) PG8_BAR; }
    }
    PG8_WAIT_V(0);
    if constexpr (!ALIGN_EPI) { if (wr == 0) PG8_BAR; }
    PG8_BAR;
    if constexpr (Epi::AFTER_DRAIN) { E.fused(acc, cur, wr, wc, fr, fq, lds, wid, lane); S.done(cur); }
#undef PG8_SA
#undef PG8_SB
#undef PG8_STAGE
#undef PG8_LDA
#undef PG8_LDB
#undef PG8_MMA
#undef PG8_WAIT_V
#undef PG8_WAIT_L
#undef PG8_BAR
#undef PG8_SCHED
}
}

#ifndef DIAG_NOCARRY
#define DIAG_NOCARRY 0
#endif
#ifndef DIAG_MIXER
#define DIAG_MIXER 1
#endif
#define LAS __attribute__((address_space(3)))
typedef unsigned short bf16;
typedef short bf16x8 __attribute__((ext_vector_type(8)));
typedef short s16x4 __attribute__((ext_vector_type(4)));
typedef float f32x2 __attribute__((ext_vector_type(2)));
typedef float f32x4 __attribute__((ext_vector_type(4)));
typedef float f32x16 __attribute__((ext_vector_type(16)));
typedef unsigned u32x2 __attribute__((ext_vector_type(2)));
typedef unsigned u32x4 __attribute__((ext_vector_type(4)));

constexpr int NT = 32768, SEQ = 4096, DM = 1024, DFF = 2816, DIN = 1280, NLAYER = 4;
constexpr float LOG2E = 1.4426950408889634f;
constexpr int NWAVES = 8, NTHREADS = 512;
constexpr int LDS_BYTES = 147456;
constexpr size_t MiB = 1u << 20;
constexpr size_t W_GU1 = 0, W_D1 = W_GU1 + (size_t)5632 * 1024 * 2, W_IN = W_D1 + (size_t)1024 * 2816 * 2, W_GLU = W_IN + (size_t)1280 * 1024 * 2,
                 W_OA = W_GLU + (size_t)512 * 512 * 2, W_OS = W_OA + (size_t)1024 * 512 * 2, W_GU2 = W_OS + (size_t)1024 * 512 * 2,
                 W_D2 = W_GU2 + (size_t)5632 * 1024 * 2, W_LAYER = W_D2 + (size_t)1024 * 2816 * 2;
static_assert(W_LAYER == 38 * MiB, "weights per layer");
constexpr size_t WS_W = 0, WS_XB = 152 * MiB, WS_BIG = 216 * MiB, WS_H = WS_BIG, WS_PROJ = WS_BIG, WS_AN = WS_BIG + 80 * MiB, WS_Z = WS_BIG + 112 * MiB, WS_S = WS_BIG + 144 * MiB,
                 WS_VT = 392 * MiB, WS_YSCR = 400 * MiB, WS_SEGE = 464 * MiB, WS_SSQ = 466 * MiB, WS_SSQ2 = 468 * MiB, WS_ABAR = 469 * MiB, WS_APOW = WS_ABAR + 256 * 1024,
                 WS_BB = 470 * MiB, WS_CC = 471 * MiB, WS_END = 472 * MiB;

struct Args { const float* in[27]; float* out; unsigned char* ws; };

__device__ __forceinline__ unsigned f2bf(float f) { unsigned u = __builtin_bit_cast(unsigned, f); return (u + 0x7fffu + ((u >> 16) & 1u)) >> 16; }
typedef __bf16 bf16x2_t __attribute__((ext_vector_type(2)));
__device__ __forceinline__ unsigned pk2(float lo, float hi) { const f32x2 v = {lo, hi}; return __builtin_bit_cast(unsigned, __builtin_convertvector(v, bf16x2_t)); }
__device__ __forceinline__ float bflo(unsigned w) { return __uint_as_float(w << 16); }
__device__ __forceinline__ float bfhi(unsigned w) { return __uint_as_float(w & 0xffff0000u); }
__device__ __forceinline__ float bf2f(bf16 v) { return __uint_as_float((unsigned)v << 16); }
#define LDS_FENCE() asm volatile("s_waitcnt lgkmcnt(0)" ::: "memory")
__device__ __forceinline__ float wave_sum(float v) {
#pragma unroll
    for (int o = 1; o < 64; o <<= 1) v += __shfl_xor(v, o);
    return v;
}
__device__ __forceinline__ int crow(int r, int hi) { return (r & 3) + 8 * (r >> 2) + 4 * hi; }

__device__ __forceinline__ void tr_item(const float* W, int ldw, int K, bf16* WT, int k0, int n0, int drow0, const float* gain, float cs, LAS float* scr, int lane) {
#pragma unroll 8
    for (int i = 0; i < 32; ++i) { const int kk = 2 * i + (lane >> 5); float v = W[(size_t)(k0 + kk) * ldw + n0 + (lane & 31)] * cs; if (gain) v *= gain[k0 + kk]; scr[kk * 33 + (lane & 31)] = v; }
    LDS_FENCE();
    const int c = lane & 7;
#pragma unroll
    for (int j = 0; j < 4; ++j) { const int n = (lane >> 3) + 8 * j; const LAS float* s = scr + (8 * c) * 33 + n;
        u32x4 o; o.x = pk2(s[0 * 33], s[1 * 33]); o.y = pk2(s[2 * 33], s[3 * 33]); o.z = pk2(s[4 * 33], s[5 * 33]); o.w = pk2(s[6 * 33], s[7 * 33]);
        *(u32x4*)(WT + (size_t)(drow0 + n) * K + k0 + 8 * c) = o; }
    LDS_FENCE();
}
__device__ __forceinline__ void sincos_rr(float th, float& s, float& c) {
    const float k = rintf(th * 0.6366197723675814f);
    float r = fmaf(-k, 1.5707963705062866f, th); r = fmaf(-k, -4.371138828673793e-8f, r);
    const float r2 = r * r;
    const float sp = r + r * r2 * (-1.6666667e-1f + r2 * (8.3333333e-3f + r2 * (-1.9841270e-4f + r2 * 2.7557319e-6f)));
    const float cp = 1.0f + r2 * (-0.5f + r2 * (4.1666667e-2f + r2 * (-1.3888889e-3f + r2 * 2.4801587e-5f)));
    const int q = ((int)k) & 3;
    s = (q == 0) ? sp : (q == 1) ? cp : (q == 2) ? -sp : -cp;
    c = (q == 0) ? cp : (q == 1) ? -sp : (q == 2) ? -cp : sp;
}
__device__ __forceinline__ void prologue(const Args& a, LAS unsigned char* lds, int G) {
    int tid_ = threadIdx.x; asm volatile("" : "+v"(tid_));
    const int tid = tid_, lane = tid & 63, wave = __builtin_amdgcn_readfirstlane(tid >> 6);
    LAS float* scr = (LAS float*)(lds + wave * 16384);
    const int gw = blockIdx.x * NWAVES + wave, NGW = G * NWAVES;
    constexpr int I_GU = 16 * 88, I_D = 44 * 32, I_IN = 16 * 40, I_GLU = 8 * 16, I_O = 8 * 32;
    constexpr int C1 = I_GU, C2 = C1 + I_GU, C3 = C2 + I_D, C4 = C3 + I_IN, C5 = C4 + I_GLU, C6 = C5 + I_O, C7 = C6 + I_O, C8 = C7 + I_GU, C9 = C8 + I_GU, C10 = C9 + I_D;
    for (int it = gw; it < NLAYER * C10; it += NGW) {
        const int l = it / C10; int r = it % C10;
        unsigned char* wl = a.ws + WS_W + (size_t)l * W_LAYER;
        const float* W; int ldw, K, nblk; bf16* WT; const float* gain = nullptr; int mode = 0;
        if (r < C1)       { W = a.in[3] + (size_t)l * 1024 * 2816; ldw = 2816; K = 1024; nblk = 88; WT = (bf16*)(wl + W_GU1); gain = a.in[2] + l * 1024; mode = 1; }
        else if (r < C2)  { r -= C1; W = a.in[4] + (size_t)l * 1024 * 2816; ldw = 2816; K = 1024; nblk = 88; WT = (bf16*)(wl + W_GU1); gain = a.in[2] + l * 1024; mode = 2; }
        else if (r < C3)  { r -= C2; W = a.in[5] + (size_t)l * 2816 * 1024; ldw = 1024; K = 2816; nblk = 32; WT = (bf16*)(wl + W_D1); }
        else if (r < C4)  { r -= C3; W = a.in[7] + (size_t)l * 1024 * 1280; ldw = 1280; K = 1024; nblk = 40; WT = (bf16*)(wl + W_IN); gain = a.in[6] + l * 1024; mode = 3; }
        else if (r < C5)  { r -= C4; W = a.in[17] + (size_t)l * 512 * 512; ldw = 512; K = 512; nblk = 16; WT = (bf16*)(wl + W_GLU); }
        else if (r < C6)  { r -= C5; W = a.in[21] + (size_t)l * 1024 * 1024; ldw = 1024; K = 512; nblk = 32; WT = (bf16*)(wl + W_OA); gain = a.in[19] + l * 512; }
        else if (r < C7)  { r -= C6; W = a.in[21] + (size_t)l * 1024 * 1024 + (size_t)512 * 1024; ldw = 1024; K = 512; nblk = 32; WT = (bf16*)(wl + W_OS); gain = a.in[20] + l * 512; }
        else if (r < C8)  { r -= C7; W = a.in[23] + (size_t)l * 1024 * 2816; ldw = 2816; K = 1024; nblk = 88; WT = (bf16*)(wl + W_GU2); gain = a.in[22] + l * 1024; mode = 1; }
        else if (r < C9)  { r -= C8; W = a.in[24] + (size_t)l * 1024 * 2816; ldw = 2816; K = 1024; nblk = 88; WT = (bf16*)(wl + W_GU2); gain = a.in[22] + l * 1024; mode = 2; }
        else              { r -= C9; W = a.in[25] + (size_t)l * 2816 * 1024; ldw = 1024; K = 2816; nblk = 32; WT = (bf16*)(wl + W_D2); }
        const int kb = r / nblk, nb = r % nblk, k0 = 64 * kb, n0 = 32 * nb;
        int drow0 = n0; float cs = 1.0f;
        if (mode == 1) drow0 = 256 * (n0 >> 7) + (n0 & 127);
        else if (mode == 2) drow0 = 256 * (n0 >> 7) + 128 + (n0 & 127);
        else if (mode == 3 && n0 < 512) cs = 0.125f * LOG2E;
        tr_item(W, ldw, K, WT, k0, n0, drow0, gain, cs, scr, lane);
    }
    {
        const float* x = a.in[0]; float* xo = a.out; bf16* xb = (bf16*)(a.ws + WS_XB); float* ssq = (float*)(a.ws + WS_SSQ);
        for (int m = gw; m < NT; m += NGW) {
            const f32x4* xr = (const f32x4*)(x + (size_t)m * DM) + lane; f32x4* orow = (f32x4*)(xo + (size_t)m * DM) + lane; u32x2* brow = (u32x2*)(xb + (size_t)m * DM) + lane;
            float s = 0.f;
#pragma unroll
            for (int j = 0; j < 4; ++j) { const f32x4 v = xr[64 * j]; orow[64 * j] = v; u32x2 w; w.x = pk2(v[0], v[1]); w.y = pk2(v[2], v[3]); brow[64 * j] = w; s += (v[0] * v[0] + v[1] * v[1]) + (v[2] * v[2] + v[3] * v[3]); }
            s = wave_sum(s);
            if (lane < 16) ssq[((size_t)(lane >> 2) * NT + m) * 4 + (lane & 3)] = (lane == 0) ? s : 0.f;
        }
    }
    {
        f32x2* AB = (f32x2*)(a.ws + WS_ABAR); f32x2* AP = (f32x2*)(a.ws + WS_APOW); bf16* BB = (bf16*)(a.ws + WS_BB); bf16* CC = (bf16*)(a.ws + WS_CC);
        for (int cb = gw; cb < NLAYER * 2 * 32; cb += NGW) {
            const int p = lane;
            const float dt = __expf(a.in[11][cb]);
            const float are = a.in[9][cb * 64 + p], aim = a.in[10][cb * 64 + p];
            const float mag = __expf(dt * are); float sn, cs; sincos_rr(dt * aim, sn, cs);
            const float abr = mag * cs, abi = mag * sn;
            const float den = are * are + aim * aim, nr = abr - 1.0f, ni = abi;
            const float kr = (nr * are + ni * aim) / den, ki = (ni * are - nr * aim) / den;
            AB[cb * 64 + p] = (f32x2){abr, abi};
            float pr = abr, pi = abi;
#pragma unroll
            for (int q = 0; q < 9; ++q) { const float t0 = pr * pr - pi * pi, t1 = 2.0f * pr * pi; pr = t0; pi = t1; }
            AP[cb * 64 + p] = (f32x2){pr, pi};
            scr[2 * p] = kr; scr[2 * p + 1] = ki;
            LDS_FENCE();
            const float* bre = a.in[12] + (size_t)cb * 64 * 16; const float* bim = a.in[13] + (size_t)cb * 64 * 16;
            const float* cre = a.in[14] + (size_t)cb * 16 * 64; const float* cim = a.in[15] + (size_t)cb * 16 * 64;
#pragma unroll
            for (int tile = 0; tile < 4; ++tile) {
                const int pp = 32 * (tile & 1) + (lane & 31); const float kr2 = scr[2 * pp], ki2 = scr[2 * pp + 1];
                unsigned w[4];
#pragma unroll
                for (int j2 = 0; j2 < 4; ++j2) { float v[2];
#pragma unroll
                    for (int e = 0; e < 2; ++e) { const int h = 8 * (lane >> 5) + 2 * j2 + e; const float br = bre[pp * 16 + h], bi = bim[pp * 16 + h];
                        v[e] = (tile >> 1) ? (kr2 * bi + ki2 * br) : (kr2 * br - ki2 * bi); }
                    w[j2] = pk2(v[0], v[1]); }
                *(u32x4*)(BB + ((size_t)(cb * 4 + tile) * 64 + lane) * 8) = (u32x4){w[0], w[1], w[2], w[3]};
            }
#pragma unroll
            for (int kk = 0; kk < 4; ++kk) {
                unsigned w[4];
#pragma unroll
                for (int j2 = 0; j2 < 4; ++j2) { const int kap = 32 * kk + 8 * (lane >> 4) + 2 * j2, pp = kap >> 1, h = lane & 15;
                    w[j2] = pk2(cre[h * 64 + pp], -cim[h * 64 + pp]); }
                *(u32x4*)(CC + ((size_t)(cb * 4 + kk) * 64 + lane) * 8) = (u32x4){w[0], w[1], w[2], w[3]};
            }
            LDS_FENCE();
        }
    }
}

__device__ __forceinline__ void attn_phase(const Args& a, LAS unsigned char* lds, int layer, int G) {
    int tid_ = threadIdx.x; asm volatile("" : "+v"(tid_));
    const int tid = tid_, lane = tid & 63, h = __builtin_amdgcn_readfirstlane(tid >> 6), kvh = h >> 2;
    LAS float* biasT = (LAS float*)lds;
    LAS float* red = (LAS float*)(lds + 10240);
    const float* tab = a.in[1];
    for (int e = tid; e < 8 * 320; e += NTHREADS) {
        const int hh = e / 320, ri = e % 320 - 32; float v = -1e30f;
        if (ri >= 0 && ri <= 256) { const int rel = ri - 128, n = rel < 0 ? -rel : rel; int bk = (rel > 0) ? 16 : 0;
            if (n < 8) bk += n; else { int lg = 2 + (31 - __builtin_clz((unsigned)(n * n))); bk += (lg < 15 ? lg : 15); }
            v = tab[bk * 8 + hh] * LOG2E; }
        biasT[e] = v;
    }
    __syncthreads();
    const bf16* proj = (const bf16*)(a.ws + WS_PROJ); const bf16* vT = (const bf16*)(a.ws + WS_VT); bf16* an = (bf16*)(a.ws + WS_AN);
    const float sinkv = a.in[8][layer * 8 + h] * LOG2E;
    const int ql = lane & 31, hi = lane >> 5;
    int par = 0;
    for (int ui = blockIdx.x; ui < 1024; ui += G, par ^= 1) {
        const int b = ui >> 7, q0 = (ui & 127) * 32, rowq = b * SEQ + q0;
        const bf16* qp = proj + (size_t)(rowq + ql) * DIN + h * 64 + 8 * hi;
        bf16x8 qf[4];
#pragma unroll
        for (int kk = 0; kk < 4; ++kk) qf[kk] = *(const bf16x8*)(qp + 16 * kk);
        float m = sinkv, lsum = 1.0f;
        f32x16 o0, o1;
#pragma unroll
        for (int r = 0; r < 16; ++r) { o0[r] = 0.f; o1[r] = 0.f; }
        const bf16* vbase = vT + ((size_t)(b * 2 + kvh) * 64 + ql) * SEQ + 4 * hi;
        for (int kt = 0; kt < 9; ++kt) {
            const int key0 = q0 - 128 + 32 * kt;
            if (key0 < 0 || key0 >= SEQ) continue;
            const bf16* kp = proj + (size_t)(b * SEQ + key0 + ql) * DIN + 512 + kvh * 64 + 8 * hi;
            bf16x8 kf[4];
#pragma unroll
            for (int kk = 0; kk < 4; ++kk) kf[kk] = *(const bf16x8*)(kp + 16 * kk);
            s16x4 vf[2][2][2];
#pragma unroll
            for (int dt = 0; dt < 2; ++dt)
#pragma unroll
                for (int s = 0; s < 2; ++s) { const bf16* vp = vbase + (size_t)(32 * dt) * SEQ + key0 + 16 * s; vf[dt][s][0] = *(const s16x4*)vp; vf[dt][s][1] = *(const s16x4*)(vp + 8); }
            f32x16 st;
#pragma unroll
            for (int r = 0; r < 16; ++r) st[r] = 0.f;
#pragma unroll
            for (int kk = 0; kk < 4; ++kk) st = __builtin_amdgcn_mfma_f32_32x32x16_bf16(kf[kk], qf[kk], st, 0, 0, 0);
            const LAS float* bt = biasT + h * 320 + 32 * kt + 32 - ql + 4 * hi;
            float tmax = -3.0e38f;
#pragma unroll
            for (int r = 0; r < 16; ++r) { st[r] += bt[(r & 3) + 8 * (r >> 2)]; tmax = fmaxf(tmax, st[r]); }
            tmax = fmaxf(tmax, __shfl_xor(tmax, 32));
            const float mnew = fmaxf(m, tmax), alpha = __builtin_amdgcn_exp2f(m - mnew); m = mnew;
            float ps = 0.f;
#pragma unroll
            for (int r = 0; r < 16; ++r) { st[r] = __builtin_amdgcn_exp2f(st[r] - mnew); ps += st[r]; }
            ps += __shfl_xor(ps, 32); lsum = lsum * alpha + ps;
#pragma unroll
            for (int r = 0; r < 16; ++r) { o0[r] *= alpha; o1[r] *= alpha; }
            bf16x8 pf[2];
#pragma unroll
            for (int s = 0; s < 2; ++s) { u32x4 w; w.x = pk2(st[8 * s + 0], st[8 * s + 1]); w.y = pk2(st[8 * s + 2], st[8 * s + 3]); w.z = pk2(st[8 * s + 4], st[8 * s + 5]); w.w = pk2(st[8 * s + 6], st[8 * s + 7]);
                pf[s] = __builtin_bit_cast(bf16x8, w); }
#pragma unroll
            for (int s = 0; s < 2; ++s) {
                bf16x8 v0 = __builtin_shufflevector(vf[0][s][0], vf[0][s][1], 0, 1, 2, 3, 4, 5, 6, 7);
                bf16x8 v1 = __builtin_shufflevector(vf[1][s][0], vf[1][s][1], 0, 1, 2, 3, 4, 5, 6, 7);
                o0 = __builtin_amdgcn_mfma_f32_32x32x16_bf16(v0, pf[s], o0, 0, 0, 0);
                o1 = __builtin_amdgcn_mfma_f32_32x32x16_bf16(v1, pf[s], o1, 0, 0, 0);
            }
        }
        const float inv = 1.0f / lsum;
        float ss = 0.f;
#pragma unroll
        for (int r = 0; r < 16; ++r) { o0[r] *= inv; o1[r] *= inv; ss += o0[r] * o0[r] + o1[r] * o1[r]; }
        ss += __shfl_xor(ss, 32);
        LAS float* rd = red + par * 256;
        if (hi == 0) rd[h * 32 + ql] = ss;
        __syncthreads();
        float tot = 0.f;
#pragma unroll
        for (int hh = 0; hh < 8; ++hh) tot += rd[hh * 32 + ql];
        const float rstd = __builtin_amdgcn_rsqf(tot * (1.0f / 512.0f) + 1e-6f);
        bf16* op = an + (size_t)(rowq + ql) * 512 + h * 64 + 4 * hi;
#pragma unroll
        for (int g4 = 0; g4 < 4; ++g4) {
            u32x2 w0, w1;
            w0.x = pk2(o0[4 * g4] * rstd, o0[4 * g4 + 1] * rstd); w0.y = pk2(o0[4 * g4 + 2] * rstd, o0[4 * g4 + 3] * rstd);
            w1.x = pk2(o1[4 * g4] * rstd, o1[4 * g4 + 1] * rstd); w1.y = pk2(o1[4 * g4 + 2] * rstd, o1[4 * g4 + 3] * rstd);
            *(u32x2*)(op + 8 * g4) = w0; *(u32x2*)(op + 32 + 8 * g4) = w1;
        }
    }
}

constexpr int XS_STRIDE = 68;
template <bool BWD, int MODE  >
__device__ __forceinline__ void ssm_pass(const bf16* proj, int rowbase, int g, const bf16x8* BBp, const bf16x8* CCp, float ar, float ai, float& sr, float& si,
                                         LAS unsigned* XS, int lane, f32x4* ysc, const float* Dp, bf16* zbuf) {
    bf16x8 bb[4], cc[4];
#pragma unroll
    for (int t = 0; t < 4; ++t) { bb[t] = BBp[t * 64 + lane]; if (MODE > 0) cc[t] = CCp[t * 64 + lane]; }
    const int ql = lane & 31, hi = lane >> 5;
    const bf16* up = proj + (size_t)(rowbase + ql) * DIN + 768 + g * 16 + 8 * hi;
    bf16x8 ucur = *(const bf16x8*)(up + (size_t)(BWD ? 15 : 0) * 32 * DIN);
    float dval = 0.f; if (MODE == 2) dval = Dp[g * 16 + (lane & 15)];
    for (int c = 0; c < 16; ++c) {
        const int ch = BWD ? 15 - c : c;
        bf16x8 unext = ucur;
        if (c < 15) unext = *(const bf16x8*)(up + (size_t)(BWD ? ch - 1 : ch + 1) * 32 * DIN);
        f32x16 z16;
#pragma unroll
        for (int r = 0; r < 16; ++r) z16[r] = 0.f;
        const f32x16 x0 = __builtin_amdgcn_mfma_f32_32x32x16_bf16(ucur, bb[0], z16, 0, 0, 0);
        const f32x16 x1 = __builtin_amdgcn_mfma_f32_32x32x16_bf16(ucur, bb[1], z16, 0, 0, 0);
        const f32x16 x2 = __builtin_amdgcn_mfma_f32_32x32x16_bf16(ucur, bb[2], z16, 0, 0, 0);
        const f32x16 x3 = __builtin_amdgcn_mfma_f32_32x32x16_bf16(ucur, bb[3], z16, 0, 0, 0);
#pragma unroll
        for (int r = 0; r < 16; ++r) { const int t = crow(r, hi); XS[t * XS_STRIDE + ql] = pk2(x0[r], x2[r]); XS[t * XS_STRIDE + 32 + ql] = pk2(x1[r], x3[r]); }
        LDS_FENCE();
#pragma unroll
        for (int tt = 0; tt < 32; ++tt) {
            const int t = BWD ? 31 - tt : tt;
            const unsigned v = XS[t * XS_STRIDE + lane];
            const float nr = fmaf(ar, sr, fmaf(-ai, si, bflo(v))), ni = fmaf(ar, si, fmaf(ai, sr, bfhi(v)));
            sr = nr; si = ni;
            if (MODE > 0) XS[t * XS_STRIDE + lane] = pk2(sr, si);
        }
        if (MODE > 0) {
            LDS_FENCE();
            f32x4 y0 = (f32x4){0.f, 0.f, 0.f, 0.f}, y1 = y0;
            if (MODE == 2) { y0 = ysc[(ch * 2 + 0) * 64 + lane]; y1 = ysc[(ch * 2 + 1) * 64 + lane]; }
            const LAS unsigned char* ab = (const LAS unsigned char*)XS + (lane & 15) * (XS_STRIDE * 4) + (lane >> 4) * 16;
#pragma unroll
            for (int kk = 0; kk < 4; ++kk) {
                const bf16x8 a0 = *(const LAS bf16x8*)(ab + kk * 64), a1 = *(const LAS bf16x8*)(ab + 16 * XS_STRIDE * 4 + kk * 64);
                y0 = __builtin_amdgcn_mfma_f32_16x16x32_bf16(a0, cc[kk], y0, 0, 0, 0);
                y1 = __builtin_amdgcn_mfma_f32_16x16x32_bf16(a1, cc[kk], y1, 0, 0, 0);
            }
            if (MODE == 1) { ysc[(ch * 2 + 0) * 64 + lane] = y0; ysc[(ch * 2 + 1) * 64 + lane] = y1; }
            else {
                const int hcol = g * 16 + (lane & 15);
#pragma unroll
                for (int rt = 0; rt < 2; ++rt)
#pragma unroll
                    for (int i = 0; i < 4; ++i) {
                        const int row = rowbase + 32 * ch + 16 * rt + 4 * (lane >> 4) + i;
                        const float uv = bf2f(proj[(size_t)row * DIN + 768 + hcol]);
                        const float y = (rt ? y1[i] : y0[i]) + dval * uv;
                        const float zz = y * __builtin_amdgcn_rcpf(1.0f + __builtin_amdgcn_exp2f(-2.3022082f * (y + 0.044715f * y * y * y)));
                        zbuf[(size_t)row * 512 + hcol] = (bf16)f2bf(zz);
                    }
            }
            LDS_FENCE();
        }
        ucur = unext;
    }
}

__device__ __forceinline__ void ssm_p1(const Args& a, LAS unsigned char* lds, int layer, int G) {
    int tid_ = threadIdx.x; asm volatile("" : "+v"(tid_));
    const int tid = tid_, lane = tid & 63, wave = __builtin_amdgcn_readfirstlane(tid >> 6);
    LAS unsigned* XS = (LAS unsigned*)(lds + 16384 + wave * (32 * XS_STRIDE * 4));
    const bf16* proj = (const bf16*)(a.ws + WS_PROJ);
    const f32x2* AB = (const f32x2*)(a.ws + WS_ABAR); f32x2* SE = (f32x2*)(a.ws + WS_SEGE);
    const int gw = blockIdx.x * NWAVES + wave, NGW = G * NWAVES;
    for (int wt = gw; wt < 4096; wt += NGW) {
        const int dir = wt & 1, seg = (wt >> 1) & 7, g = (wt >> 4) & 31, b = wt >> 9;
        const int cb = (layer * 2 + dir) * 32 + g;
        const f32x2 ab = AB[cb * 64 + lane];
        float sr = 0.f, si = 0.f;
        const bf16x8* BBp = (const bf16x8*)(a.ws + WS_BB) + (size_t)cb * 4 * 64;
        const int rowbase = b * SEQ + seg * 512;
        if (dir) ssm_pass<true, 0>(proj, rowbase, g, BBp, nullptr, ab[0], ab[1], sr, si, XS, lane, nullptr, nullptr, nullptr);
        else     ssm_pass<false, 0>(proj, rowbase, g, BBp, nullptr, ab[0], ab[1], sr, si, XS, lane, nullptr, nullptr, nullptr);
        SE[((size_t)((b * 32 + g) * 2 + dir) * 8 + seg) * 64 + lane] = (f32x2){sr, si};
    }
}
__device__ __forceinline__ void ssm_p3(const Args& a, LAS unsigned char* lds, int layer, int G) {
    int tid_ = threadIdx.x; asm volatile("" : "+v"(tid_));
    const int tid = tid_, lane = tid & 63, wave = __builtin_amdgcn_readfirstlane(tid >> 6);
    LAS unsigned* XS = (LAS unsigned*)(lds + 16384 + wave * (32 * XS_STRIDE * 4));
    const bf16* proj = (const bf16*)(a.ws + WS_PROJ); bf16* zbuf = (bf16*)(a.ws + WS_Z);
    const f32x2* AB = (const f32x2*)(a.ws + WS_ABAR); const f32x2* AP = (const f32x2*)(a.ws + WS_APOW); const f32x2* SE = (const f32x2*)(a.ws + WS_SEGE);
    const int gw = blockIdx.x * NWAVES + wave, NGW = G * NWAVES;
    (void)gw; (void)NGW;
    for (int wg = blockIdx.x; wg < 256; wg += G) {
        const int wt = wg * 8 + wave, g = (wg & 3) * 8 + wave, seg = (wg >> 2) & 7, b = wg >> 5;
        const int rowbase = b * SEQ + seg * 512;
        f32x4* ysc = (f32x4*)(a.ws + WS_YSCR) + (size_t)wt * (16 * 2 * 64);
        {
            const int cb = (layer * 2 + 1) * 32 + g;
            const f32x2 ab = AB[cb * 64 + lane], ap = AP[cb * 64 + lane];
            const f32x2* se = SE + ((size_t)((b * 32 + g) * 2 + 1) * 8) * 64 + lane;
            float sr = 0.f, si = 0.f;
            for (int k = 7; k > seg && !DIAG_NOCARRY; --k) { const f32x2 e = se[k * 64]; const float nr = ap[0] * sr - ap[1] * si + e[0], ni = ap[0] * si + ap[1] * sr + e[1]; sr = nr; si = ni; }
            ssm_pass<true, 1>(proj, rowbase, g, (const bf16x8*)(a.ws + WS_BB) + (size_t)cb * 256, (const bf16x8*)(a.ws + WS_CC) + (size_t)cb * 256, ab[0], ab[1], sr, si, XS, lane, ysc, nullptr, nullptr);
        }
        {
            const int cb = (layer * 2 + 0) * 32 + g;
            const f32x2 ab = AB[cb * 64 + lane], ap = AP[cb * 64 + lane];
            const f32x2* se = SE + ((size_t)((b * 32 + g) * 2 + 0) * 8) * 64 + lane;
            float sr = 0.f, si = 0.f;
            for (int k = 0; k < seg && !DIAG_NOCARRY; ++k) { const f32x2 e = se[k * 64]; const float nr = ap[0] * sr - ap[1] * si + e[0], ni = ap[0] * si + ap[1] * sr + e[1]; sr = nr; si = ni; }
            ssm_pass<false, 2>(proj, rowbase, g, (const bf16x8*)(a.ws + WS_BB) + (size_t)cb * 256, (const bf16x8*)(a.ws + WS_CC) + (size_t)cb * 256, ab[0], ab[1], sr, si, XS, lane, ysc, a.in[16] + layer * 512, zbuf);
        }
    }
}

__device__ __forceinline__ void final_norm(const Args& a, int G) {
    int tid_ = threadIdx.x; asm volatile("" : "+v"(tid_));
    const int tid = tid_, lane = tid & 63, wave = __builtin_amdgcn_readfirstlane(tid >> 6);
    const int gw = blockIdx.x * NWAVES + wave, NGW = G * NWAVES;
    const float* ssq = (const float*)(a.ws + WS_SSQ); const f32x4* gn = (const f32x4*)a.in[26] + lane;
    f32x4 gv[4];
#pragma unroll
    for (int j = 0; j < 4; ++j) gv[j] = gn[64 * j];
    for (int m = gw; m < NT; m += NGW) {
        float s = (lane < 16) ? ssq[((size_t)(lane >> 2) * NT + m) * 4 + (lane & 3)] : 0.f; s = wave_sum(s);
        const float rs = __builtin_amdgcn_rsqf(s * (1.0f / 1024.0f) + 1e-6f);
        f32x4* orow = (f32x4*)(a.out + (size_t)m * DM) + lane;
#pragma unroll
        for (int j = 0; j < 4; ++j) { const f32x4 v = orow[64 * j]; orow[64 * j] = v * rs * gv[j]; }
    }
}

#define GRID_SYNC() do { asm volatile("s_waitcnt vmcnt(0) lgkmcnt(0)" ::: "memory"); __builtin_amdgcn_fence(__ATOMIC_RELEASE, "agent"); asm volatile("s_waitcnt vmcnt(0)" ::: "memory"); \
    grid.sync(); __builtin_amdgcn_fence(__ATOMIC_ACQUIRE, "agent"); asm volatile("s_waitcnt vmcnt(0)" ::: "memory"); __syncthreads(); } while (0)
__global__ void __launch_bounds__(NTHREADS, 2) hymba_fwd(Args a) {
    extern __shared__ __attribute__((aligned(16))) unsigned char lds_raw[];
    LAS unsigned char* lds = (LAS unsigned char*)lds_raw;
    cg::grid_group grid = cg::this_grid();
    const int G = gridDim.x, bid = blockIdx.x;
    unsigned char* ws = a.ws;
    float* xf = a.out; pg8::bf16_t* xb = (pg8::bf16_t*)(ws + WS_XB);
    float* ssq = (float*)(ws + WS_SSQ); float* ssq2 = (float*)(ws + WS_SSQ2);
    pg8::bf16_t* Hb = (pg8::bf16_t*)(ws + WS_H); pg8::bf16_t* projb = (pg8::bf16_t*)(ws + WS_PROJ); pg8::bf16_t* vTb = (pg8::bf16_t*)(ws + WS_VT);
    pg8::bf16_t* anb = (pg8::bf16_t*)(ws + WS_AN); pg8::bf16_t* zb = (pg8::bf16_t*)(ws + WS_Z); pg8::bf16_t* sb = (pg8::bf16_t*)(ws + WS_S);

    prologue(a, lds, G);
    GRID_SYNC();
    for (int st = 0; st < 2 * NLAYER; ++st) {
        const int layer = st >> 1, second = st & 1;
        const unsigned char* wl = ws + WS_W + (size_t)layer * W_LAYER;
        {
            pg8::Gemm g{xb, (const pg8::bf16_t*)(wl + (second ? W_GU2 : W_GU1)), NT, 2 * DFF, DM}; pg8::StaticOrder S; S.init(NT, 2 * DFF, G, bid);
            pg8::EpiSwiGLU E{Hb, ssq};
            pg8::gemm_phase<pg8::EpiSwiGLU, pg8::StaticOrder, true, true>(lds, g, S, E);
            GRID_SYNC();
            pg8::Gemm g2{Hb, (const pg8::bf16_t*)(wl + (second ? W_D2 : W_D1)), NT, DM, DFF}; pg8::StaticOrder S2; S2.init(NT, DM, G, bid);
            pg8::EpiResid<false, true> E2{xf, xb, ssq, nullptr, 0.5f};
            pg8::gemm_phase<pg8::EpiResid<false, true>, pg8::StaticOrder, true, true>(lds, g2, S2, E2);
            GRID_SYNC();
        }
        if (!second && DIAG_MIXER) {
            {
                pg8::Gemm g{xb, (const pg8::bf16_t*)(wl + W_IN), NT, DIN, DM}; pg8::StaticOrder S; S.init(NT, DIN, G, bid);
                pg8::EpiProj E{projb, vTb, ssq};
                pg8::gemm_phase<pg8::EpiProj, pg8::StaticOrder, true, true>(lds, g, S, E);
                GRID_SYNC();
            }
            if (DIAG_MIXER != 3) attn_phase(a, lds, layer, G);
            if (DIAG_MIXER != 2 && !DIAG_NOCARRY) ssm_p1(a, lds, layer, G);
            GRID_SYNC();
            if (DIAG_MIXER != 2) ssm_p3(a, lds, layer, G);
            GRID_SYNC();
            if (DIAG_MIXER != 2) {
                pg8::Gemm g{zb, (const pg8::bf16_t*)(wl + W_GLU), NT, 512, 512}; pg8::StaticOrder S; S.init(NT, 512, G, bid);
                pg8::EpiGlu E{zb, sb, a.in[18] + layer * 512, ssq2};
                pg8::gemm_phase<pg8::EpiGlu, pg8::StaticOrder, true, true>(lds, g, S, E);
                GRID_SYNC();
            }
            {
                pg8::Gemm g{anb, (const pg8::bf16_t*)(wl + W_OA), NT, DM, 512}; pg8::StaticOrder S; S.init(NT, DM, G, bid);
                if (DIAG_MIXER == 1) { pg8::EpiResid<false, false> E{xf, xb, ssq, nullptr, 1.0f};
                pg8::gemm_phase<pg8::EpiResid<false, false>, pg8::StaticOrder, true, true>(lds, g, S, E); }
                if (DIAG_MIXER == 2) { pg8::EpiResid<false, true> E{xf, xb, ssq, nullptr, 1.0f};
                pg8::gemm_phase<pg8::EpiResid<false, true>, pg8::StaticOrder, true, true>(lds, g, S, E); }
                if (DIAG_MIXER != 2) { pg8::Gemm g2{sb, (const pg8::bf16_t*)(wl + W_OS), NT, DM, 512};
                pg8::EpiResid<true, true> E2{xf, xb, ssq, ssq2, 1.0f};
                pg8::gemm_phase<pg8::EpiResid<true, true>, pg8::StaticOrder, true, true>(lds, g2, S, E2); }
                GRID_SYNC();
            }
        }
    }
    final_norm(a, G);
}

extern "C" void kernel_launch(void* const* d_in, const int* in_sizes, int n_in, void* d_out, int out_size, void* d_ws, size_t ws_size, hipStream_t stream) {
    static int grid = 0;
    if (grid == 0) {
        if (n_in != 27 || out_size != NT * DM || ws_size < WS_END) { fprintf(stderr, "kernel_launch: unexpected shapes: n_in %d out %d ws %zu (need %zu)\n", n_in, out_size, ws_size, (size_t)WS_END); grid = -1; return; }
        int dev = 0, cus = 0, per_cu = 0;
        hipGetDevice(&dev); hipDeviceGetAttribute(&cus, hipDeviceAttributeMultiprocessorCount, dev);
        hipFuncSetAttribute((const void*)hymba_fwd, hipFuncAttributeMaxDynamicSharedMemorySize, LDS_BYTES);
        hipOccupancyMaxActiveBlocksPerMultiprocessor(&per_cu, (const void*)hymba_fwd, NTHREADS, LDS_BYTES);
        if (per_cu < 1) { fprintf(stderr, "kernel_launch: occupancy query says %d blocks per CU\n", per_cu); per_cu = 1; }
        (void)hipGetLastError();
        grid = cus * per_cu;
        fprintf(stderr, "kernel_launch: grid %d (%d CUs x %d)\n", grid, cus, per_cu);
    }
    if (grid < 0) return;
    Args a{};
    for (int i = 0; i < 27; ++i) a.in[i] = (const float*)d_in[i];
    a.out = (float*)d_out; a.ws = (unsigned char*)d_ws;
    void* args[] = {&a};
    hipError_t e = hipLaunchCooperativeKernel((const void*)hymba_fwd, dim3(grid), dim3(NTHREADS), args, LDS_BYTES, stream);
    if (e != hipSuccess) fprintf(stderr, "cooperative launch failed: %s (grid %d)\n", hipGetErrorString(e), grid);
}
```

```cpp
#include <hip/hip_runtime.h>
#include <hip/hip_cooperative_groups.h>
#include <cstdio>
#include <cstdint>
namespace cg = cooperative_groups;
namespace pg8 {
#define PG8_LAS __attribute__((address_space(3)))
typedef unsigned short bf16_t;
typedef short bf16x8 __attribute__((ext_vector_type(8)));
typedef float f32x4 __attribute__((ext_vector_type(4)));
typedef unsigned u32x4 __attribute__((ext_vector_type(4)));
constexpr int BM = 256, BK = 64, HALF = 128, HTB = HALF * BK * 2  , STAGE_BYTES = 8 * HTB, NXCD = 8, WGM = 8;

__host__ __device__ __forceinline__ int lds_byte(int r, int c) { const int st = (r >> 4) * 2 + (c >> 5), rr = r & 15, cc = c & 31, ob = rr * 64 + cc * 2; return st * 1024 + (ob ^ (((ob >> 9) & 1) << 5)); }
__host__ __device__ __forceinline__ void stage_rc(int b, int& R, int& C) { const int st = b / 1024, sb = b % 1024, swz = sb ^ (((sb >> 9) & 1) << 5); R = (st >> 1) * 16 + swz / 64; C = (st & 1) * 32 + (swz % 64) / 2; }
__host__ __device__ __forceinline__ int perm32(int rho) { const int n = rho >> 4, i = rho & 15; return 8 * (i >> 2) + 4 * n + (i & 3); }

struct Unit { int pm, pn; };
struct Gemm { const bf16_t* A; const bf16_t* Bt; int M, N, K; };

struct StaticOrder {
    int nM, nN, nwg, G, c;
    __host__ __device__ void init(int M, int N, int G_, int c_) { nM = M / BM; nN = N / BM; nwg = nM * nN; G = G_; c = c_; }
    __host__ __device__ bool next(int i, Unit& u) const {
        const long L = (long)i * G + c; if (L >= nwg) return false;
        int wgid = (int)L; { const int q = nwg / NXCD, r = nwg % NXCD, xcd = wgid % NXCD, off = wgid / NXCD; wgid = (xcd < r ? xcd * (q + 1) : r * (q + 1) + (xcd - r) * q) + off; }
        const int nig = WGM * nN, gid = wgid / nig, fm = gid * WGM, gsz = (nM - fm) < WGM ? (nM - fm) : WGM;
        u.pm = fm + ((wgid % nig) % gsz); u.pn = (wgid % nig) / gsz; return true;
    }
    __device__ __forceinline__ void a_ready(const Unit&) const {}
    __device__ __forceinline__ void done(const Unit&) const {}
};

typedef float f32x2 __attribute__((ext_vector_type(2)));
typedef __bf16 bf16x2_t __attribute__((ext_vector_type(2)));
__device__ __forceinline__ unsigned cvt_pk_bf16(float lo, float hi) { const f32x2 v = {lo, hi}; return __builtin_bit_cast(unsigned, __builtin_convertvector(v, bf16x2_t)); }
typedef unsigned u32x2 __attribute__((ext_vector_type(2)));
constexpr float RMS_EPS = 1e-6f;
__device__ __forceinline__ float bf_lo(unsigned w) { return __uint_as_float(w << 16); }
__device__ __forceinline__ float bf_hi(unsigned w) { return __uint_as_float(w & 0xffff0000u); }
__device__ __forceinline__ float fast_sigmoid(float v) { return __builtin_amdgcn_rcpf(1.0f + __builtin_amdgcn_exp2f(-1.4426950408889634f * v)); }
__device__ __forceinline__ float row_rstd16(const float* ssq, int row, int fq) {
    const f32x4 v = *(const f32x4*)(ssq + ((size_t)fq * 32768 + row) * 4);
    float s = (v[0] + v[1]) + (v[2] + v[3]);
    s += __shfl_xor(s, 16); s += __shfl_xor(s, 32);
    return __builtin_amdgcn_rsqf(s * (1.0f / 1024.0f) + RMS_EPS);
}
__device__ __forceinline__ float row_rstd8(const float* ssq2, int row, int fq) {
    const f32x2 v = *(const f32x2*)(ssq2 + ((size_t)(fq & 1) * 32768 + row) * 4 + 2 * (fq >> 1));
    float s = v[0] + v[1];
    s += __shfl_xor(s, 16); s += __shfl_xor(s, 32);
    return __builtin_amdgcn_rsqf(s * (1.0f / 512.0f) + RMS_EPS);
}

struct EpiSwiGLU {
    static constexpr bool PERM = true, AFTER_DRAIN = false;
    bf16_t* H; const float* ssq;
    __device__ __forceinline__ void operator()(const f32x4 (&acc)[2][2][4][2], const Unit& u, int wr, int wc, int fr, int fq) const {
        const int row0 = u.pm * BM + wr * 64 + fr, hc = u.pn * 128 + wc * 32 + 8 * fq;
#pragma unroll
        for (int ai = 0; ai < 2; ++ai)
#pragma unroll
            for (int m = 0; m < 4; ++m) {
                const int row = row0 + ai * HALF + m * 16;
                const float rs = row_rstd16(ssq, row, fq);
                float o[8];
#pragma unroll
                for (int n = 0; n < 2; ++n)
#pragma unroll
                    for (int j = 0; j < 4; ++j) { const float g = acc[ai][0][m][n][j] * rs, up = acc[ai][1][m][n][j] * rs; o[4 * n + j] = g * fast_sigmoid(g) * up; }
                u32x4 w; w.x = cvt_pk_bf16(o[0], o[1]); w.y = cvt_pk_bf16(o[2], o[3]); w.z = cvt_pk_bf16(o[4], o[5]); w.w = cvt_pk_bf16(o[6], o[7]);
                *(u32x4*)(H + (size_t)row * 2816 + hc) = w;
            }
    }
};

template <bool ROWSCALE, bool FINAL> struct EpiResid {
    static constexpr bool PERM = false, AFTER_DRAIN = false;
    float* x; bf16_t* xb; float* ssq; const float* ssq2; float scale;
    __device__ __forceinline__ void operator()(const f32x4 (&acc)[2][2][4][2], const Unit& u, int wr, int wc, int fr, int fq) const {
        const int row0 = u.pm * BM + wr * 64 + fr, col0 = u.pn * BM + wc * 32 + 4 * fq;
#pragma unroll
        for (int ai = 0; ai < 2; ++ai)
#pragma unroll
            for (int m = 0; m < 4; ++m) {
                const int row = row0 + ai * HALF + m * 16;
                float sc = scale; if (ROWSCALE) sc = row_rstd8(ssq2, row, fq);
                float ss = 0.f;
#pragma unroll
                for (int bj = 0; bj < 2; ++bj)
#pragma unroll
                    for (int n = 0; n < 2; ++n) {
                        const size_t off = (size_t)row * 1024 + col0 + bj * HALF + n * 16;
                        const f32x4 xv = *(const f32x4*)(x + off);
                        const f32x4 o = xv + acc[ai][bj][m][n] * sc;
                        *(f32x4*)(x + off) = o;
                        if (FINAL) { u32x2 w; w.x = cvt_pk_bf16(o[0], o[1]); w.y = cvt_pk_bf16(o[2], o[3]); *(u32x2*)(xb + off) = w;
                            ss += (o[0] * o[0] + o[1] * o[1]) + (o[2] * o[2] + o[3] * o[3]); }
                    }
                if (FINAL) { ss += __shfl_xor(ss, 16); ss += __shfl_xor(ss, 32); if (fq == 0) ssq[((size_t)u.pn * 32768 + row) * 4 + wc] = ss; }
            }
    }
};

struct EpiProj {
    static constexpr bool PERM = true, AFTER_DRAIN = false;
    bf16_t* proj; bf16_t* vT; const float* ssq;
    __device__ __forceinline__ void operator()(const f32x4 (&acc)[2][2][4][2], const Unit& u, int wr, int wc, int fr, int fq) const {
        const int row0 = u.pm * BM + wr * 64 + fr;
#pragma unroll
        for (int ai = 0; ai < 2; ++ai)
#pragma unroll
            for (int m = 0; m < 4; ++m) {
                const int row = row0 + ai * HALF + m * 16;
                const float rs = row_rstd16(ssq, row, fq);
#pragma unroll
                for (int bj = 0; bj < 2; ++bj) {
                    const f32x4 v0 = acc[ai][bj][m][0] * rs, v1 = acc[ai][bj][m][1] * rs;
                    u32x4 w; w.x = cvt_pk_bf16(v0[0], v0[1]); w.y = cvt_pk_bf16(v0[2], v0[3]); w.z = cvt_pk_bf16(v1[0], v1[1]); w.w = cvt_pk_bf16(v1[2], v1[3]);
                    if (u.pn == 2 && bj == 1) {
                        const int vc = wc * 32 + 8 * fq, b = row >> 12, t = row & 4095;
                        bf16_t* dst = vT + ((size_t)(b * 2 + (vc >> 6)) * 64 + (vc & 63)) * 4096 + t;
                        dst[0 * 4096] = (bf16_t)(w.x & 0xffffu); dst[1 * 4096] = (bf16_t)(w.x >> 16);
                        dst[2 * 4096] = (bf16_t)(w.y & 0xffffu); dst[3 * 4096] = (bf16_t)(w.y >> 16);
                        dst[4 * 4096] = (bf16_t)(w.z & 0xffffu); dst[5 * 4096] = (bf16_t)(w.z >> 16);
                        dst[6 * 4096] = (bf16_t)(w.w & 0xffffu); dst[7 * 4096] = (bf16_t)(w.w >> 16);
                    } else {
                        *(u32x4*)(proj + (size_t)row * 1280 + u.pn * BM + bj * HALF + wc * 32 + 8 * fq) = w;
                    }
                }
            }
    }
};

struct EpiGlu {
    static constexpr bool PERM = true, AFTER_DRAIN = false;
    const bf16_t* z; bf16_t* s; const float* bglu; float* ssq2;
    __device__ __forceinline__ void operator()(const f32x4 (&acc)[2][2][4][2], const Unit& u, int wr, int wc, int fr, int fq) const {
        const int row0 = u.pm * BM + wr * 64 + fr;
#pragma unroll
        for (int ai = 0; ai < 2; ++ai)
#pragma unroll
            for (int m = 0; m < 4; ++m) {
                const int row = row0 + ai * HALF + m * 16;
                float ss = 0.f;
#pragma unroll
                for (int bj = 0; bj < 2; ++bj) {
                    const int c0 = u.pn * BM + bj * HALF + wc * 32 + 8 * fq;
                    const u32x4 zw = *(const u32x4*)(z + (size_t)row * 512 + c0);
                    const f32x4 b0 = *(const f32x4*)(bglu + c0), b1 = *(const f32x4*)(bglu + c0 + 4);
                    const f32x4 a0 = acc[ai][bj][m][0] + b0, a1 = acc[ai][bj][m][1] + b1;
                    float o[8];
                    o[0] = bf_lo(zw.x) * fast_sigmoid(a0[0]); o[1] = bf_hi(zw.x) * fast_sigmoid(a0[1]);
                    o[2] = bf_lo(zw.y) * fast_sigmoid(a0[2]); o[3] = bf_hi(zw.y) * fast_sigmoid(a0[3]);
                    o[4] = bf_lo(zw.z) * fast_sigmoid(a1[0]); o[5] = bf_hi(zw.z) * fast_sigmoid(a1[1]);
                    o[6] = bf_lo(zw.w) * fast_sigmoid(a1[2]); o[7] = bf_hi(zw.w) * fast_sigmoid(a1[3]);
#pragma unroll
                    for (int j = 0; j < 8; ++j) ss += o[j] * o[j];
                    u32x4 w; w.x = cvt_pk_bf16(o[0], o[1]); w.y = cvt_pk_bf16(o[2], o[3]); w.z = cvt_pk_bf16(o[4], o[5]); w.w = cvt_pk_bf16(o[6], o[7]);
                    *(u32x4*)(s + (size_t)row * 512 + c0) = w;
                }
                ss += __shfl_xor(ss, 16); ss += __shfl_xor(ss, 32); if (fq == 0) ssq2[((size_t)u.pn * 32768 + row) * 4 + wc] = ss;
            }
    }
};
template <class Epi, class Sched, bool ALIGN_EPI = false, bool SP2 = false>
__device__ __forceinline__ void gemm_phase(PG8_LAS unsigned char* lds, const Gemm g, const Sched& S, const Epi& E) {
    int tid_ = threadIdx.x; asm volatile("" : "+v"(tid_));
    const int tid = tid_, wid = __builtin_amdgcn_readfirstlane(tid >> 6), lane = tid & 63, wr = wid >> 2, wc = wid & 3, fr = lane & 15, fq = lane >> 4;
    const int K = g.K, nt = K / BK;
    unsigned voffA[2], voffB[2];
#pragma unroll
    for (int i = 0; i < 2; ++i) { int R, C; stage_rc(tid * 16 + i * 8192, R, C); const int Rb = Epi::PERM ? ((R & ~31) + perm32(R & 31)) : R;
        voffA[i] = (unsigned)(R * K + C) * 2u; voffB[i] = (unsigned)(Rb * K + C) * 2u; }
    const size_t kstep = (size_t)(BK * 2);
    const size_t hstep = (size_t)HALF * K * 2;
    const size_t tstep = 2 * hstep;
    const unsigned ldsw = (unsigned)wid * 1024u;
    const int aoff = lds_byte(wr * 64 + fr, fq * 8), boff = lds_byte(wc * 32 + fr, fq * 8);
#define PG8_SA(b, h) (((b) * 2 + (h)) * HTB)
#define PG8_SB(b, h) ((4 + (b) * 2 + (h)) * HTB)
#define PG8_STAGE(bufoff, gbase, voff) do { _Pragma("unroll") for (int _i = 0; _i < 2; ++_i) \
        __builtin_amdgcn_global_load_lds((const unsigned*)((const char*)(gbase) + (voff)[_i]), (PG8_LAS unsigned*)(lds + (bufoff) + ldsw + _i * 8192), 16, 0, 0); } while (0)
#define PG8_LDA(dst, b, h) do { _Pragma("unroll") for (int m = 0; m < 4; ++m) _Pragma("unroll") for (int k = 0; k < 2; ++k) dst[m][k] = *(const PG8_LAS bf16x8*)(lds + PG8_SA(b, h) + aoff + m * 2048 + k * 1024); } while (0)
#define PG8_LDB(dst, b, h) do { _Pragma("unroll") for (int n = 0; n < 2; ++n) _Pragma("unroll") for (int k = 0; k < 2; ++k) dst[n][k] = *(const PG8_LAS bf16x8*)(lds + PG8_SB(b, h) + boff + n * 2048 + k * 1024); } while (0)
#define PG8_MMA(ai, bj, At, Bt) do { __builtin_amdgcn_s_setprio(1); _Pragma("unroll") for (int m = 0; m < 4; ++m) _Pragma("unroll") for (int n = 0; n < 2; ++n) _Pragma("unroll") for (int k = 0; k < 2; ++k) \
        acc[ai][bj][m][n] = __builtin_amdgcn_mfma_f32_16x16x32_bf16(Bt[n][k], At[m][k], acc[ai][bj][m][n], 0, 0, 0); __builtin_amdgcn_s_setprio(0); } while (0)
#define PG8_WAIT_V(n) asm volatile("s_waitcnt vmcnt(" #n ")" ::: "memory")
#define PG8_WAIT_L(n) asm volatile("s_waitcnt lgkmcnt(" #n ")" ::: "memory")
#define PG8_BAR __builtin_amdgcn_s_barrier()
#define PG8_SCHED __builtin_amdgcn_sched_barrier(0)
    Unit cur, nxt; int ui = 0;
    if (!S.next(0, cur)) return;
    f32x4 acc[2][2][4][2];
#pragma unroll
    for (int a = 0; a < 2; ++a)
#pragma unroll
        for (int b = 0; b < 2; ++b)
#pragma unroll
            for (int m = 0; m < 4; ++m)
#pragma unroll
                for (int n = 0; n < 2; ++n) acc[a][b][m][n] = (f32x4){0.f, 0.f, 0.f, 0.f};
    bf16x8 At[4][2], B0[2][2], B1[2][2];
    const char* cA = (const char*)g.A + (size_t)cur.pm * tstep; const char* cB = (const char*)g.Bt + (size_t)cur.pn * tstep;
    S.a_ready(cur);
    if constexpr (SP2) {
        PG8_STAGE(PG8_SB(0, 0), cB, voffB); PG8_STAGE(PG8_SB(0, 1), cB + hstep, voffB); PG8_STAGE(PG8_SA(0, 0), cA, voffA); PG8_STAGE(PG8_SA(0, 1), cA + hstep, voffA);
        if (wr == 1) PG8_BAR;
        PG8_WAIT_V(2); PG8_BAR;
        PG8_STAGE(PG8_SB(1, 0), cB + kstep, voffB); PG8_STAGE(PG8_SA(1, 0), cA + kstep, voffA); PG8_STAGE(PG8_SB(1, 1), cB + hstep + kstep, voffB);
        PG8_WAIT_V(6); PG8_BAR;
    } else {
        PG8_STAGE(PG8_SB(0, 0), cB, voffB); PG8_STAGE(PG8_SA(0, 0), cA, voffA); PG8_STAGE(PG8_SB(0, 1), cB + hstep, voffB); PG8_STAGE(PG8_SA(0, 1), cA + hstep, voffA);
        if (wr == 1) PG8_BAR;
        PG8_WAIT_V(4); PG8_BAR;
        PG8_STAGE(PG8_SB(1, 0), cB + kstep, voffB); PG8_STAGE(PG8_SA(1, 0), cA + kstep, voffA); PG8_STAGE(PG8_SB(1, 1), cB + hstep + kstep, voffB);
        PG8_WAIT_V(6); PG8_BAR;
    }
    for (;;) {
        const bool has_next = S.next(ui + 1, nxt);
        const char* nA = has_next ? (const char*)g.A + (size_t)nxt.pm * tstep : cA; const char* nB = has_next ? (const char*)g.Bt + (size_t)nxt.pn * tstep : cB;
        for (int t = 0; t < nt; t += 2) {
            const bool last = (t == nt - 2);
            const char* a1 = cA + (size_t)(t + 1) * kstep;
            const char* a2 = last ? nA : cA + (size_t)(t + 2) * kstep; const char* b2 = last ? nB : cB + (size_t)(t + 2) * kstep;
            const char* a3 = a2 + kstep; const char* b3 = b2 + kstep;
            if (last && has_next) S.a_ready(nxt);
            if constexpr (SP2) {
            PG8_LDB(B0, 0, 0); PG8_LDB(B1, 0, 1); PG8_SCHED; PG8_LDA(At, 0, 0); PG8_STAGE(PG8_SA(1, 1), a1 + hstep, voffA);
            PG8_WAIT_V(8); PG8_WAIT_L(0); PG8_BAR; PG8_MMA(0, 0, At, B0); PG8_MMA(0, 1, At, B1); PG8_BAR; PG8_SCHED;
            PG8_LDA(At, 0, 1); PG8_STAGE(PG8_SB(0, 0), b2, voffB); PG8_STAGE(PG8_SB(0, 1), b2 + hstep, voffB); PG8_STAGE(PG8_SA(0, 0), a2, voffA);
            PG8_WAIT_V(8); PG8_WAIT_L(0); PG8_BAR; PG8_MMA(1, 0, At, B0); PG8_MMA(1, 1, At, B1); PG8_BAR; PG8_SCHED;
            PG8_LDB(B0, 1, 0); PG8_LDB(B1, 1, 1); PG8_SCHED; PG8_LDA(At, 1, 0); PG8_STAGE(PG8_SA(0, 1), a2 + hstep, voffA);
            PG8_WAIT_V(8); PG8_WAIT_L(0); PG8_BAR; PG8_MMA(0, 0, At, B0); PG8_MMA(0, 1, At, B1); PG8_BAR; PG8_SCHED;
            PG8_LDA(At, 1, 1); PG8_STAGE(PG8_SB(1, 0), b3, voffB); PG8_STAGE(PG8_SB(1, 1), b3 + hstep, voffB); PG8_STAGE(PG8_SA(1, 0), a3, voffA);
            PG8_WAIT_V(8); PG8_WAIT_L(0); PG8_BAR; PG8_MMA(1, 0, At, B0); PG8_MMA(1, 1, At, B1); PG8_BAR; PG8_SCHED;
            } else {
            PG8_LDB(B0, 0, 0); PG8_SCHED; PG8_LDA(At, 0, 0); PG8_STAGE(PG8_SA(1, 1), a1 + hstep, voffA);
            PG8_WAIT_L(8); PG8_BAR; PG8_WAIT_L(0); PG8_MMA(0, 0, At, B0); PG8_BAR; PG8_SCHED;
            PG8_LDB(B1, 0, 1); PG8_STAGE(PG8_SB(0, 0), b2, voffB);
            PG8_BAR; PG8_WAIT_L(0); PG8_MMA(0, 1, At, B1); PG8_BAR;
            PG8_LDA(At, 0, 1); PG8_STAGE(PG8_SA(0, 0), a2, voffA);
            PG8_BAR; PG8_WAIT_L(0); PG8_MMA(1, 0, At, B0); PG8_BAR; PG8_SCHED;
            PG8_STAGE(PG8_SB(0, 1), b2 + hstep, voffB);
            PG8_WAIT_V(6); PG8_BAR; PG8_MMA(1, 1, At, B1); PG8_BAR;
            PG8_LDB(B0, 1, 0); PG8_SCHED; PG8_LDA(At, 1, 0); PG8_STAGE(PG8_SA(0, 1), a2 + hstep, voffA);
            PG8_WAIT_L(8); PG8_BAR; PG8_WAIT_L(0); PG8_MMA(0, 0, At, B0); PG8_BAR; PG8_SCHED;
            PG8_LDB(B1, 1, 1); PG8_STAGE(PG8_SB(1, 0), b3, voffB);
            PG8_BAR; PG8_WAIT_L(0); PG8_MMA(0, 1, At, B1); PG8_BAR;
            PG8_LDA(At, 1, 1); PG8_STAGE(PG8_SA(1, 0), a3, voffA);
            PG8_BAR; PG8_WAIT_L(0); PG8_MMA(1, 0, At, B0); PG8_BAR; PG8_SCHED;
            PG8_STAGE(PG8_SB(1, 1), b3 + hstep, voffB);
            PG8_WAIT_V(6); PG8_BAR; PG8_MMA(1, 1, At, B1); PG8_BAR;
            }
        }
        if constexpr (ALIGN_EPI) { if (wr == 0) PG8_BAR; }
        if constexpr (!Epi::AFTER_DRAIN) { E(acc, cur, wr, wc, fr, fq); S.done(cur); }
        if (!has_next) break;
#pragma unroll
        for (int a = 0; a < 2; ++a)
#pragma unroll
            for (int b = 0; b < 2; ++b)
#pragma unroll
                for (int m = 0; m < 4; ++m)
#pragma unroll
                    for (int n = 0; n < 2; ++n) acc[a][b][m][n] = (f32x4){0.f, 0.f, 0.f, 0.f};
        cur = nxt; cA = nA; cB = nB; ++ui;
        if constexpr (ALIGN_EPI) { if (wr == 1) PG8_BAR; }
    }
    PG8_WAIT_V(0);
    if constexpr (!ALIGN_EPI) { if (wr == 0) PG8_BAR; }
    PG8_BAR;
    if constexpr (Epi::AFTER_DRAIN) { E.fused(acc, cur, wr, wc, fr, fq, lds, wid, lane); S.done(cur); }
#undef PG8_SA
#undef PG8_SB
#undef PG8_STAGE
#undef PG8_LDA
#undef PG8_LDB
#undef PG8_MMA
#undef PG8_WAIT_V
#undef PG8_WAIT_L
#undef PG8_BAR
#undef PG8_SCHED
}
}

#ifndef DIAG_NOCARRY
#define DIAG_NOCARRY 0
#endif
#ifndef DUP_MIX
#define DUP_MIX 0
#endif
#ifndef DUP_G1
#define DUP_G1 0
#endif
#ifndef DIAG_MIXER
#define DIAG_MIXER 1
#endif
#define LAS __attribute__((address_space(3)))
typedef unsigned short bf16;
typedef short bf16x8 __attribute__((ext_vector_type(8)));
typedef short s16x4 __attribute__((ext_vector_type(4)));
typedef float f32x2 __attribute__((ext_vector_type(2)));
typedef float f32x4 __attribute__((ext_vector_type(4)));
typedef float f32x16 __attribute__((ext_vector_type(16)));
typedef unsigned u32x2 __attribute__((ext_vector_type(2)));
typedef unsigned u32x4 __attribute__((ext_vector_type(4)));

constexpr int NT = 32768, SEQ = 4096, DM = 1024, DFF = 2816, DIN = 1280, NLAYER = 4;
constexpr float LOG2E = 1.4426950408889634f;
constexpr int NWAVES = 8, NTHREADS = 512;
constexpr int LDS_BYTES = 147456;
constexpr size_t MiB = 1u << 20;
constexpr size_t W_GU1 = 0, W_D1 = W_GU1 + (size_t)5632 * 1024 * 2, W_IN = W_D1 + (size_t)1024 * 2816 * 2, W_GLU = W_IN + (size_t)1280 * 1024 * 2,
                 W_OA = W_GLU + (size_t)512 * 512 * 2, W_OS = W_OA + (size_t)1024 * 512 * 2, W_GU2 = W_OS + (size_t)1024 * 512 * 2,
                 W_D2 = W_GU2 + (size_t)5632 * 1024 * 2, W_LAYER = W_D2 + (size_t)1024 * 2816 * 2;
static_assert(W_LAYER == 38 * MiB, "weights per layer");
constexpr size_t WS_W = 0, WS_XB = 152 * MiB, WS_BIG = 216 * MiB, WS_H = WS_BIG, WS_PROJ = WS_BIG, WS_AN = WS_BIG + 80 * MiB, WS_Z = WS_BIG + 112 * MiB, WS_S = WS_BIG + 144 * MiB,
                 WS_VT = 392 * MiB, WS_YSCR = 400 * MiB, WS_SEGE = 464 * MiB, WS_SSQ = 466 * MiB, WS_SSQ2 = 468 * MiB, WS_ABAR = 469 * MiB, WS_APOW = WS_ABAR + 256 * 1024,
                 WS_BB = 470 * MiB, WS_CC = 471 * MiB, WS_CTL = 472 * MiB, CTL_BYTES = 16384, WS_END = 473 * MiB;

struct Args { const float* in[27]; float* out; unsigned char* ws; };

__device__ __forceinline__ unsigned f2bf(float f) { unsigned u = __builtin_bit_cast(unsigned, f); return (u + 0x7fffu + ((u >> 16) & 1u)) >> 16; }
typedef __bf16 bf16x2_t __attribute__((ext_vector_type(2)));
__device__ __forceinline__ unsigned pk2(float lo, float hi) { const f32x2 v = {lo, hi}; return __builtin_bit_cast(unsigned, __builtin_convertvector(v, bf16x2_t)); }
__device__ __forceinline__ float bflo(unsigned w) { return __uint_as_float(w << 16); }
__device__ __forceinline__ float bfhi(unsigned w) { return __uint_as_float(w & 0xffff0000u); }
__device__ __forceinline__ float bf2f(bf16 v) { return __uint_as_float((unsigned)v << 16); }
#define LDS_FENCE() asm volatile("s_waitcnt lgkmcnt(0)" ::: "memory")
__device__ __forceinline__ float wave_sum(float v) {
#pragma unroll
    for (int o = 1; o < 64; o <<= 1) v += __shfl_xor(v, o);
    return v;
}
__device__ __forceinline__ int crow(int r, int hi) { return (r & 3) + 8 * (r >> 2) + 4 * hi; }

__device__ __forceinline__ void tr_item(const float* W, int ldw, int K, bf16* WT, int k0, int n0, int drow0, const float* gain, float cs, LAS float* scr, int lane) {
#pragma unroll 8
    for (int i = 0; i < 32; ++i) { const int kk = 2 * i + (lane >> 5); float v = W[(size_t)(k0 + kk) * ldw + n0 + (lane & 31)] * cs; if (gain) v *= gain[k0 + kk]; scr[kk * 33 + (lane & 31)] = v; }
    LDS_FENCE();
    const int c = lane & 7;
#pragma unroll
    for (int j = 0; j < 4; ++j) { const int n = (lane >> 3) + 8 * j; const LAS float* s = scr + (8 * c) * 33 + n;
        u32x4 o; o.x = pk2(s[0 * 33], s[1 * 33]); o.y = pk2(s[2 * 33], s[3 * 33]); o.z = pk2(s[4 * 33], s[5 * 33]); o.w = pk2(s[6 * 33], s[7 * 33]);
        *(u32x4*)(WT + (size_t)(drow0 + n) * K + k0 + 8 * c) = o; }
    LDS_FENCE();
}
__device__ __forceinline__ void sincos_rr(float th, float& s, float& c) {
    const float k = rintf(th * 0.6366197723675814f);
    float r = fmaf(-k, 1.5707963705062866f, th); r = fmaf(-k, -4.371138828673793e-8f, r);
    const float r2 = r * r;
    const float sp = r + r * r2 * (-1.6666667e-1f + r2 * (8.3333333e-3f + r2 * (-1.9841270e-4f + r2 * 2.7557319e-6f)));
    const float cp = 1.0f + r2 * (-0.5f + r2 * (4.1666667e-2f + r2 * (-1.3888889e-3f + r2 * 2.4801587e-5f)));
    const int q = ((int)k) & 3;
    s = (q == 0) ? sp : (q == 1) ? cp : (q == 2) ? -sp : -cp;
    c = (q == 0) ? cp : (q == 1) ? -sp : (q == 2) ? -cp : sp;
}
__device__ __forceinline__ void prologue(const Args& a, LAS unsigned char* lds, int G) {
    int tid_ = threadIdx.x; asm volatile("" : "+v"(tid_));
    const int tid = tid_, lane = tid & 63, wave = __builtin_amdgcn_readfirstlane(tid >> 6);
    LAS float* scr = (LAS float*)(lds + wave * 16384);
    const int gw = blockIdx.x * NWAVES + wave, NGW = G * NWAVES;
    constexpr int I_GU = 16 * 88, I_D = 44 * 32, I_IN = 16 * 40, I_GLU = 8 * 16, I_O = 8 * 32;
    constexpr int C1 = I_GU, C2 = C1 + I_GU, C3 = C2 + I_D, C4 = C3 + I_IN, C5 = C4 + I_GLU, C6 = C5 + I_O, C7 = C6 + I_O, C8 = C7 + I_GU, C9 = C8 + I_GU, C10 = C9 + I_D;
    for (int it = gw; it < NLAYER * C10; it += NGW) {
        const int l = it / C10; int r = it % C10;
        unsigned char* wl = a.ws + WS_W + (size_t)l * W_LAYER;
        const float* W; int ldw, K, nblk; bf16* WT; const float* gain = nullptr; int mode = 0;
        if (r < C1)       { W = a.in[3] + (size_t)l * 1024 * 2816; ldw = 2816; K = 1024; nblk = 88; WT = (bf16*)(wl + W_GU1); gain = a.in[2] + l * 1024; mode = 1; }
        else if (r < C2)  { r -= C1; W = a.in[4] + (size_t)l * 1024 * 2816; ldw = 2816; K = 1024; nblk = 88; WT = (bf16*)(wl + W_GU1); gain = a.in[2] + l * 1024; mode = 2; }
        else if (r < C3)  { r -= C2; W = a.in[5] + (size_t)l * 2816 * 1024; ldw = 1024; K = 2816; nblk = 32; WT = (bf16*)(wl + W_D1); }
        else if (r < C4)  { r -= C3; W = a.in[7] + (size_t)l * 1024 * 1280; ldw = 1280; K = 1024; nblk = 40; WT = (bf16*)(wl + W_IN); gain = a.in[6] + l * 1024; mode = 3; }
        else if (r < C5)  { r -= C4; W = a.in[17] + (size_t)l * 512 * 512; ldw = 512; K = 512; nblk = 16; WT = (bf16*)(wl + W_GLU); }
        else if (r < C6)  { r -= C5; W = a.in[21] + (size_t)l * 1024 * 1024; ldw = 1024; K = 512; nblk = 32; WT = (bf16*)(wl + W_OA); gain = a.in[19] + l * 512; }
        else if (r < C7)  { r -= C6; W = a.in[21] + (size_t)l * 1024 * 1024 + (size_t)512 * 1024; ldw = 1024; K = 512; nblk = 32; WT = (bf16*)(wl + W_OS); gain = a.in[20] + l * 512; }
        else if (r < C8)  { r -= C7; W = a.in[23] + (size_t)l * 1024 * 2816; ldw = 2816; K = 1024; nblk = 88; WT = (bf16*)(wl + W_GU2); gain = a.in[22] + l * 1024; mode = 1; }
        else if (r < C9)  { r -= C8; W = a.in[24] + (size_t)l * 1024 * 2816; ldw = 2816; K = 1024; nblk = 88; WT = (bf16*)(wl + W_GU2); gain = a.in[22] + l * 1024; mode = 2; }
        else              { r -= C9; W = a.in[25] + (size_t)l * 2816 * 1024; ldw = 1024; K = 2816; nblk = 32; WT = (bf16*)(wl + W_D2); }
        const int kb = r / nblk, nb = r % nblk, k0 = 64 * kb, n0 = 32 * nb;
        int drow0 = n0; float cs = 1.0f;
        if (mode == 1) drow0 = 256 * (n0 >> 7) + (n0 & 127);
        else if (mode == 2) drow0 = 256 * (n0 >> 7) + 128 + (n0 & 127);
        else if (mode == 3 && n0 < 512) cs = 0.125f * LOG2E;
        tr_item(W, ldw, K, WT, k0, n0, drow0, gain, cs, scr, lane);
    }
    {
        const float* x = a.in[0]; float* xo = a.out; bf16* xb = (bf16*)(a.ws + WS_XB); float* ssq = (float*)(a.ws + WS_SSQ);
        for (int m = gw; m < NT; m += NGW) {
            const f32x4* xr = (const f32x4*)(x + (size_t)m * DM) + lane; f32x4* orow = (f32x4*)(xo + (size_t)m * DM) + lane; u32x2* brow = (u32x2*)(xb + (size_t)m * DM) + lane;
            float s = 0.f;
#pragma unroll
            for (int j = 0; j < 4; ++j) { const f32x4 v = xr[64 * j]; orow[64 * j] = v; u32x2 w; w.x = pk2(v[0], v[1]); w.y = pk2(v[2], v[3]); brow[64 * j] = w; s += (v[0] * v[0] + v[1] * v[1]) + (v[2] * v[2] + v[3] * v[3]); }
            s = wave_sum(s);
            if (lane < 16) ssq[((size_t)(lane >> 2) * NT + m) * 4 + (lane & 3)] = (lane == 0) ? s : 0.f;
        }
    }
    {
        f32x2* AB = (f32x2*)(a.ws + WS_ABAR); f32x2* AP = (f32x2*)(a.ws + WS_APOW); bf16* BB = (bf16*)(a.ws + WS_BB); bf16* CC = (bf16*)(a.ws + WS_CC);
        for (int cb = gw; cb < NLAYER * 2 * 32; cb += NGW) {
            const int p = lane;
            const float dt = __expf(a.in[11][cb]);
            const float are = a.in[9][cb * 64 + p], aim = a.in[10][cb * 64 + p];
            const float mag = __expf(dt * are); float sn, cs; sincos_rr(dt * aim, sn, cs);
            const float abr = mag * cs, abi = mag * sn;
            const float den = are * are + aim * aim, nr = abr - 1.0f, ni = abi;
            const float kr = (nr * are + ni * aim) / den, ki = (ni * are - nr * aim) / den;
            AB[cb * 64 + p] = (f32x2){abr, abi};
            float pr = abr, pi = abi;
#pragma unroll
            for (int q = 0; q < 9; ++q) { const float t0 = pr * pr - pi * pi, t1 = 2.0f * pr * pi; pr = t0; pi = t1; }
            AP[cb * 64 + p] = (f32x2){pr, pi};
            scr[2 * p] = kr; scr[2 * p + 1] = ki;
            LDS_FENCE();
            const float* bre = a.in[12] + (size_t)cb * 64 * 16; const float* bim = a.in[13] + (size_t)cb * 64 * 16;
            const float* cre = a.in[14] + (size_t)cb * 16 * 64; const float* cim = a.in[15] + (size_t)cb * 16 * 64;
#pragma unroll
            for (int tile = 0; tile < 4; ++tile) {
                const int pp = 32 * (tile & 1) + (lane & 31); const float kr2 = scr[2 * pp], ki2 = scr[2 * pp + 1];
                unsigned w[4];
#pragma unroll
                for (int j2 = 0; j2 < 4; ++j2) { float v[2];
#pragma unroll
                    for (int e = 0; e < 2; ++e) { const int h = 8 * (lane >> 5) + 2 * j2 + e; const float br = bre[pp * 16 + h], bi = bim[pp * 16 + h];
                        v[e] = (tile >> 1) ? (kr2 * bi + ki2 * br) : (kr2 * br - ki2 * bi); }
                    w[j2] = pk2(v[0], v[1]); }
                *(u32x4*)(BB + ((size_t)(cb * 4 + tile) * 64 + lane) * 8) = (u32x4){w[0], w[1], w[2], w[3]};
            }
#pragma unroll
            for (int kk = 0; kk < 4; ++kk) {
                unsigned w[4];
#pragma unroll
                for (int j2 = 0; j2 < 4; ++j2) { const int kap = 32 * kk + 8 * (lane >> 4) + 2 * j2, pp = kap >> 1, h = lane & 15;
                    w[j2] = pk2(cre[h * 64 + pp], -cim[h * 64 + pp]); }
                *(u32x4*)(CC + ((size_t)(cb * 4 + kk) * 64 + lane) * 8) = (u32x4){w[0], w[1], w[2], w[3]};
            }
            LDS_FENCE();
        }
    }
}

__device__ __forceinline__ void attn_phase(const Args& a, LAS unsigned char* lds, int layer, int G) {
    int tid_ = threadIdx.x; asm volatile("" : "+v"(tid_));
    const int tid = tid_, lane = tid & 63, h = __builtin_amdgcn_readfirstlane(tid >> 6), kvh = h >> 2;
    LAS float* biasT = (LAS float*)lds;
    LAS float* red = (LAS float*)(lds + 10240);
    const float* tab = a.in[1];
    for (int e = tid; e < 8 * 320; e += NTHREADS) {
        const int hh = e / 320, ri = e % 320 - 32; float v = -1e30f;
        if (ri >= 0 && ri <= 256) { const int rel = ri - 128, n = rel < 0 ? -rel : rel; int bk = (rel > 0) ? 16 : 0;
            if (n < 8) bk += n; else { int lg = 2 + (31 - __builtin_clz((unsigned)(n * n))); bk += (lg < 15 ? lg : 15); }
            v = tab[bk * 8 + hh] * LOG2E; }
        biasT[e] = v;
    }
    __syncthreads();
    const bf16* proj = (const bf16*)(a.ws + WS_PROJ); const bf16* vT = (const bf16*)(a.ws + WS_VT); bf16* an = (bf16*)(a.ws + WS_AN);
    const float sinkv = a.in[8][layer * 8 + h] * LOG2E;
    const int ql = lane & 31, hi = lane >> 5;
    int par = 0;
    for (int ui = blockIdx.x; ui < 1024; ui += G, par ^= 1) {
        const int b = ui >> 7, q0 = (ui & 127) * 32, rowq = b * SEQ + q0;
        const bf16* qp = proj + (size_t)(rowq + ql) * DIN + h * 64 + 8 * hi;
        bf16x8 qf[4];
#pragma unroll
        for (int kk = 0; kk < 4; ++kk) qf[kk] = *(const bf16x8*)(qp + 16 * kk);
        float m = sinkv, lsum = 1.0f;
        f32x16 o0, o1;
#pragma unroll
        for (int r = 0; r < 16; ++r) { o0[r] = 0.f; o1[r] = 0.f; }
        const bf16* vbase = vT + ((size_t)(b * 2 + kvh) * 64 + ql) * SEQ + 4 * hi;
        for (int kt = 0; kt < 9; ++kt) {
            const int key0 = q0 - 128 + 32 * kt;
            if (key0 < 0 || key0 >= SEQ) continue;
            const bf16* kp = proj + (size_t)(b * SEQ + key0 + ql) * DIN + 512 + kvh * 64 + 8 * hi;
            bf16x8 kf[4];
#pragma unroll
            for (int kk = 0; kk < 4; ++kk) kf[kk] = *(const bf16x8*)(kp + 16 * kk);
            s16x4 vf[2][2][2];
#pragma unroll
            for (int dt = 0; dt < 2; ++dt)
#pragma unroll
                for (int s = 0; s < 2; ++s) { const bf16* vp = vbase + (size_t)(32 * dt) * SEQ + key0 + 16 * s; vf[dt][s][0] = *(const s16x4*)vp; vf[dt][s][1] = *(const s16x4*)(vp + 8); }
            f32x16 st;
#pragma unroll
            for (int r = 0; r < 16; ++r) st[r] = 0.f;
#pragma unroll
            for (int kk = 0; kk < 4; ++kk) st = __builtin_amdgcn_mfma_f32_32x32x16_bf16(kf[kk], qf[kk], st, 0, 0, 0);
            const LAS float* bt = biasT + h * 320 + 32 * kt + 32 - ql + 4 * hi;
            float tmax = -3.0e38f;
#pragma unroll
            for (int r = 0; r < 16; ++r) { st[r] += bt[(r & 3) + 8 * (r >> 2)]; tmax = fmaxf(tmax, st[r]); }
            tmax = fmaxf(tmax, __shfl_xor(tmax, 32));
            const float mnew = fmaxf(m, tmax), alpha = __builtin_amdgcn_exp2f(m - mnew); m = mnew;
            float ps = 0.f;
#pragma unroll
            for (int r = 0; r < 16; ++r) { st[r] = __builtin_amdgcn_exp2f(st[r] - mnew); ps += st[r]; }
            ps += __shfl_xor(ps, 32); lsum = lsum * alpha + ps;
#pragma unroll
            for (int r = 0; r < 16; ++r) { o0[r] *= alpha; o1[r] *= alpha; }
            bf16x8 pf[2];
#pragma unroll
            for (int s = 0; s < 2; ++s) { u32x4 w; w.x = pk2(st[8 * s + 0], st[8 * s + 1]); w.y = pk2(st[8 * s + 2], st[8 * s + 3]); w.z = pk2(st[8 * s + 4], st[8 * s + 5]); w.w = pk2(st[8 * s + 6], st[8 * s + 7]);
                pf[s] = __builtin_bit_cast(bf16x8, w); }
#pragma unroll
            for (int s = 0; s < 2; ++s) {
                bf16x8 v0 = __builtin_shufflevector(vf[0][s][0], vf[0][s][1], 0, 1, 2, 3, 4, 5, 6, 7);
                bf16x8 v1 = __builtin_shufflevector(vf[1][s][0], vf[1][s][1], 0, 1, 2, 3, 4, 5, 6, 7);
                o0 = __builtin_amdgcn_mfma_f32_32x32x16_bf16(v0, pf[s], o0, 0, 0, 0);
                o1 = __builtin_amdgcn_mfma_f32_32x32x16_bf16(v1, pf[s], o1, 0, 0, 0);
            }
        }
        const float inv = 1.0f / lsum;
        float ss = 0.f;
#pragma unroll
        for (int r = 0; r < 16; ++r) { o0[r] *= inv; o1[r] *= inv; ss += o0[r] * o0[r] + o1[r] * o1[r]; }
        ss += __shfl_xor(ss, 32);
        LAS float* rd = red + par * 256;
        if (hi == 0) rd[h * 32 + ql] = ss;
        __syncthreads();
        float tot = 0.f;
#pragma unroll
        for (int hh = 0; hh < 8; ++hh) tot += rd[hh * 32 + ql];
        const float rstd = __builtin_amdgcn_rsqf(tot * (1.0f / 512.0f) + 1e-6f);
        bf16* op = an + (size_t)(rowq + ql) * 512 + h * 64 + 4 * hi;
#pragma unroll
        for (int g4 = 0; g4 < 4; ++g4) {
            u32x2 w0, w1;
            w0.x = pk2(o0[4 * g4] * rstd, o0[4 * g4 + 1] * rstd); w0.y = pk2(o0[4 * g4 + 2] * rstd, o0[4 * g4 + 3] * rstd);
            w1.x = pk2(o1[4 * g4] * rstd, o1[4 * g4 + 1] * rstd); w1.y = pk2(o1[4 * g4 + 2] * rstd, o1[4 * g4 + 3] * rstd);
            *(u32x2*)(op + 8 * g4) = w0; *(u32x2*)(op + 32 + 8 * g4) = w1;
        }
    }
}

constexpr int XS_STRIDE = 68;
template <bool BWD, int MODE  >
__device__ __forceinline__ void ssm_pass(const bf16* proj, int rowbase, int g, const bf16x8* BBp, const bf16x8* CCp, float ar, float ai, float& sr, float& si,
                                         LAS unsigned* XS, int lane, f32x4* ysc, const float* Dp, bf16* zbuf) {
    bf16x8 bb[4], cc[4];
#pragma unroll
    for (int t = 0; t < 4; ++t) { bb[t] = BBp[t * 64 + lane]; if (MODE > 0) cc[t] = CCp[t * 64 + lane]; }
    const int ql = lane & 31, hi = lane >> 5;
    const bf16* up = proj + (size_t)(rowbase + ql) * DIN + 768 + g * 16 + 8 * hi;
    bf16x8 ucur = *(const bf16x8*)(up + (size_t)(BWD ? 15 : 0) * 32 * DIN);
    float dval = 0.f; if (MODE == 2) dval = Dp[g * 16 + (lane & 15)];
    for (int c = 0; c < 16; ++c) {
        const int ch = BWD ? 15 - c : c;
        bf16x8 unext = ucur;
        if (c < 15) unext = *(const bf16x8*)(up + (size_t)(BWD ? ch - 1 : ch + 1) * 32 * DIN);
        f32x16 z16;
#pragma unroll
        for (int r = 0; r < 16; ++r) z16[r] = 0.f;
        const f32x16 x0 = __builtin_amdgcn_mfma_f32_32x32x16_bf16(ucur, bb[0], z16, 0, 0, 0);
        const f32x16 x1 = __builtin_amdgcn_mfma_f32_32x32x16_bf16(ucur, bb[1], z16, 0, 0, 0);
        const f32x16 x2 = __builtin_amdgcn_mfma_f32_32x32x16_bf16(ucur, bb[2], z16, 0, 0, 0);
        const f32x16 x3 = __builtin_amdgcn_mfma_f32_32x32x16_bf16(ucur, bb[3], z16, 0, 0, 0);
#pragma unroll
        for (int r = 0; r < 16; ++r) { const int t = crow(r, hi); XS[t * XS_STRIDE + ql] = pk2(x0[r], x2[r]); XS[t * XS_STRIDE + 32 + ql] = pk2(x1[r], x3[r]); }
        LDS_FENCE();
#pragma unroll
        for (int tt = 0; tt < 32; ++tt) {
            const int t = BWD ? 31 - tt : tt;
            const unsigned v = XS[t * XS_STRIDE + lane];
            const float nr = fmaf(ar, sr, fmaf(-ai, si, bflo(v))), ni = fmaf(ar, si, fmaf(ai, sr, bfhi(v)));
            sr = nr; si = ni;
            if (MODE > 0) XS[t * XS_STRIDE + lane] = pk2(sr, si);
        }
        if (MODE > 0) {
            LDS_FENCE();
            f32x4 y0 = (f32x4){0.f, 0.f, 0.f, 0.f}, y1 = y0;
            if (MODE == 2) { y0 = ysc[(ch * 2 + 0) * 64 + lane]; y1 = ysc[(ch * 2 + 1) * 64 + lane]; }
            const LAS unsigned char* ab = (const LAS unsigned char*)XS + (lane & 15) * (XS_STRIDE * 4) + (lane >> 4) * 16;
#pragma unroll
            for (int kk = 0; kk < 4; ++kk) {
                const bf16x8 a0 = *(const LAS bf16x8*)(ab + kk * 64), a1 = *(const LAS bf16x8*)(ab + 16 * XS_STRIDE * 4 + kk * 64);
                y0 = __builtin_amdgcn_mfma_f32_16x16x32_bf16(a0, cc[kk], y0, 0, 0, 0);
                y1 = __builtin_amdgcn_mfma_f32_16x16x32_bf16(a1, cc[kk], y1, 0, 0, 0);
            }
            if (MODE == 1) { ysc[(ch * 2 + 0) * 64 + lane] = y0; ysc[(ch * 2 + 1) * 64 + lane] = y1; }
            else {
                const int hcol = g * 16 + (lane & 15);
#pragma unroll
                for (int rt = 0; rt < 2; ++rt)
#pragma unroll
                    for (int i = 0; i < 4; ++i) {
                        const int row = rowbase + 32 * ch + 16 * rt + 4 * (lane >> 4) + i;
                        const float uv = bf2f(proj[(size_t)row * DIN + 768 + hcol]);
                        const float y = (rt ? y1[i] : y0[i]) + dval * uv;
                        const float zz = y * __builtin_amdgcn_rcpf(1.0f + __builtin_amdgcn_exp2f(-2.3022082f * (y + 0.044715f * y * y * y)));
                        zbuf[(size_t)row * 512 + hcol] = (bf16)f2bf(zz);
                    }
            }
            LDS_FENCE();
        }
        ucur = unext;
    }
}

__device__ __forceinline__ void ssm_p1(const Args& a, LAS unsigned char* lds, int layer, int G) {
    int tid_ = threadIdx.x; asm volatile("" : "+v"(tid_));
    const int tid = tid_, lane = tid & 63, wave = __builtin_amdgcn_readfirstlane(tid >> 6);
    LAS unsigned* XS = (LAS unsigned*)(lds + 16384 + wave * (32 * XS_STRIDE * 4));
    const bf16* proj = (const bf16*)(a.ws + WS_PROJ);
    const f32x2* AB = (const f32x2*)(a.ws + WS_ABAR); f32x2* SE = (f32x2*)(a.ws + WS_SEGE);
    const int gw = blockIdx.x * NWAVES + wave, NGW = G * NWAVES;
    for (int wt = gw; wt < 4096; wt += NGW) {
        const int dir = wt & 1, seg = (wt >> 1) & 7, g = (wt >> 4) & 31, b = wt >> 9;
        const int cb = (layer * 2 + dir) * 32 + g;
        const f32x2 ab = AB[cb * 64 + lane];
        float sr = 0.f, si = 0.f;
        const bf16x8* BBp = (const bf16x8*)(a.ws + WS_BB) + (size_t)cb * 4 * 64;
        const int rowbase = b * SEQ + seg * 512;
        if (dir) ssm_pass<true, 0>(proj, rowbase, g, BBp, nullptr, ab[0], ab[1], sr, si, XS, lane, nullptr, nullptr, nullptr);
        else     ssm_pass<false, 0>(proj, rowbase, g, BBp, nullptr, ab[0], ab[1], sr, si, XS, lane, nullptr, nullptr, nullptr);
        SE[((size_t)((b * 32 + g) * 2 + dir) * 8 + seg) * 64 + lane] = (f32x2){sr, si};
    }
}
__device__ __forceinline__ void ssm_p3(const Args& a, LAS unsigned char* lds, int layer, int G) {
    int tid_ = threadIdx.x; asm volatile("" : "+v"(tid_));
    const int tid = tid_, lane = tid & 63, wave = __builtin_amdgcn_readfirstlane(tid >> 6);
    LAS unsigned* XS = (LAS unsigned*)(lds + 16384 + wave * (32 * XS_STRIDE * 4));
    const bf16* proj = (const bf16*)(a.ws + WS_PROJ); bf16* zbuf = (bf16*)(a.ws + WS_Z);
    const f32x2* AB = (const f32x2*)(a.ws + WS_ABAR); const f32x2* AP = (const f32x2*)(a.ws + WS_APOW); const f32x2* SE = (const f32x2*)(a.ws + WS_SEGE);
    const int gw = blockIdx.x * NWAVES + wave, NGW = G * NWAVES;
    (void)gw; (void)NGW;
    for (int wg = blockIdx.x; wg < 256; wg += G) {
        const int wt = wg * 8 + wave, g = (wg & 3) * 8 + wave, seg = (wg >> 2) & 7, b = wg >> 5;
        const int rowbase = b * SEQ + seg * 512;
        f32x4* ysc = (f32x4*)(a.ws + WS_YSCR) + (size_t)wt * (16 * 2 * 64);
        {
            const int cb = (layer * 2 + 1) * 32 + g;
            const f32x2 ab = AB[cb * 64 + lane], ap = AP[cb * 64 + lane];
            const f32x2* se = SE + ((size_t)((b * 32 + g) * 2 + 1) * 8) * 64 + lane;
            float sr = 0.f, si = 0.f;
            for (int k = 7; k > seg && !DIAG_NOCARRY; --k) { const f32x2 e = se[k * 64]; const float nr = ap[0] * sr - ap[1] * si + e[0], ni = ap[0] * si + ap[1] * sr + e[1]; sr = nr; si = ni; }
            ssm_pass<true, 1>(proj, rowbase, g, (const bf16x8*)(a.ws + WS_BB) + (size_t)cb * 256, (const bf16x8*)(a.ws + WS_CC) + (size_t)cb * 256, ab[0], ab[1], sr, si, XS, lane, ysc, nullptr, nullptr);
        }
        {
            const int cb = (layer * 2 + 0) * 32 + g;
            const f32x2 ab = AB[cb * 64 + lane], ap = AP[cb * 64 + lane];
            const f32x2* se = SE + ((size_t)((b * 32 + g) * 2 + 0) * 8) * 64 + lane;
            float sr = 0.f, si = 0.f;
            for (int k = 0; k < seg && !DIAG_NOCARRY; ++k) { const f32x2 e = se[k * 64]; const float nr = ap[0] * sr - ap[1] * si + e[0], ni = ap[0] * si + ap[1] * sr + e[1]; sr = nr; si = ni; }
            ssm_pass<false, 2>(proj, rowbase, g, (const bf16x8*)(a.ws + WS_BB) + (size_t)cb * 256, (const bf16x8*)(a.ws + WS_CC) + (size_t)cb * 256, ab[0], ab[1], sr, si, XS, lane, ysc, a.in[16] + layer * 512, zbuf);
        }
    }
}

__device__ __forceinline__ void final_norm(const Args& a, int G) {
    int tid_ = threadIdx.x; asm volatile("" : "+v"(tid_));
    const int tid = tid_, lane = tid & 63, wave = __builtin_amdgcn_readfirstlane(tid >> 6);
    const int gw = blockIdx.x * NWAVES + wave, NGW = G * NWAVES;
    const float* ssq = (const float*)(a.ws + WS_SSQ); const f32x4* gn = (const f32x4*)a.in[26] + lane;
    f32x4 gv[4];
#pragma unroll
    for (int j = 0; j < 4; ++j) gv[j] = gn[64 * j];
    for (int m = gw; m < NT; m += NGW) {
        float s = (lane < 16) ? ssq[((size_t)(lane >> 2) * NT + m) * 4 + (lane & 3)] : 0.f; s = wave_sum(s);
        const float rs = __builtin_amdgcn_rsqf(s * (1.0f / 1024.0f) + 1e-6f);
        f32x4* orow = (f32x4*)(a.out + (size_t)m * DM) + lane;
#pragma unroll
        for (int j = 0; j < 4; ++j) { const f32x4 v = orow[64 * j]; orow[64 * j] = v * rs * gv[j]; }
    }
}

#define XB_TMO      128
#define XB_XCNT(j)  (256  + 64 * (j))
#define XB_XSUB(j)  (1280 + 64 * (j))
#define XB_XGEN(j)  (2304 + 64 * (j))
#define XB_TOP      3328
#define XB_TOPGEN   3392
#define XCD_BAR_WORDS 3456
#define XB_SPIN_CAP (1u << 18)

__device__ __forceinline__ unsigned xb_ld(unsigned* p)              { return __hip_atomic_load(p, __ATOMIC_RELAXED, __HIP_MEMORY_SCOPE_AGENT); }
__device__ __forceinline__ unsigned xb_add(unsigned* p, unsigned v) { return __hip_atomic_fetch_add(p, v, __ATOMIC_RELAXED, __HIP_MEMORY_SCOPE_AGENT); }
__device__ __forceinline__ unsigned xb_xcc_id() { return (unsigned)__builtin_amdgcn_s_getreg((3 << 11) | 20) & 0xFu; }
#define XB_SPIN(cond, bar) do { unsigned _sp = 0; while (cond) { __builtin_amdgcn_s_sleep(1); \
    if ((++_sp & 255u) == 0u) { if (xb_ld(&(bar)[XB_TMO])) break; if (_sp > XB_SPIN_CAP) { atomicAdd(&(bar)[XB_TMO], 1u); break; } } } } while (0)

struct XcdBarrier {
    unsigned* bar; unsigned x;
    volatile LAS unsigned* st;
};

__device__ __forceinline__ XcdBarrier xcd_barrier_post(unsigned* bar, volatile LAS unsigned* st) {
    XcdBarrier b; b.bar = bar; b.x = xb_xcc_id(); b.st = st;
    if (threadIdx.x == 0) (void)xb_add(&bar[XB_XCNT(b.x)], 1u);
    return b;
}
__device__ __forceinline__ void xcd_barrier_complete(unsigned* bar, unsigned x, unsigned& nloc, unsigned& nx) {
    const unsigned G = gridDim.x * gridDim.y * gridDim.z;
    unsigned sum, cnt, mine, sp = 0u;
    for (;;) {
        sum = 0u; cnt = 0u; mine = 0u;
#pragma unroll
        for (unsigned j = 0; j < 16; ++j) { const unsigned c = xb_ld(&bar[XB_XCNT(j)]); sum += c; cnt += (c > 0u) ? 1u : 0u; mine = (j == x) ? c : mine; }
        if (sum == G) break;
        __builtin_amdgcn_s_sleep(1);
        if ((++sp & 255u) == 0u) { if (xb_ld(&bar[XB_TMO])) break; if (sp > XB_SPIN_CAP) { atomicAdd(&bar[XB_TMO], 1u); break; } }
    }
    nloc = mine > 0u ? mine : 1u; nx = cnt > 0u ? cnt : 1u;
}

__device__ __forceinline__ void xcd_barrier(const XcdBarrier& b) {
    asm volatile("s_waitcnt vmcnt(0)" ::: "memory");
    __syncthreads();
    if (threadIdx.x == 0) {
        unsigned* bar = b.bar;
        __builtin_amdgcn_s_waitcnt(0);
        unsigned nloc = b.st[0], nx = b.st[1];
        if (nloc == 0u) { xcd_barrier_complete(bar, b.x, nloc, nx); b.st[0] = nloc; b.st[1] = nx; }
        const unsigned old = xb_add(&bar[XB_XSUB(b.x)], 1u);
        const unsigned gen = old / nloc;
        if (old + 1u == (gen + 1u) * nloc) {
            __builtin_amdgcn_fence(__ATOMIC_RELEASE, "agent");
            asm volatile("s_waitcnt vmcnt(0)" ::: "memory");
            const unsigned og = xb_add(&bar[XB_TOP], 1u);
            const unsigned tg = og / nx;
            if (og + 1u == (tg + 1u) * nx) xb_add(&bar[XB_TOPGEN], 1u);
            else XB_SPIN(xb_ld(&bar[XB_TOPGEN]) == tg, bar);
            __builtin_amdgcn_fence(__ATOMIC_ACQUIRE, "agent");
            xb_add(&bar[XB_XGEN(b.x)], 1u);
            asm volatile("s_waitcnt vmcnt(0)" ::: "memory");
        } else {
            XB_SPIN(xb_ld(&bar[XB_XGEN(b.x)]) == gen, bar);
            __builtin_amdgcn_fence(__ATOMIC_ACQUIRE, "agent");
            asm volatile("s_waitcnt vmcnt(0)" ::: "memory");
        }
    }
    __syncthreads();
}

#define GRID_SYNC() xcd_barrier(xbar)
__global__ void __launch_bounds__(NTHREADS, 2) hymba_fwd(Args a) {
    extern __shared__ __attribute__((aligned(16))) unsigned char lds_raw[];
    LAS unsigned char* lds = (LAS unsigned char*)lds_raw;
    cg::grid_group grid = cg::this_grid();
    const int G = gridDim.x, bid = blockIdx.x;
    volatile LAS unsigned* misc = (volatile LAS unsigned*)(lds + LDS_BYTES - 64);
    if (threadIdx.x < 16) misc[threadIdx.x] = 0u;
    __syncthreads();
    const XcdBarrier xbar = xcd_barrier_post((unsigned*)(a.ws + WS_CTL), misc);
    grid.sync();
    unsigned char* ws = a.ws;
    float* xf = a.out; pg8::bf16_t* xb = (pg8::bf16_t*)(ws + WS_XB);
    float* ssq = (float*)(ws + WS_SSQ); float* ssq2 = (float*)(ws + WS_SSQ2);
    pg8::bf16_t* Hb = (pg8::bf16_t*)(ws + WS_H); pg8::bf16_t* projb = (pg8::bf16_t*)(ws + WS_PROJ); pg8::bf16_t* vTb = (pg8::bf16_t*)(ws + WS_VT);
    pg8::bf16_t* anb = (pg8::bf16_t*)(ws + WS_AN); pg8::bf16_t* zb = (pg8::bf16_t*)(ws + WS_Z); pg8::bf16_t* sb = (pg8::bf16_t*)(ws + WS_S);

    prologue(a, lds, G);
    GRID_SYNC();
    for (int st = 0; st < 2 * NLAYER; ++st) {
        const int layer = st >> 1, second = st & 1;
        const unsigned char* wl = ws + WS_W + (size_t)layer * W_LAYER;
        {
            pg8::Gemm g{xb, (const pg8::bf16_t*)(wl + (second ? W_GU2 : W_GU1)), NT, 2 * DFF, DM}; pg8::StaticOrder S; S.init(NT, 2 * DFF, G, bid);
            pg8::EpiSwiGLU E{Hb, ssq};
            for (int rep = 0; rep < 1 + DUP_G1; ++rep) {
            pg8::gemm_phase<pg8::EpiSwiGLU, pg8::StaticOrder, true, true>(lds, g, S, E);
            GRID_SYNC(); }
            pg8::Gemm g2{Hb, (const pg8::bf16_t*)(wl + (second ? W_D2 : W_D1)), NT, DM, DFF}; pg8::StaticOrder S2; S2.init(NT, DM, G, bid);
            pg8::EpiResid<false, true> E2{xf, xb, ssq, nullptr, 0.5f};
            pg8::gemm_phase<pg8::EpiResid<false, true>, pg8::StaticOrder, true, true>(lds, g2, S2, E2);
            GRID_SYNC();
        }
        if (!second && DIAG_MIXER) {
            {
                pg8::Gemm g{xb, (const pg8::bf16_t*)(wl + W_IN), NT, DIN, DM}; pg8::StaticOrder S; S.init(NT, DIN, G, bid);
                pg8::EpiProj E{projb, vTb, ssq};
                pg8::gemm_phase<pg8::EpiProj, pg8::StaticOrder, true, true>(lds, g, S, E);
                GRID_SYNC();
            }
            for (int rep = 0; rep < 1 + DUP_MIX; ++rep) {
            if (DUP_MIX != 3) attn_phase(a, lds, layer, G);
            if (DUP_MIX != 2) ssm_p1(a, lds, layer, G);
            GRID_SYNC();
            if (DUP_MIX != 2) ssm_p3(a, lds, layer, G);
            GRID_SYNC();
            }
            if (DIAG_MIXER != 2) {
                pg8::Gemm g{zb, (const pg8::bf16_t*)(wl + W_GLU), NT, 512, 512}; pg8::StaticOrder S; S.init(NT, 512, G, bid);
                pg8::EpiGlu E{zb, sb, a.in[18] + layer * 512, ssq2};
                pg8::gemm_phase<pg8::EpiGlu, pg8::StaticOrder, true, true>(lds, g, S, E);
                GRID_SYNC();
            }
            {
                pg8::Gemm g{anb, (const pg8::bf16_t*)(wl + W_OA), NT, DM, 512}; pg8::StaticOrder S; S.init(NT, DM, G, bid);
                if (DIAG_MIXER == 1) { pg8::EpiResid<false, false> E{xf, xb, ssq, nullptr, 1.0f};
                pg8::gemm_phase<pg8::EpiResid<false, false>, pg8::StaticOrder, true, true>(lds, g, S, E); }
                if (DIAG_MIXER == 2) { pg8::EpiResid<false, true> E{xf, xb, ssq, nullptr, 1.0f};
                pg8::gemm_phase<pg8::EpiResid<false, true>, pg8::StaticOrder, true, true>(lds, g, S, E); }
                if (DIAG_MIXER != 2) { pg8::Gemm g2{sb, (const pg8::bf16_t*)(wl + W_OS), NT, DM, 512};
                pg8::EpiResid<true, true> E2{xf, xb, ssq, ssq2, 1.0f};
                pg8::gemm_phase<pg8::EpiResid<true, true>, pg8::StaticOrder, true, true>(lds, g2, S, E2); }
                GRID_SYNC();
            }
        }
    }
    final_norm(a, G);
}

extern "C" void kernel_launch(void* const* d_in, const int* in_sizes, int n_in, void* d_out, int out_size, void* d_ws, size_t ws_size, hipStream_t stream) {
    static int grid = 0;
    if (grid == 0) {
        if (n_in != 27 || out_size != NT * DM || ws_size < WS_END) { fprintf(stderr, "kernel_launch: unexpected shapes: n_in %d out %d ws %zu (need %zu)\n", n_in, out_size, ws_size, (size_t)WS_END); grid = -1; return; }
        int dev = 0, cus = 0, per_cu = 0;
        hipGetDevice(&dev); hipDeviceGetAttribute(&cus, hipDeviceAttributeMultiprocessorCount, dev);
        hipFuncSetAttribute((const void*)hymba_fwd, hipFuncAttributeMaxDynamicSharedMemorySize, LDS_BYTES);
        hipOccupancyMaxActiveBlocksPerMultiprocessor(&per_cu, (const void*)hymba_fwd, NTHREADS, LDS_BYTES);
        if (per_cu < 1) { fprintf(stderr, "kernel_launch: occupancy query says %d blocks per CU\n", per_cu); per_cu = 1; }
        (void)hipGetLastError();
        grid = cus * per_cu;
        fprintf(stderr, "kernel_launch: grid %d (%d CUs x %d)\n", grid, cus, per_cu);
    }
    if (grid < 0) return;
    if (hipMemsetAsync((char*)d_ws + WS_CTL, 0, CTL_BYTES, stream) != hipSuccess) { fprintf(stderr, "kernel_launch: memset of the barrier words failed\n"); return; }
    Args a{};
    for (int i = 0; i < 27; ++i) a.in[i] = (const float*)d_in[i];
    a.out = (float*)d_out; a.ws = (unsigned char*)d_ws;
    void* args[] = {&a};
    hipError_t e = hipLaunchCooperativeKernel((const void*)hymba_fwd, dim3(grid), dim3(NTHREADS), args, LDS_BYTES, stream);
    if (e != hipSuccess) fprintf(stderr, "cooperative launch failed: %s (grid %d)\n", hipGetErrorString(e), grid);
}
```

```cpp
#include <hip/hip_runtime.h>
#include <hip/hip_cooperative_groups.h>
#include <cstdio>
#include <cstdint>
namespace cg = cooperative_groups;
namespace pg8 {
#define PG8_LAS __attribute__((address_space(3)))
typedef unsigned short bf16_t;
typedef short bf16x8 __attribute__((ext_vector_type(8)));
typedef float f32x4 __attribute__((ext_vector_type(4)));
typedef unsigned u32x4 __attribute__((ext_vector_type(4)));
constexpr int BM = 256, BK = 64, HALF = 128, HTB = HALF * BK * 2  , STAGE_BYTES = 8 * HTB, NXCD = 8, WGM = 8;

__host__ __device__ __forceinline__ int lds_byte(int r, int c) { const int st = (r >> 4) * 2 + (c >> 5), rr = r & 15, cc = c & 31, ob = rr * 64 + cc * 2; return st * 1024 + (ob ^ (((ob >> 9) & 1) << 5)); }
__host__ __device__ __forceinline__ void stage_rc(int b, int& R, int& C) { const int st = b / 1024, sb = b % 1024, swz = sb ^ (((sb >> 9) & 1) << 5); R = (st >> 1) * 16 + swz / 64; C = (st & 1) * 32 + (swz % 64) / 2; }
__host__ __device__ __forceinline__ int perm32(int rho) { const int n = rho >> 4, i = rho & 15; return 8 * (i >> 2) + 4 * n + (i & 3); }

struct Unit { int pm, pn; };
struct Gemm { const bf16_t* A; const bf16_t* Bt; int M, N, K; };

struct StaticOrder {
    int nM, nN, nwg, G, c;
    __host__ __device__ void init(int M, int N, int G_, int c_) { nM = M / BM; nN = N / BM; nwg = nM * nN; G = G_; c = c_; }
    __host__ __device__ bool next(int i, Unit& u) const {
        const long L = (long)i * G + c; if (L >= nwg) return false;
        int wgid = (int)L; { const int q = nwg / NXCD, r = nwg % NXCD, xcd = wgid % NXCD, off = wgid / NXCD; wgid = (xcd < r ? xcd * (q + 1) : r * (q + 1) + (xcd - r) * q) + off; }
        const int nig = WGM * nN, gid = wgid / nig, fm = gid * WGM, gsz = (nM - fm) < WGM ? (nM - fm) : WGM;
        u.pm = fm + ((wgid % nig) % gsz); u.pn = (wgid % nig) / gsz; return true;
    }
    __device__ __forceinline__ void a_ready(const Unit&) const {}
    __device__ __forceinline__ void done(const Unit&) const {}
};

typedef float f32x2 __attribute__((ext_vector_type(2)));
typedef __bf16 bf16x2_t __attribute__((ext_vector_type(2)));
__device__ __forceinline__ unsigned cvt_pk_bf16(float lo, float hi) { const f32x2 v = {lo, hi}; return __builtin_bit_cast(unsigned, __builtin_convertvector(v, bf16x2_t)); }
typedef unsigned u32x2 __attribute__((ext_vector_type(2)));
constexpr float RMS_EPS = 1e-6f;
__device__ __forceinline__ float bf_lo(unsigned w) { return __uint_as_float(w << 16); }
__device__ __forceinline__ float bf_hi(unsigned w) { return __uint_as_float(w & 0xffff0000u); }
__device__ __forceinline__ float fast_sigmoid(float v) { return __builtin_amdgcn_rcpf(1.0f + __builtin_amdgcn_exp2f(-1.4426950408889634f * v)); }
__device__ __forceinline__ float row_rstd16(const float* ssq, int row, int fq) {
    const f32x4 v = *(const f32x4*)(ssq + ((size_t)fq * 32768 + row) * 4);
    float s = (v[0] + v[1]) + (v[2] + v[3]);
    s += __shfl_xor(s, 16); s += __shfl_xor(s, 32);
    return __builtin_amdgcn_rsqf(s * (1.0f / 1024.0f) + RMS_EPS);
}
__device__ __forceinline__ float row_rstd8(const float* ssq2, int row, int fq) {
    const f32x2 v = *(const f32x2*)(ssq2 + ((size_t)(fq & 1) * 32768 + row) * 4 + 2 * (fq >> 1));
    float s = v[0] + v[1];
    s += __shfl_xor(s, 16); s += __shfl_xor(s, 32);
    return __builtin_amdgcn_rsqf(s * (1.0f / 512.0f) + RMS_EPS);
}

struct EpiSwiGLU {
    static constexpr bool PERM = true, AFTER_DRAIN = false, MIDK = false;
    bf16_t* H; const float* ssq;
    __device__ __forceinline__ void operator()(const f32x4 (&acc)[2][2][4][2], const Unit& u, int wr, int wc, int fr, int fq) const {
        const int row0 = u.pm * BM + wr * 64 + fr, hc = u.pn * 128 + wc * 32 + 8 * fq;
        float rsv[8];
#pragma unroll
        for (int i = 0; i < 8; ++i) rsv[i] = row_rstd16(ssq, row0 + (i >> 2) * HALF + (i & 3) * 16, fq);
#pragma unroll
        for (int ai = 0; ai < 2; ++ai)
#pragma unroll
            for (int m = 0; m < 4; ++m) {
                const int row = row0 + ai * HALF + m * 16;
                const float rs = rsv[ai * 4 + m];
                float o[8];
#pragma unroll
                for (int n = 0; n < 2; ++n)
#pragma unroll
                    for (int j = 0; j < 4; ++j) { const float g = acc[ai][0][m][n][j] * rs, up = acc[ai][1][m][n][j] * rs; o[4 * n + j] = g * fast_sigmoid(g) * up; }
                u32x4 w; w.x = cvt_pk_bf16(o[0], o[1]); w.y = cvt_pk_bf16(o[2], o[3]); w.z = cvt_pk_bf16(o[4], o[5]); w.w = cvt_pk_bf16(o[6], o[7]);
                *(u32x4*)(H + (size_t)row * 2816 + hc) = w;
            }
    }
};

template <bool ROWSCALE, bool FINAL, bool MIDK_ = false> struct EpiResid {
    static constexpr bool PERM = false, AFTER_DRAIN = false, MIDK = MIDK_;
    float* x; bf16_t* xb; float* ssq; const float* ssq2; float scale;
    __device__ __forceinline__ void mid(f32x4 (&acc)[2][2][4][2], const Unit& u, int wr, int wc, int fr, int fq) const {
        const int row0 = u.pm * BM + wr * 64 + fr;
#pragma unroll
        for (int ai = 0; ai < 2; ++ai) {
            float iv[4];
#pragma unroll
            for (int m = 0; m < 4; ++m) iv[m] = 1.0f / row_rstd8(ssq2, row0 + ai * HALF + m * 16, fq);
#pragma unroll
            for (int m = 0; m < 4; ++m)
#pragma unroll
                for (int bj = 0; bj < 2; ++bj)
#pragma unroll
                    for (int n = 0; n < 2; ++n) acc[ai][bj][m][n] *= iv[m];
            asm volatile("" ::: "memory");
        }
    }
    __device__ __forceinline__ void operator()(const f32x4 (&acc)[2][2][4][2], const Unit& u, int wr, int wc, int fr, int fq) const {
        const int row0 = u.pm * BM + wr * 64 + fr, col0 = u.pn * BM + wc * 32 + 4 * fq;
        float scv[8];
#pragma unroll
        for (int i = 0; i < 8; ++i) scv[i] = ROWSCALE ? row_rstd8(ssq2, row0 + (i >> 2) * HALF + (i & 3) * 16, fq) : scale;
#pragma unroll
        for (int ai = 0; ai < 2; ++ai) {
            f32x4 xv[4][2][2];
#pragma unroll
            for (int m = 0; m < 4; ++m)
#pragma unroll
                for (int bj = 0; bj < 2; ++bj)
#pragma unroll
                    for (int n = 0; n < 2; ++n) xv[m][bj][n] = *(const f32x4*)(x + (size_t)(row0 + ai * HALF + m * 16) * 1024 + col0 + bj * HALF + n * 16);
#pragma unroll
            for (int m = 0; m < 4; ++m) {
                const int row = row0 + ai * HALF + m * 16;
                const float sc = scv[ai * 4 + m];
                float ss = 0.f;
#pragma unroll
                for (int bj = 0; bj < 2; ++bj)
#pragma unroll
                    for (int n = 0; n < 2; ++n) {
                        const size_t off = (size_t)row * 1024 + col0 + bj * HALF + n * 16;
                        const f32x4 o = xv[m][bj][n] + acc[ai][bj][m][n] * sc;
                        *(f32x4*)(x + off) = o;
                        if (FINAL) { u32x2 w; w.x = cvt_pk_bf16(o[0], o[1]); w.y = cvt_pk_bf16(o[2], o[3]); *(u32x2*)(xb + off) = w;
                            ss += (o[0] * o[0] + o[1] * o[1]) + (o[2] * o[2] + o[3] * o[3]); }
                    }
                if (FINAL) { ss += __shfl_xor(ss, 16); ss += __shfl_xor(ss, 32); if (fq == 0) ssq[((size_t)u.pn * 32768 + row) * 4 + wc] = ss; }
            }
        }
    }
};

struct EpiProj {
    static constexpr bool PERM = true, AFTER_DRAIN = false, MIDK = false;
    bf16_t* proj; bf16_t* vT; const float* ssq;
    __device__ __forceinline__ void operator()(const f32x4 (&acc)[2][2][4][2], const Unit& u, int wr, int wc, int fr, int fq) const {
        const int row0 = u.pm * BM + wr * 64 + fr;
        float rsv[8];
#pragma unroll
        for (int i = 0; i < 8; ++i) rsv[i] = row_rstd16(ssq, row0 + (i >> 2) * HALF + (i & 3) * 16, fq);
#pragma unroll
        for (int ai = 0; ai < 2; ++ai)
#pragma unroll
            for (int m = 0; m < 4; ++m) {
                const int row = row0 + ai * HALF + m * 16;
                const float rs = rsv[ai * 4 + m];
#pragma unroll
                for (int bj = 0; bj < 2; ++bj) {
                    const f32x4 v0 = acc[ai][bj][m][0] * rs, v1 = acc[ai][bj][m][1] * rs;
                    u32x4 w; w.x = cvt_pk_bf16(v0[0], v0[1]); w.y = cvt_pk_bf16(v0[2], v0[3]); w.z = cvt_pk_bf16(v1[0], v1[1]); w.w = cvt_pk_bf16(v1[2], v1[3]);
                    if (u.pn == 2 && bj == 1) {
                        const int vc = wc * 32 + 8 * fq, b = row >> 12, t = row & 4095;
                        bf16_t* dst = vT + ((size_t)(b * 2 + (vc >> 6)) * 64 + (vc & 63)) * 4096 + t;
                        dst[0 * 4096] = (bf16_t)(w.x & 0xffffu); dst[1 * 4096] = (bf16_t)(w.x >> 16);
                        dst[2 * 4096] = (bf16_t)(w.y & 0xffffu); dst[3 * 4096] = (bf16_t)(w.y >> 16);
                        dst[4 * 4096] = (bf16_t)(w.z & 0xffffu); dst[5 * 4096] = (bf16_t)(w.z >> 16);
                        dst[6 * 4096] = (bf16_t)(w.w & 0xffffu); dst[7 * 4096] = (bf16_t)(w.w >> 16);
                    } else {
                        *(u32x4*)(proj + (size_t)row * 1280 + u.pn * BM + bj * HALF + wc * 32 + 8 * fq) = w;
                    }
                }
            }
    }
};

struct EpiGlu {
    static constexpr bool PERM = true, AFTER_DRAIN = false, MIDK = false;
    const bf16_t* z; bf16_t* s; const float* bglu; float* ssq2;
    __device__ __forceinline__ void operator()(const f32x4 (&acc)[2][2][4][2], const Unit& u, int wr, int wc, int fr, int fq) const {
        const int row0 = u.pm * BM + wr * 64 + fr;
#pragma unroll
        for (int ai = 0; ai < 2; ++ai)
#pragma unroll
            for (int m = 0; m < 4; ++m) {
                const int row = row0 + ai * HALF + m * 16;
                float ss = 0.f;
#pragma unroll
                for (int bj = 0; bj < 2; ++bj) {
                    const int c0 = u.pn * BM + bj * HALF + wc * 32 + 8 * fq;
                    const u32x4 zw = *(const u32x4*)(z + (size_t)row * 512 + c0);
                    const f32x4 b0 = *(const f32x4*)(bglu + c0), b1 = *(const f32x4*)(bglu + c0 + 4);
                    const f32x4 a0 = acc[ai][bj][m][0] + b0, a1 = acc[ai][bj][m][1] + b1;
                    float o[8];
                    o[0] = bf_lo(zw.x) * fast_sigmoid(a0[0]); o[1] = bf_hi(zw.x) * fast_sigmoid(a0[1]);
                    o[2] = bf_lo(zw.y) * fast_sigmoid(a0[2]); o[3] = bf_hi(zw.y) * fast_sigmoid(a0[3]);
                    o[4] = bf_lo(zw.z) * fast_sigmoid(a1[0]); o[5] = bf_hi(zw.z) * fast_sigmoid(a1[1]);
                    o[6] = bf_lo(zw.w) * fast_sigmoid(a1[2]); o[7] = bf_hi(zw.w) * fast_sigmoid(a1[3]);
#pragma unroll
                    for (int j = 0; j < 8; ++j) ss += o[j] * o[j];
                    u32x4 w; w.x = cvt_pk_bf16(o[0], o[1]); w.y = cvt_pk_bf16(o[2], o[3]); w.z = cvt_pk_bf16(o[4], o[5]); w.w = cvt_pk_bf16(o[6], o[7]);
                    *(u32x4*)(s + (size_t)row * 1024 + 512 + c0) = w;
                }
                ss += __shfl_xor(ss, 16); ss += __shfl_xor(ss, 32); if (fq == 0) ssq2[((size_t)u.pn * 32768 + row) * 4 + wc] = ss;
            }
    }
};
template <class Epi, class Sched, bool ALIGN_EPI = false, bool SP2 = false>
__device__ __forceinline__ void gemm_phase(PG8_LAS unsigned char* lds, const Gemm g, const Sched& S, const Epi& E) {
    int tid_ = threadIdx.x; asm volatile("" : "+v"(tid_));
    const int tid = tid_, wid = __builtin_amdgcn_readfirstlane(tid >> 6), lane = tid & 63, wr = wid >> 2, wc = wid & 3, fr = lane & 15, fq = lane >> 4;
    const int K = g.K, nt = K / BK;
    unsigned voffA[2], voffB[2];
#pragma unroll
    for (int i = 0; i < 2; ++i) { int R, C; stage_rc(tid * 16 + i * 8192, R, C); const int Rb = Epi::PERM ? ((R & ~31) + perm32(R & 31)) : R;
        voffA[i] = (unsigned)(R * K + C) * 2u; voffB[i] = (unsigned)(Rb * K + C) * 2u; }
    const size_t kstep = (size_t)(BK * 2);
    const size_t hstep = (size_t)HALF * K * 2;
    const size_t tstep = 2 * hstep;
    const unsigned ldsw = (unsigned)wid * 1024u;
    const int aoff = lds_byte(wr * 64 + fr, fq * 8), boff = lds_byte(wc * 32 + fr, fq * 8);
#define PG8_SA(b, h) (((b) * 2 + (h)) * HTB)
#define PG8_SB(b, h) ((4 + (b) * 2 + (h)) * HTB)
#define PG8_STAGE(bufoff, gbase, voff) do { _Pragma("unroll") for (int _i = 0; _i < 2; ++_i) \
        __builtin_amdgcn_global_load_lds((const unsigned*)((const char*)(gbase) + (voff)[_i]), (PG8_LAS unsigned*)(lds + (bufoff) + ldsw + _i * 8192), 16, 0, 0); } while (0)
#define PG8_LDA(dst, b, h) do { _Pragma("unroll") for (int m = 0; m < 4; ++m) _Pragma("unroll") for (int k = 0; k < 2; ++k) dst[m][k] = *(const PG8_LAS bf16x8*)(lds + PG8_SA(b, h) + aoff + m * 2048 + k * 1024); } while (0)
#define PG8_LDB(dst, b, h) do { _Pragma("unroll") for (int n = 0; n < 2; ++n) _Pragma("unroll") for (int k = 0; k < 2; ++k) dst[n][k] = *(const PG8_LAS bf16x8*)(lds + PG8_SB(b, h) + boff + n * 2048 + k * 1024); } while (0)
#define PG8_MMA(ai, bj, At, Bt) do { __builtin_amdgcn_s_setprio(1); _Pragma("unroll") for (int m = 0; m < 4; ++m) _Pragma("unroll") for (int n = 0; n < 2; ++n) _Pragma("unroll") for (int k = 0; k < 2; ++k) \
        acc[ai][bj][m][n] = __builtin_amdgcn_mfma_f32_16x16x32_bf16(Bt[n][k], At[m][k], acc[ai][bj][m][n], 0, 0, 0); __builtin_amdgcn_s_setprio(0); } while (0)
#define PG8_WAIT_V(n) asm volatile("s_waitcnt vmcnt(" #n ")" ::: "memory")
#define PG8_WAIT_L(n) asm volatile("s_waitcnt lgkmcnt(" #n ")" ::: "memory")
#define PG8_BAR __builtin_amdgcn_s_barrier()
#define PG8_SCHED __builtin_amdgcn_sched_barrier(0)
    Unit cur, nxt; int ui = 0;
    if (!S.next(0, cur)) return;
    f32x4 acc[2][2][4][2];
#pragma unroll
    for (int a = 0; a < 2; ++a)
#pragma unroll
        for (int b = 0; b < 2; ++b)
#pragma unroll
            for (int m = 0; m < 4; ++m)
#pragma unroll
                for (int n = 0; n < 2; ++n) acc[a][b][m][n] = (f32x4){0.f, 0.f, 0.f, 0.f};
    bf16x8 At[4][2], B0[2][2], B1[2][2];
    const char* cA = (const char*)g.A + (size_t)cur.pm * tstep; const char* cB = (const char*)g.Bt + (size_t)cur.pn * tstep;
    S.a_ready(cur);
    if constexpr (SP2) {
        PG8_STAGE(PG8_SB(0, 0), cB, voffB); PG8_STAGE(PG8_SB(0, 1), cB + hstep, voffB); PG8_STAGE(PG8_SA(0, 0), cA, voffA); PG8_STAGE(PG8_SA(0, 1), cA + hstep, voffA);
        if (wr == 1) PG8_BAR;
        PG8_WAIT_V(2); PG8_BAR;
        PG8_STAGE(PG8_SB(1, 0), cB + kstep, voffB); PG8_STAGE(PG8_SA(1, 0), cA + kstep, voffA); PG8_STAGE(PG8_SB(1, 1), cB + hstep + kstep, voffB);
        PG8_WAIT_V(6); PG8_BAR;
    } else {
        PG8_STAGE(PG8_SB(0, 0), cB, voffB); PG8_STAGE(PG8_SA(0, 0), cA, voffA); PG8_STAGE(PG8_SB(0, 1), cB + hstep, voffB); PG8_STAGE(PG8_SA(0, 1), cA + hstep, voffA);
        if (wr == 1) PG8_BAR;
        PG8_WAIT_V(4); PG8_BAR;
        PG8_STAGE(PG8_SB(1, 0), cB + kstep, voffB); PG8_STAGE(PG8_SA(1, 0), cA + kstep, voffA); PG8_STAGE(PG8_SB(1, 1), cB + hstep + kstep, voffB);
        PG8_WAIT_V(6); PG8_BAR;
    }
    for (;;) {
        const bool has_next = S.next(ui + 1, nxt);
        const char* nA = has_next ? (const char*)g.A + (size_t)nxt.pm * tstep : cA; const char* nB = has_next ? (const char*)g.Bt + (size_t)nxt.pn * tstep : cB;
        for (int t = 0; t < nt; t += 2) {
            const bool last = (t == nt - 2);
            const char* a1 = cA + (size_t)(t + 1) * kstep;
            const char* a2 = last ? nA : cA + (size_t)(t + 2) * kstep; const char* b2 = last ? nB : cB + (size_t)(t + 2) * kstep;
            const char* a3 = a2 + kstep; const char* b3 = b2 + kstep;
            if (last && has_next) S.a_ready(nxt);
            if constexpr (Epi::MIDK) { if (t == (nt >> 1)) E.mid(acc, cur, wr, wc, fr, fq); }
            if constexpr (SP2) {
            PG8_LDB(B0, 0, 0); PG8_LDB(B1, 0, 1); PG8_SCHED; PG8_LDA(At, 0, 0); PG8_STAGE(PG8_SA(1, 1), a1 + hstep, voffA);
            PG8_WAIT_V(8); PG8_WAIT_L(0); PG8_BAR; PG8_MMA(0, 0, At, B0); PG8_MMA(0, 1, At, B1); PG8_BAR; PG8_SCHED;
            PG8_LDA(At, 0, 1); PG8_STAGE(PG8_SB(0, 0), b2, voffB); PG8_STAGE(PG8_SB(0, 1), b2 + hstep, voffB); PG8_STAGE(PG8_SA(0, 0), a2, voffA);
            PG8_WAIT_V(8); PG8_WAIT_L(0); PG8_BAR; PG8_MMA(1, 0, At, B0); PG8_MMA(1, 1, At, B1); PG8_BAR; PG8_SCHED;
            PG8_LDB(B0, 1, 0); PG8_LDB(B1, 1, 1); PG8_SCHED; PG8_LDA(At, 1, 0); PG8_STAGE(PG8_SA(0, 1), a2 + hstep, voffA);
            PG8_WAIT_V(8); PG8_WAIT_L(0); PG8_BAR; PG8_MMA(0, 0, At, B0); PG8_MMA(0, 1, At, B1); PG8_BAR; PG8_SCHED;
            PG8_LDA(At, 1, 1); PG8_STAGE(PG8_SB(1, 0), b3, voffB); PG8_STAGE(PG8_SB(1, 1), b3 + hstep, voffB); PG8_STAGE(PG8_SA(1, 0), a3, voffA);
            PG8_WAIT_V(8); PG8_WAIT_L(0); PG8_BAR; PG8_MMA(1, 0, At, B0); PG8_MMA(1, 1, At, B1); PG8_BAR; PG8_SCHED;
            } else {
            PG8_LDB(B0, 0, 0); PG8_SCHED; PG8_LDA(At, 0, 0); PG8_STAGE(PG8_SA(1, 1), a1 + hstep, voffA);
            PG8_WAIT_L(8); PG8_BAR; PG8_WAIT_L(0); PG8_MMA(0, 0, At, B0); PG8_BAR; PG8_SCHED;
            PG8_LDB(B1, 0, 1); PG8_STAGE(PG8_SB(0, 0), b2, voffB);
            PG8_BAR; PG8_WAIT_L(0); PG8_MMA(0, 1, At, B1); PG8_BAR;
            PG8_LDA(At, 0, 1); PG8_STAGE(PG8_SA(0, 0), a2, voffA);
            PG8_BAR; PG8_WAIT_L(0); PG8_MMA(1, 0, At, B0); PG8_BAR; PG8_SCHED;
            PG8_STAGE(PG8_SB(0, 1), b2 + hstep, voffB);
            PG8_WAIT_V(6); PG8_BAR; PG8_MMA(1, 1, At, B1); PG8_BAR;
            PG8_LDB(B0, 1, 0); PG8_SCHED; PG8_LDA(At, 1, 0); PG8_STAGE(PG8_SA(0, 1), a2 + hstep, voffA);
            PG8_WAIT_L(8); PG8_BAR; PG8_WAIT_L(0); PG8_MMA(0, 0, At, B0); PG8_BAR; PG8_SCHED;
            PG8_LDB(B1, 1, 1); PG8_STAGE(PG8_SB(1, 0), b3, voffB);
            PG8_BAR; PG8_WAIT_L(0); PG8_MMA(0, 1, At, B1); PG8_BAR;
            PG8_LDA(At, 1, 1); PG8_STAGE(PG8_SA(1, 0), a3, voffA);
            PG8_BAR; PG8_WAIT_L(0); PG8_MMA(1, 0, At, B0); PG8_BAR; PG8_SCHED;
            PG8_STAGE(PG8_SB(1, 1), b3 + hstep, voffB);
            PG8_WAIT_V(6); PG8_BAR; PG8_MMA(1, 1, At, B1); PG8_BAR;
            }
        }
        if constexpr (ALIGN_EPI) { if (wr == 0) PG8_BAR; }
        if constexpr (!Epi::AFTER_DRAIN) { E(acc, cur, wr, wc, fr, fq); S.done(cur); }
        if (!has_next) break;
#pragma unroll
        for (int a = 0; a < 2; ++a)
#pragma unroll
            for (int b = 0; b < 2; ++b)
#pragma unroll
                for (int m = 0; m < 4; ++m)
#pragma unroll
                    for (int n = 0; n < 2; ++n) acc[a][b][m][n] = (f32x4){0.f, 0.f, 0.f, 0.f};
        cur = nxt; cA = nA; cB = nB; ++ui;
        if constexpr (ALIGN_EPI) { if (wr == 1) PG8_BAR; }
    }
    PG8_WAIT_V(0);
    if constexpr (!ALIGN_EPI) { if (wr == 0) PG8_BAR; }
    PG8_BAR;
    if constexpr (Epi::AFTER_DRAIN) { E.fused(acc, cur, wr, wc, fr, fq, lds, wid, lane); S.done(cur); }
#undef PG8_SA
#undef PG8_SB
#undef PG8_STAGE
#undef PG8_LDA
#undef PG8_LDB
#undef PG8_MMA
#undef PG8_WAIT_V
#undef PG8_WAIT_L
#undef PG8_BAR
#undef PG8_SCHED
}
}

#ifndef DIAG_NOCARRY
#define DIAG_NOCARRY 0
#endif
#ifndef N_ATT
#define N_ATT 1
#endif
#ifndef N_P1
#define N_P1 1
#endif
#ifndef N_P3
#define N_P3 1
#endif
#ifndef DUP_G1
#define DUP_G1 0
#endif
#ifndef DIAG_MIXER
#define DIAG_MIXER 1
#endif
#define LAS __attribute__((address_space(3)))
typedef unsigned short bf16;
typedef short bf16x8 __attribute__((ext_vector_type(8)));
typedef short s16x4 __attribute__((ext_vector_type(4)));
typedef float f32x2 __attribute__((ext_vector_type(2)));
typedef float f32x4 __attribute__((ext_vector_type(4)));
typedef float f32x16 __attribute__((ext_vector_type(16)));
typedef unsigned u32x2 __attribute__((ext_vector_type(2)));
typedef unsigned u32x4 __attribute__((ext_vector_type(4)));

constexpr int NT = 32768, SEQ = 4096, DM = 1024, DFF = 2816, DIN = 1280, NLAYER = 4;
constexpr float LOG2E = 1.4426950408889634f;
constexpr int NWAVES = 8, NTHREADS = 512;
constexpr int LDS_BYTES = 147456;
constexpr size_t MiB = 1u << 20;
constexpr size_t W_GU1 = 0, W_D1 = W_GU1 + (size_t)5632 * 1024 * 2, W_IN = W_D1 + (size_t)1024 * 2816 * 2, W_GLU = W_IN + (size_t)1280 * 1024 * 2,
                 W_OA = W_GLU + (size_t)512 * 512 * 2, W_OS = W_OA + (size_t)1024 * 512 * 2, W_GU2 = W_OS + (size_t)1024 * 512 * 2,
                 W_D2 = W_GU2 + (size_t)5632 * 1024 * 2, W_LAYER = W_D2 + (size_t)1024 * 2816 * 2;
static_assert(W_LAYER == 38 * MiB, "weights per layer");
constexpr size_t WS_W = 0, WS_XB = 152 * MiB, WS_BIG = 216 * MiB, WS_H = WS_BIG, WS_PROJ = WS_BIG, WS_MIX = WS_BIG + 80 * MiB, WS_Z = WS_BIG + 144 * MiB,
                 WS_VT = 392 * MiB, WS_YSCR = 400 * MiB, WS_SEGE = 464 * MiB, WS_SSQ = 466 * MiB, WS_SSQ2 = 468 * MiB, WS_ABAR = 469 * MiB, WS_APOW = WS_ABAR + 256 * 1024,
                 WS_BB = 470 * MiB, WS_CC = 471 * MiB, WS_CTL = 472 * MiB, CTL_BYTES = 16384, WS_END = 473 * MiB;

struct Args { const float* in[27]; float* out; unsigned char* ws; };
__device__ __forceinline__ const float* inptr(int k) {
    typedef const float* cfp;
    const __attribute__((address_space(4))) char* kp = (const __attribute__((address_space(4))) char*)__builtin_amdgcn_kernarg_segment_ptr();
    int off = k * 8; asm volatile("" : "+s"(off));
    return *(const __attribute__((address_space(4))) cfp*)(kp + off);
}
#define INP(k) inptr(k)
__device__ __forceinline__ unsigned char* kptr(int off0) {
    typedef unsigned char* ucp;
    const __attribute__((address_space(4))) char* kp = (const __attribute__((address_space(4))) char*)__builtin_amdgcn_kernarg_segment_ptr();
    int off = off0; asm volatile("" : "+s"(off));
    return *(const __attribute__((address_space(4))) ucp*)(kp + off);
}
#define WSPTR() kptr(224)
#define OUTPTR() ((float*)kptr(216))

__device__ __forceinline__ unsigned f2bf(float f) { unsigned u = __builtin_bit_cast(unsigned, f); return (u + 0x7fffu + ((u >> 16) & 1u)) >> 16; }
typedef __bf16 bf16x2_t __attribute__((ext_vector_type(2)));
__device__ __forceinline__ unsigned pk2(float lo, float hi) { const f32x2 v = {lo, hi}; return __builtin_bit_cast(unsigned, __builtin_convertvector(v, bf16x2_t)); }
__device__ __forceinline__ float bflo(unsigned w) { return __uint_as_float(w << 16); }
__device__ __forceinline__ float bfhi(unsigned w) { return __uint_as_float(w & 0xffff0000u); }
__device__ __forceinline__ float bf2f(bf16 v) { return __uint_as_float((unsigned)v << 16); }
#define LDS_FENCE() asm volatile("s_waitcnt lgkmcnt(0)" ::: "memory")
__device__ __forceinline__ float wave_sum(float v) {
#pragma unroll
    for (int o = 1; o < 64; o <<= 1) v += __shfl_xor(v, o);
    return v;
}
__device__ __forceinline__ int crow(int r, int hi) { return (r & 3) + 8 * (r >> 2) + 4 * hi; }

__device__ __forceinline__ void tr_item(const float* W, int ldw, int K, bf16* WT, int k0, int n0, int drow0, const float* gain, float cs, LAS float* scr, int lane) {
#pragma unroll 8
    for (int i = 0; i < 32; ++i) { const int kk = 2 * i + (lane >> 5); float v = W[(size_t)(k0 + kk) * ldw + n0 + (lane & 31)] * cs; if (gain) v *= gain[k0 + kk]; scr[kk * 33 + (lane & 31)] = v; }
    LDS_FENCE();
    const int c = lane & 7;
#pragma unroll
    for (int j = 0; j < 4; ++j) { const int n = (lane >> 3) + 8 * j; const LAS float* s = scr + (8 * c) * 33 + n;
        u32x4 o; o.x = pk2(s[0 * 33], s[1 * 33]); o.y = pk2(s[2 * 33], s[3 * 33]); o.z = pk2(s[4 * 33], s[5 * 33]); o.w = pk2(s[6 * 33], s[7 * 33]);
        *(u32x4*)(WT + (size_t)(drow0 + n) * K + k0 + 8 * c) = o; }
    LDS_FENCE();
}
__device__ __forceinline__ void sincos_rr(float th, float& s, float& c) {
    const float k = rintf(th * 0.6366197723675814f);
    float r = fmaf(-k, 1.5707963705062866f, th); r = fmaf(-k, -4.371138828673793e-8f, r);
    const float r2 = r * r;
    const float sp = r + r * r2 * (-1.6666667e-1f + r2 * (8.3333333e-3f + r2 * (-1.9841270e-4f + r2 * 2.7557319e-6f)));
    const float cp = 1.0f + r2 * (-0.5f + r2 * (4.1666667e-2f + r2 * (-1.3888889e-3f + r2 * 2.4801587e-5f)));
    const int q = ((int)k) & 3;
    s = (q == 0) ? sp : (q == 1) ? cp : (q == 2) ? -sp : -cp;
    c = (q == 0) ? cp : (q == 1) ? -sp : (q == 2) ? -cp : sp;
}
__device__ __forceinline__ void prologue(const Args& a, LAS unsigned char* lds, int G) {
    int tid_ = threadIdx.x; asm volatile("" : "+v"(tid_));
    const int tid = tid_, lane = tid & 63, wave = __builtin_amdgcn_readfirstlane(tid >> 6);
    LAS float* scr = (LAS float*)(lds + wave * 16384);
    const int gw = blockIdx.x * NWAVES + wave, NGW = G * NWAVES;
    constexpr int I_GU = 16 * 88, I_D = 44 * 32, I_IN = 16 * 40, I_GLU = 8 * 16, I_O = 8 * 32;
    constexpr int C1 = I_GU, C2 = C1 + I_GU, C3 = C2 + I_D, C4 = C3 + I_IN, C5 = C4 + I_GLU, C6 = C5 + I_O, C7 = C6 + I_O, C8 = C7 + I_GU, C9 = C8 + I_GU, C10 = C9 + I_D;
    for (int it = gw; it < NLAYER * C10; it += NGW) {
        const int l = it / C10; int r = it % C10;
        unsigned char* wl = WSPTR() + WS_W + (size_t)l * W_LAYER;
        const float* W; int ldw, K, nblk; bf16* WT; const float* gain = nullptr; int mode = 0;
        if (r < C1)       { W = INP(3) + (size_t)l * 1024 * 2816; ldw = 2816; K = 1024; nblk = 88; WT = (bf16*)(wl + W_GU1); gain = INP(2) + l * 1024; mode = 1; }
        else if (r < C2)  { r -= C1; W = INP(4) + (size_t)l * 1024 * 2816; ldw = 2816; K = 1024; nblk = 88; WT = (bf16*)(wl + W_GU1); gain = INP(2) + l * 1024; mode = 2; }
        else if (r < C3)  { r -= C2; W = INP(5) + (size_t)l * 2816 * 1024; ldw = 1024; K = 2816; nblk = 32; WT = (bf16*)(wl + W_D1); }
        else if (r < C4)  { r -= C3; W = INP(7) + (size_t)l * 1024 * 1280; ldw = 1280; K = 1024; nblk = 40; WT = (bf16*)(wl + W_IN); gain = INP(6) + l * 1024; mode = 3; }
        else if (r < C5)  { r -= C4; W = INP(17) + (size_t)l * 512 * 512; ldw = 512; K = 512; nblk = 16; WT = (bf16*)(wl + W_GLU); }
        else if (r < C6)  { r -= C5; W = INP(21) + (size_t)l * 1024 * 1024; ldw = 1024; K = 1024; nblk = 32; WT = (bf16*)(wl + W_OA); gain = INP(19) + l * 512; }
        else if (r < C7)  { r -= C6; W = INP(21) + (size_t)l * 1024 * 1024 + (size_t)512 * 1024; ldw = 1024; K = 1024; nblk = 32; WT = (bf16*)(wl + W_OA) + 512; gain = INP(20) + l * 512; }
        else if (r < C8)  { r -= C7; W = INP(23) + (size_t)l * 1024 * 2816; ldw = 2816; K = 1024; nblk = 88; WT = (bf16*)(wl + W_GU2); gain = INP(22) + l * 1024; mode = 1; }
        else if (r < C9)  { r -= C8; W = INP(24) + (size_t)l * 1024 * 2816; ldw = 2816; K = 1024; nblk = 88; WT = (bf16*)(wl + W_GU2); gain = INP(22) + l * 1024; mode = 2; }
        else              { r -= C9; W = INP(25) + (size_t)l * 2816 * 1024; ldw = 1024; K = 2816; nblk = 32; WT = (bf16*)(wl + W_D2); }
        const int kb = r / nblk, nb = r % nblk, k0 = 64 * kb, n0 = 32 * nb;
        int drow0 = n0; float cs = 1.0f;
        if (mode == 1) drow0 = 256 * (n0 >> 7) + (n0 & 127);
        else if (mode == 2) drow0 = 256 * (n0 >> 7) + 128 + (n0 & 127);
        else if (mode == 3 && n0 < 512) cs = 0.125f * LOG2E;
        tr_item(W, ldw, K, WT, k0, n0, drow0, gain, cs, scr, lane);
    }
    {
        const float* x = INP(0); float* xo = OUTPTR(); bf16* xb = (bf16*)(WSPTR() + WS_XB); float* ssq = (float*)(WSPTR() + WS_SSQ);
        for (int m = gw; m < NT; m += NGW) {
            const f32x4* xr = (const f32x4*)(x + (size_t)m * DM) + lane; f32x4* orow = (f32x4*)(xo + (size_t)m * DM) + lane; u32x2* brow = (u32x2*)(xb + (size_t)m * DM) + lane;
            float s = 0.f;
#pragma unroll
            for (int j = 0; j < 4; ++j) { const f32x4 v = xr[64 * j]; orow[64 * j] = v; u32x2 w; w.x = pk2(v[0], v[1]); w.y = pk2(v[2], v[3]); brow[64 * j] = w; s += (v[0] * v[0] + v[1] * v[1]) + (v[2] * v[2] + v[3] * v[3]); }
            s = wave_sum(s);
            if (lane < 16) ssq[((size_t)(lane >> 2) * NT + m) * 4 + (lane & 3)] = (lane == 0) ? s : 0.f;
        }
    }
    {
        f32x2* AB = (f32x2*)(WSPTR() + WS_ABAR); f32x2* AP = (f32x2*)(WSPTR() + WS_APOW); bf16* BB = (bf16*)(WSPTR() + WS_BB); bf16* CC = (bf16*)(WSPTR() + WS_CC);
        for (int cb = gw; cb < NLAYER * 2 * 32; cb += NGW) {
            const int p = lane;
            const float dt = __expf(INP(11)[cb]);
            const float are = INP(9)[cb * 64 + p], aim = INP(10)[cb * 64 + p];
            const float mag = __expf(dt * are); float sn, cs; sincos_rr(dt * aim, sn, cs);
            const float abr = mag * cs, abi = mag * sn;
            const float den = are * are + aim * aim, nr = abr - 1.0f, ni = abi;
            const float kr = (nr * are + ni * aim) / den, ki = (ni * are - nr * aim) / den;
            AB[cb * 64 + p] = (f32x2){abr, abi};
            float pr = abr, pi = abi;
#pragma unroll
            for (int q = 0; q < 9; ++q) { const float t0 = pr * pr - pi * pi, t1 = 2.0f * pr * pi; pr = t0; pi = t1; }
            AP[cb * 64 + p] = (f32x2){pr, pi};
            scr[2 * p] = kr; scr[2 * p + 1] = ki;
            LDS_FENCE();
            const float* bre = INP(12) + (size_t)cb * 64 * 16; const float* bim = INP(13) + (size_t)cb * 64 * 16;
            const float* cre = INP(14) + (size_t)cb * 16 * 64; const float* cim = INP(15) + (size_t)cb * 16 * 64;
#pragma unroll
            for (int tile = 0; tile < 4; ++tile) {
                const int pp = 32 * (tile & 1) + (lane & 31); const float kr2 = scr[2 * pp], ki2 = scr[2 * pp + 1];
                unsigned w[4];
#pragma unroll
                for (int j2 = 0; j2 < 4; ++j2) { float v[2];
#pragma unroll
                    for (int e = 0; e < 2; ++e) { const int h = 8 * (lane >> 5) + 2 * j2 + e; const float br = bre[pp * 16 + h], bi = bim[pp * 16 + h];
                        v[e] = (tile >> 1) ? (kr2 * bi + ki2 * br) : (kr2 * br - ki2 * bi); }
                    w[j2] = pk2(v[0], v[1]); }
                *(u32x4*)(BB + ((size_t)(cb * 4 + tile) * 64 + lane) * 8) = (u32x4){w[0], w[1], w[2], w[3]};
            }
#pragma unroll
            for (int kk = 0; kk < 4; ++kk) {
                unsigned w[4];
#pragma unroll
                for (int j2 = 0; j2 < 4; ++j2) { const int kap = 32 * kk + 8 * (lane >> 4) + 2 * j2, pp = kap >> 1, h = lane & 15;
                    w[j2] = pk2(cre[h * 64 + pp], -cim[h * 64 + pp]); }
                *(u32x4*)(CC + ((size_t)(cb * 4 + kk) * 64 + lane) * 8) = (u32x4){w[0], w[1], w[2], w[3]};
            }
            LDS_FENCE();
        }
    }
}

__device__ __forceinline__ void attn_phase(const Args& a, LAS unsigned char* lds, int layer, int G) {
    int tid_ = threadIdx.x; asm volatile("" : "+v"(tid_));
    const int tid = tid_, lane = tid & 63, h = __builtin_amdgcn_readfirstlane(tid >> 6), kvh = h >> 2;
    LAS float* biasT = (LAS float*)lds;
    LAS float* red = (LAS float*)(lds + 10240);
    const float* tab = INP(1);
    for (int e = tid; e < 8 * 320; e += NTHREADS) {
        const int hh = e / 320, ri = e % 320 - 32; float v = -1e30f;
        if (ri >= 0 && ri <= 256) { const int rel = ri - 128, n = rel < 0 ? -rel : rel; int bk = (rel > 0) ? 16 : 0;
            if (n < 8) bk += n; else { int lg = 2 + (31 - __builtin_clz((unsigned)(n * n))); bk += (lg < 15 ? lg : 15); }
            v = tab[bk * 8 + hh] * LOG2E; }
        biasT[e] = v;
    }
    __syncthreads();
    const bf16* proj = (const bf16*)(WSPTR() + WS_PROJ); const bf16* vT = (const bf16*)(WSPTR() + WS_VT); bf16* an = (bf16*)(WSPTR() + WS_MIX); const float* ssq2p = (const float*)(WSPTR() + WS_SSQ2);
    const float sinkv = INP(8)[layer * 8 + h] * LOG2E;
    const int ql = lane & 31, hi = lane >> 5;
    int par = 0;
    for (int ui = blockIdx.x; ui < 1024; ui += G, par ^= 1) {
        const int b = ui >> 7, q0 = (ui & 127) * 32, rowq = b * SEQ + q0;
        const bf16* qp = proj + (size_t)(rowq + ql) * DIN + h * 64 + 8 * hi;
        bf16x8 qf[4];
#pragma unroll
        for (int kk = 0; kk < 4; ++kk) qf[kk] = *(const bf16x8*)(qp + 16 * kk);
        float m = sinkv, lsum = 1.0f;
        f32x16 o0, o1;
#pragma unroll
        for (int r = 0; r < 16; ++r) { o0[r] = 0.f; o1[r] = 0.f; }
        const bf16* vbase = vT + ((size_t)(b * 2 + kvh) * 64 + ql) * SEQ + 4 * hi;
        for (int kt = 0; kt < 9; ++kt) {
            const int key0 = q0 - 128 + 32 * kt;
            if (key0 < 0 || key0 >= SEQ) continue;
            const bf16* kp = proj + (size_t)(b * SEQ + key0 + ql) * DIN + 512 + kvh * 64 + 8 * hi;
            bf16x8 kf[4];
#pragma unroll
            for (int kk = 0; kk < 4; ++kk) kf[kk] = *(const bf16x8*)(kp + 16 * kk);
            s16x4 vf[2][2][2];
#pragma unroll
            for (int dt = 0; dt < 2; ++dt)
#pragma unroll
                for (int s = 0; s < 2; ++s) { const bf16* vp = vbase + (size_t)(32 * dt) * SEQ + key0 + 16 * s; vf[dt][s][0] = *(const s16x4*)vp; vf[dt][s][1] = *(const s16x4*)(vp + 8); }
            f32x16 st;
#pragma unroll
            for (int r = 0; r < 16; ++r) st[r] = 0.f;
#pragma unroll
            for (int kk = 0; kk < 4; ++kk) st = __builtin_amdgcn_mfma_f32_32x32x16_bf16(kf[kk], qf[kk], st, 0, 0, 0);
            const LAS float* bt = biasT + h * 320 + 32 * kt + 32 - ql + 4 * hi;
            float tmax = -3.0e38f;
#pragma unroll
            for (int r = 0; r < 16; ++r) { st[r] += bt[(r & 3) + 8 * (r >> 2)]; tmax = fmaxf(tmax, st[r]); }
            tmax = fmaxf(tmax, __shfl_xor(tmax, 32));
            const float mnew = fmaxf(m, tmax), alpha = __builtin_amdgcn_exp2f(m - mnew); m = mnew;
            float ps = 0.f;
#pragma unroll
            for (int r = 0; r < 16; ++r) { st[r] = __builtin_amdgcn_exp2f(st[r] - mnew); ps += st[r]; }
            ps += __shfl_xor(ps, 32); lsum = lsum * alpha + ps;
#pragma unroll
            for (int r = 0; r < 16; ++r) { o0[r] *= alpha; o1[r] *= alpha; }
            bf16x8 pf[2];
#pragma unroll
            for (int s = 0; s < 2; ++s) { u32x4 w; w.x = pk2(st[8 * s + 0], st[8 * s + 1]); w.y = pk2(st[8 * s + 2], st[8 * s + 3]); w.z = pk2(st[8 * s + 4], st[8 * s + 5]); w.w = pk2(st[8 * s + 6], st[8 * s + 7]);
                pf[s] = __builtin_bit_cast(bf16x8, w); }
#pragma unroll
            for (int s = 0; s < 2; ++s) {
                bf16x8 v0 = __builtin_shufflevector(vf[0][s][0], vf[0][s][1], 0, 1, 2, 3, 4, 5, 6, 7);
                bf16x8 v1 = __builtin_shufflevector(vf[1][s][0], vf[1][s][1], 0, 1, 2, 3, 4, 5, 6, 7);
                o0 = __builtin_amdgcn_mfma_f32_32x32x16_bf16(v0, pf[s], o0, 0, 0, 0);
                o1 = __builtin_amdgcn_mfma_f32_32x32x16_bf16(v1, pf[s], o1, 0, 0, 0);
            }
        }
        const float inv = 1.0f / lsum;
        float ss = 0.f;
#pragma unroll
        for (int r = 0; r < 16; ++r) { o0[r] *= inv; o1[r] *= inv; ss += o0[r] * o0[r] + o1[r] * o1[r]; }
        ss += __shfl_xor(ss, 32);
        LAS float* rd = red + par * 256;
        if (hi == 0) rd[h * 32 + ql] = ss;
        __syncthreads();
        float tot = 0.f;
#pragma unroll
        for (int hh = 0; hh < 8; ++hh) tot += rd[hh * 32 + ql];
        const f32x4 sq = *(const f32x4*)(ssq2p + ((size_t)hi * NT + rowq + ql) * 4);
        float ts = (sq[0] + sq[1]) + (sq[2] + sq[3]); ts += __shfl_xor(ts, 32);
        const float rstd = __builtin_amdgcn_rsqf(tot * (1.0f / 512.0f) + 1e-6f) * __builtin_amdgcn_sqrtf(ts * (1.0f / 512.0f) + 1e-6f);
        bf16* op = an + (size_t)(rowq + ql) * 1024 + h * 64 + 4 * hi;
#pragma unroll
        for (int g4 = 0; g4 < 4; ++g4) {
            u32x2 w0, w1;
            w0.x = pk2(o0[4 * g4] * rstd, o0[4 * g4 + 1] * rstd); w0.y = pk2(o0[4 * g4 + 2] * rstd, o0[4 * g4 + 3] * rstd);
            w1.x = pk2(o1[4 * g4] * rstd, o1[4 * g4 + 1] * rstd); w1.y = pk2(o1[4 * g4 + 2] * rstd, o1[4 * g4 + 3] * rstd);
            *(u32x2*)(op + 8 * g4) = w0; *(u32x2*)(op + 32 + 8 * g4) = w1;
        }
    }
}

constexpr int XS_STRIDE = 68;
template <bool BWD, int MODE  >
__device__ __forceinline__ void ssm_pass(const bf16* proj, int rowbase, int g, const bf16x8* BBp, const bf16x8* CCp, float ar, float ai, float& sr, float& si,
                                         LAS unsigned* XS, int lane, f32x4* ysc, const float* Dp, bf16* zbuf) {
    bf16x8 bb[4], cc[4];
#pragma unroll
    for (int t = 0; t < 4; ++t) { bb[t] = BBp[t * 64 + lane]; if (MODE > 0) cc[t] = CCp[t * 64 + lane]; }
    const int ql = lane & 31, hi = lane >> 5;
    const bf16* up = proj + (size_t)(rowbase + ql) * DIN + 768 + g * 16 + 8 * hi;
    bf16x8 ucur = *(const bf16x8*)(up + (size_t)(BWD ? 15 : 0) * 32 * DIN);
    float dval = 0.f; if (MODE == 2) dval = Dp[g * 16 + (lane & 15)];
    for (int c = 0; c < 16; ++c) {
        const int ch = BWD ? 15 - c : c;
        bf16x8 unext = ucur;
        if (c < 15) unext = *(const bf16x8*)(up + (size_t)(BWD ? ch - 1 : ch + 1) * 32 * DIN);
        f32x16 z16;
#pragma unroll
        for (int r = 0; r < 16; ++r) z16[r] = 0.f;
        const f32x16 x0 = __builtin_amdgcn_mfma_f32_32x32x16_bf16(ucur, bb[0], z16, 0, 0, 0);
        const f32x16 x1 = __builtin_amdgcn_mfma_f32_32x32x16_bf16(ucur, bb[1], z16, 0, 0, 0);
        const f32x16 x2 = __builtin_amdgcn_mfma_f32_32x32x16_bf16(ucur, bb[2], z16, 0, 0, 0);
        const f32x16 x3 = __builtin_amdgcn_mfma_f32_32x32x16_bf16(ucur, bb[3], z16, 0, 0, 0);
#pragma unroll
        for (int r = 0; r < 16; ++r) { const int t = crow(r, hi); XS[t * XS_STRIDE + ql] = pk2(x0[r], x2[r]); XS[t * XS_STRIDE + 32 + ql] = pk2(x1[r], x3[r]); }
        LDS_FENCE();
#pragma unroll
        for (int tt = 0; tt < 32; ++tt) {
            const int t = BWD ? 31 - tt : tt;
            const unsigned v = XS[t * XS_STRIDE + lane];
            const float nr = fmaf(ar, sr, fmaf(-ai, si, bflo(v))), ni = fmaf(ar, si, fmaf(ai, sr, bfhi(v)));
            sr = nr; si = ni;
            if (MODE > 0) XS[t * XS_STRIDE + lane] = pk2(sr, si);
        }
        if (MODE > 0) {
            LDS_FENCE();
            f32x4 y0 = (f32x4){0.f, 0.f, 0.f, 0.f}, y1 = y0;
            if (MODE == 2) { y0 = ysc[(ch * 2 + 0) * 64 + lane]; y1 = ysc[(ch * 2 + 1) * 64 + lane]; }
            const LAS unsigned char* ab = (const LAS unsigned char*)XS + (lane & 15) * (XS_STRIDE * 4) + (lane >> 4) * 16;
#pragma unroll
            for (int kk = 0; kk < 4; ++kk) {
                const bf16x8 a0 = *(const LAS bf16x8*)(ab + kk * 64), a1 = *(const LAS bf16x8*)(ab + 16 * XS_STRIDE * 4 + kk * 64);
                y0 = __builtin_amdgcn_mfma_f32_16x16x32_bf16(a0, cc[kk], y0, 0, 0, 0);
                y1 = __builtin_amdgcn_mfma_f32_16x16x32_bf16(a1, cc[kk], y1, 0, 0, 0);
            }
            if (MODE == 1) { ysc[(ch * 2 + 0) * 64 + lane] = y0; ysc[(ch * 2 + 1) * 64 + lane] = y1; }
            else {
                const int hcol = g * 16 + (lane & 15);
#pragma unroll
                for (int rt = 0; rt < 2; ++rt)
#pragma unroll
                    for (int i = 0; i < 4; ++i) {
                        const int row = rowbase + 32 * ch + 16 * rt + 4 * (lane >> 4) + i;
                        const float uv = bf2f(proj[(size_t)row * DIN + 768 + hcol]);
                        const float y = (rt ? y1[i] : y0[i]) + dval * uv;
                        const float zz = y * __builtin_amdgcn_rcpf(1.0f + __builtin_amdgcn_exp2f(-2.3022082f * (y + 0.044715f * y * y * y)));
                        zbuf[(size_t)row * 512 + hcol] = (bf16)f2bf(zz);
                    }
            }
            LDS_FENCE();
        }
        ucur = unext;
    }
}

__device__ __forceinline__ void ssm_p1(const Args& a, LAS unsigned char* lds, int layer, int G) {
    int tid_ = threadIdx.x; asm volatile("" : "+v"(tid_));
    const int tid = tid_, lane = tid & 63, wave = __builtin_amdgcn_readfirstlane(tid >> 6);
    LAS unsigned* XS = (LAS unsigned*)(lds + 16384 + wave * (32 * XS_STRIDE * 4));
    const bf16* proj = (const bf16*)(WSPTR() + WS_PROJ);
    const f32x2* AB = (const f32x2*)(WSPTR() + WS_ABAR); f32x2* SE = (f32x2*)(WSPTR() + WS_SEGE);
    const int gw = blockIdx.x * NWAVES + wave, NGW = G * NWAVES;
    for (int wt = gw; wt < 4096; wt += NGW) {
        const int dir = wt & 1, seg = (wt >> 1) & 7, g = (wt >> 4) & 31, b = wt >> 9;
        const int cb = (layer * 2 + dir) * 32 + g;
        const f32x2 ab = AB[cb * 64 + lane];
        float sr = 0.f, si = 0.f;
        const bf16x8* BBp = (const bf16x8*)(WSPTR() + WS_BB) + (size_t)cb * 4 * 64;
        const int rowbase = b * SEQ + seg * 512;
        if (dir) ssm_pass<true, 0>(proj, rowbase, g, BBp, nullptr, ab[0], ab[1], sr, si, XS, lane, nullptr, nullptr, nullptr);
        else     ssm_pass<false, 0>(proj, rowbase, g, BBp, nullptr, ab[0], ab[1], sr, si, XS, lane, nullptr, nullptr, nullptr);
        SE[((size_t)((b * 32 + g) * 2 + dir) * 8 + seg) * 64 + lane] = (f32x2){sr, si};
    }
}
__device__ __forceinline__ void ssm_p3(const Args& a, LAS unsigned char* lds, int layer, int G) {
    int tid_ = threadIdx.x; asm volatile("" : "+v"(tid_));
    const int tid = tid_, lane = tid & 63, wave = __builtin_amdgcn_readfirstlane(tid >> 6);
    LAS unsigned* XS = (LAS unsigned*)(lds + 16384 + wave * (32 * XS_STRIDE * 4));
    const bf16* proj = (const bf16*)(WSPTR() + WS_PROJ); bf16* zbuf = (bf16*)(WSPTR() + WS_Z);
    const f32x2* AB = (const f32x2*)(WSPTR() + WS_ABAR); const f32x2* AP = (const f32x2*)(WSPTR() + WS_APOW); const f32x2* SE = (const f32x2*)(WSPTR() + WS_SEGE);
    const int gw = blockIdx.x * NWAVES + wave, NGW = G * NWAVES;
    (void)gw; (void)NGW;
    for (int wg = blockIdx.x; wg < 256; wg += G) {
        const int wt = wg * 8 + wave, g = (wg & 3) * 8 + wave, seg = (wg >> 2) & 7, b = wg >> 5;
        const int rowbase = b * SEQ + seg * 512;
        f32x4* ysc = (f32x4*)(WSPTR() + WS_YSCR) + (size_t)wt * (16 * 2 * 64);
        {
            const int cb = (layer * 2 + 1) * 32 + g;
            const f32x2 ab = AB[cb * 64 + lane], ap = AP[cb * 64 + lane];
            const f32x2* se = SE + ((size_t)((b * 32 + g) * 2 + 1) * 8) * 64 + lane;
            float sr = 0.f, si = 0.f;
            for (int k = 7; k > seg && !DIAG_NOCARRY; --k) { const f32x2 e = se[k * 64]; const float nr = ap[0] * sr - ap[1] * si + e[0], ni = ap[0] * si + ap[1] * sr + e[1]; sr = nr; si = ni; }
            ssm_pass<true, 1>(proj, rowbase, g, (const bf16x8*)(WSPTR() + WS_BB) + (size_t)cb * 256, (const bf16x8*)(WSPTR() + WS_CC) + (size_t)cb * 256, ab[0], ab[1], sr, si, XS, lane, ysc, nullptr, nullptr);
        }
        {
            const int cb = (layer * 2 + 0) * 32 + g;
            const f32x2 ab = AB[cb * 64 + lane], ap = AP[cb * 64 + lane];
            const f32x2* se = SE + ((size_t)((b * 32 + g) * 2 + 0) * 8) * 64 + lane;
            float sr = 0.f, si = 0.f;
            for (int k = 0; k < seg && !DIAG_NOCARRY; ++k) { const f32x2 e = se[k * 64]; const float nr = ap[0] * sr - ap[1] * si + e[0], ni = ap[0] * si + ap[1] * sr + e[1]; sr = nr; si = ni; }
            ssm_pass<false, 2>(proj, rowbase, g, (const bf16x8*)(WSPTR() + WS_BB) + (size_t)cb * 256, (const bf16x8*)(WSPTR() + WS_CC) + (size_t)cb * 256, ab[0], ab[1], sr, si, XS, lane, ysc, INP(16) + layer * 512, zbuf);
        }
    }
}

__device__ __forceinline__ void final_norm(const Args& a, int G) {
    int tid_ = threadIdx.x; asm volatile("" : "+v"(tid_));
    const int tid = tid_, lane = tid & 63, wave = __builtin_amdgcn_readfirstlane(tid >> 6);
    const int gw = blockIdx.x * NWAVES + wave, NGW = G * NWAVES;
    const float* ssq = (const float*)(WSPTR() + WS_SSQ); const f32x4* gn = (const f32x4*)INP(26) + lane;
    f32x4 gv[4];
#pragma unroll
    for (int j = 0; j < 4; ++j) gv[j] = gn[64 * j];
    for (int m = gw; m < NT; m += NGW) {
        float s = (lane < 16) ? ssq[((size_t)(lane >> 2) * NT + m) * 4 + (lane & 3)] : 0.f; s = wave_sum(s);
        const float rs = __builtin_amdgcn_rsqf(s * (1.0f / 1024.0f) + 1e-6f);
        f32x4* orow = (f32x4*)(OUTPTR() + (size_t)m * DM) + lane;
#pragma unroll
        for (int j = 0; j < 4; ++j) { const f32x4 v = orow[64 * j]; orow[64 * j] = v * rs * gv[j]; }
    }
}

#define XB_TMO      128
#define XB_XCNT(j)  (256  + 64 * (j))
#define XB_XSUB(j)  (1280 + 64 * (j))
#define XB_XGEN(j)  (2304 + 64 * (j))
#define XB_TOP      3328
#define XB_TOPGEN   3392
#define XCD_BAR_WORDS 3456
#define XB_SPIN_CAP (1u << 18)

__device__ __forceinline__ unsigned xb_ld(unsigned* p)              { return __hip_atomic_load(p, __ATOMIC_RELAXED, __HIP_MEMORY_SCOPE_AGENT); }
__device__ __forceinline__ unsigned xb_add(unsigned* p, unsigned v) { return __hip_atomic_fetch_add(p, v, __ATOMIC_RELAXED, __HIP_MEMORY_SCOPE_AGENT); }
__device__ __forceinline__ unsigned xb_xcc_id() { return (unsigned)__builtin_amdgcn_s_getreg((3 << 11) | 20) & 0xFu; }
#define XB_SPIN(cond, bar) do { unsigned _sp = 0; while (cond) { __builtin_amdgcn_s_sleep(1); \
    if ((++_sp & 255u) == 0u) { if (xb_ld(&(bar)[XB_TMO])) break; if (_sp > XB_SPIN_CAP) { atomicAdd(&(bar)[XB_TMO], 1u); break; } } } } while (0)

struct XcdBarrier {
    unsigned* bar; unsigned x;
    volatile LAS unsigned* st;
};

__device__ __forceinline__ XcdBarrier xcd_barrier_post(unsigned* bar, volatile LAS unsigned* st) {
    XcdBarrier b; b.bar = bar; b.x = xb_xcc_id(); b.st = st;
    if (threadIdx.x == 0) (void)xb_add(&bar[XB_XCNT(b.x)], 1u);
    return b;
}
__device__ __forceinline__ void xcd_barrier_complete(unsigned* bar, unsigned x, unsigned& nloc, unsigned& nx) {
    const unsigned G = gridDim.x * gridDim.y * gridDim.z;
    unsigned sum, cnt, mine, sp = 0u;
    for (;;) {
        sum = 0u; cnt = 0u; mine = 0u;
#pragma unroll
        for (unsigned j = 0; j < 16; ++j) { const unsigned c = xb_ld(&bar[XB_XCNT(j)]); sum += c; cnt += (c > 0u) ? 1u : 0u; mine = (j == x) ? c : mine; }
        if (sum == G) break;
        __builtin_amdgcn_s_sleep(1);
        if ((++sp & 255u) == 0u) { if (xb_ld(&bar[XB_TMO])) break; if (sp > XB_SPIN_CAP) { atomicAdd(&bar[XB_TMO], 1u); break; } }
    }
    nloc = mine > 0u ? mine : 1u; nx = cnt > 0u ? cnt : 1u;
}

__device__ __forceinline__ void xcd_barrier(const XcdBarrier& b) {
    asm volatile("s_waitcnt vmcnt(0)" ::: "memory");
    __syncthreads();
    if (threadIdx.x == 0) {
        unsigned* bar = b.bar;
        __builtin_amdgcn_s_waitcnt(0);
        unsigned nloc = b.st[0], nx = b.st[1];
        if (nloc == 0u) { xcd_barrier_complete(bar, b.x, nloc, nx); b.st[0] = nloc; b.st[1] = nx; }
        const unsigned old = xb_add(&bar[XB_XSUB(b.x)], 1u);
        const unsigned gen = old / nloc;
        if (old + 1u == (gen + 1u) * nloc) {
            __builtin_amdgcn_fence(__ATOMIC_RELEASE, "agent");
            asm volatile("s_waitcnt vmcnt(0)" ::: "memory");
            const unsigned og = xb_add(&bar[XB_TOP], 1u);
            const unsigned tg = og / nx;
            if (og + 1u == (tg + 1u) * nx) xb_add(&bar[XB_TOPGEN], 1u);
            else XB_SPIN(xb_ld(&bar[XB_TOPGEN]) == tg, bar);
            __builtin_amdgcn_fence(__ATOMIC_ACQUIRE, "agent");
            xb_add(&bar[XB_XGEN(b.x)], 1u);
            asm volatile("s_waitcnt vmcnt(0)" ::: "memory");
        } else {
            XB_SPIN(xb_ld(&bar[XB_XGEN(b.x)]) == gen, bar);
            __builtin_amdgcn_fence(__ATOMIC_ACQUIRE, "agent");
            asm volatile("s_waitcnt vmcnt(0)" ::: "memory");
        }
    }
    __syncthreads();
}

#define GRID_SYNC() do { XcdBarrier xb_; xb_.bar = (unsigned*)(WSPTR() + WS_CTL); xb_.x = xb_xcc_id(); xb_.st = (volatile LAS unsigned*)((LAS unsigned char*)lds_raw + (LDS_BYTES - 64)); xcd_barrier(xb_); } while (0)
__global__ void __launch_bounds__(NTHREADS, 2) hymba_fwd(Args a) {
    extern __shared__ __attribute__((aligned(16))) unsigned char lds_raw[];
    LAS unsigned char* lds = (LAS unsigned char*)lds_raw;
    cg::grid_group grid = cg::this_grid();
    const int G = gridDim.x, bid = blockIdx.x;
    volatile LAS unsigned* misc = (volatile LAS unsigned*)(lds + LDS_BYTES - 64);
    if (threadIdx.x < 16) misc[threadIdx.x] = 0u;
    __syncthreads();
    (void)xcd_barrier_post((unsigned*)(WSPTR() + WS_CTL), misc);
    grid.sync();
#define ws WSPTR()
#define xf OUTPTR()
#define xb ((pg8::bf16_t*)(WSPTR() + WS_XB))
#define ssq ((float*)(WSPTR() + WS_SSQ))
#define ssq2 ((float*)(WSPTR() + WS_SSQ2))
#define Hb ((pg8::bf16_t*)(WSPTR() + WS_H))
#define projb ((pg8::bf16_t*)(WSPTR() + WS_PROJ))
#define vTb ((pg8::bf16_t*)(WSPTR() + WS_VT))
#define mixb ((pg8::bf16_t*)(WSPTR() + WS_MIX))
#define zb ((pg8::bf16_t*)(WSPTR() + WS_Z))

    prologue(a, lds, G);
    GRID_SYNC();
    for (int st = 0; st < 2 * NLAYER; ++st) {
        const int layer = st >> 1, second = st & 1;
        const unsigned char* wl = ws + WS_W + (size_t)layer * W_LAYER;
        {
            pg8::Gemm g{xb, (const pg8::bf16_t*)(wl + (second ? W_GU2 : W_GU1)), NT, 2 * DFF, DM}; pg8::StaticOrder S; S.init(NT, 2 * DFF, G, bid);
            pg8::EpiSwiGLU E{Hb, ssq};
            for (int rep = 0; rep < 1 + DUP_G1; ++rep) {
            pg8::gemm_phase<pg8::EpiSwiGLU, pg8::StaticOrder, true, true>(lds, g, S, E);
            GRID_SYNC(); }
            pg8::Gemm g2{Hb, (const pg8::bf16_t*)(wl + (second ? W_D2 : W_D1)), NT, DM, DFF}; pg8::StaticOrder S2; S2.init(NT, DM, G, bid);
            pg8::EpiResid<false, true> E2{xf, xb, ssq, nullptr, 0.5f};
            pg8::gemm_phase<pg8::EpiResid<false, true>, pg8::StaticOrder, true, true>(lds, g2, S2, E2);
            GRID_SYNC();
        }
        if (!second && DIAG_MIXER) {
            {
                pg8::Gemm g{xb, (const pg8::bf16_t*)(wl + W_IN), NT, DIN, DM}; pg8::StaticOrder S; S.init(NT, DIN, G, bid);
                pg8::EpiProj E{projb, vTb, ssq};
                pg8::gemm_phase<pg8::EpiProj, pg8::StaticOrder, true, true>(lds, g, S, E);
                GRID_SYNC();
            }
            for (int rep = 0; rep < N_P1; ++rep) ssm_p1(a, lds, layer, G);
            GRID_SYNC();
            for (int rep = 0; rep < N_P3; ++rep) ssm_p3(a, lds, layer, G);
            GRID_SYNC();
            {
                pg8::Gemm g{zb, (const pg8::bf16_t*)(wl + W_GLU), NT, 512, 512}; pg8::StaticOrder S; S.init(NT, 512, G, bid);
                pg8::EpiGlu E{zb, mixb, INP(18) + layer * 512, ssq2};
                pg8::gemm_phase<pg8::EpiGlu, pg8::StaticOrder, true, true>(lds, g, S, E);
                GRID_SYNC();
            }
            for (int rep = 0; rep < N_ATT; ++rep) attn_phase(a, lds, layer, G);
            GRID_SYNC();
            {
                pg8::Gemm g{mixb, (const pg8::bf16_t*)(wl + W_OA), NT, DM, 1024}; pg8::StaticOrder S; S.init(NT, DM, G, bid);
                pg8::EpiResid<true, true> E{xf, xb, ssq, ssq2, 1.0f};
                pg8::gemm_phase<pg8::EpiResid<true, true>, pg8::StaticOrder, true, true>(lds, g, S, E);
                GRID_SYNC();
            }
        }
    }
    final_norm(a, G);
}

#undef ws
#undef xf
#undef xb
#undef ssq
#undef ssq2
#undef Hb
#undef projb
#undef vTb
#undef mixb
#undef zb
extern "C" void kernel_launch(void* const* d_in, const int* in_sizes, int n_in, void* d_out, int out_size, void* d_ws, size_t ws_size, hipStream_t stream) {
    static int grid = 0;
    if (grid == 0) {
        if (n_in != 27 || out_size != NT * DM || ws_size < WS_END) { fprintf(stderr, "kernel_launch: unexpected shapes: n_in %d out %d ws %zu (need %zu)\n", n_in, out_size, ws_size, (size_t)WS_END); grid = -1; return; }
        int dev = 0, cus = 0, per_cu = 0;
        hipGetDevice(&dev); hipDeviceGetAttribute(&cus, hipDeviceAttributeMultiprocessorCount, dev);
        hipFuncSetAttribute((const void*)hymba_fwd, hipFuncAttributeMaxDynamicSharedMemorySize, LDS_BYTES);
        hipOccupancyMaxActiveBlocksPerMultiprocessor(&per_cu, (const void*)hymba_fwd, NTHREADS, LDS_BYTES);
        if (per_cu < 1) { fprintf(stderr, "kernel_launch: occupancy query says %d blocks per CU\n", per_cu); per_cu = 1; }
        (void)hipGetLastError();
        grid = cus * per_cu;
        fprintf(stderr, "kernel_launch: grid %d (%d CUs x %d)\n", grid, cus, per_cu);
    }
    if (grid < 0) return;
    if (hipMemsetAsync((char*)d_ws + WS_CTL, 0, CTL_BYTES, stream) != hipSuccess) { fprintf(stderr, "kernel_launch: memset of the barrier words failed\n"); return; }
    Args a{};
    for (int i = 0; i < 27; ++i) a.in[i] = (const float*)d_in[i];
    a.out = (float*)d_out; a.ws = (unsigned char*)d_ws;
    void* args[] = {&a};
    hipError_t e = hipLaunchCooperativeKernel((const void*)hymba_fwd, dim3(grid), dim3(NTHREADS), args, LDS_BYTES, stream);
    if (e != hipSuccess) fprintf(stderr, "cooperative launch failed: %s (grid %d)\n", hipGetErrorString(e), grid);
}
```

```cpp
#include <hip/hip_runtime.h>
#include <hip/hip_cooperative_groups.h>
#include <cstdio>
#include <cstdint>
namespace cg = cooperative_groups;
namespace pg8 {
#define PG8_LAS __attribute__((address_space(3)))
typedef unsigned short bf16_t;
typedef short bf16x8 __attribute__((ext_vector_type(8)));
typedef float f32x4 __attribute__((ext_vector_type(4)));
typedef unsigned u32x4 __attribute__((ext_vector_type(4)));
constexpr int BM = 256, BK = 64, HALF = 128, HTB = HALF * BK * 2  , STAGE_BYTES = 8 * HTB, NXCD = 8, WGM = 8;

__host__ __device__ __forceinline__ int lds_byte(int r, int c) { const int st = (r >> 4) * 2 + (c >> 5), rr = r & 15, cc = c & 31, ob = rr * 64 + cc * 2; return st * 1024 + (ob ^ (((ob >> 9) & 1) << 5)); }
__host__ __device__ __forceinline__ void stage_rc(int b, int& R, int& C) { const int st = b / 1024, sb = b % 1024, swz = sb ^ (((sb >> 9) & 1) << 5); R = (st >> 1) * 16 + swz / 64; C = (st & 1) * 32 + (swz % 64) / 2; }
__host__ __device__ __forceinline__ int perm32(int rho) { const int n = rho >> 4, i = rho & 15; return 8 * (i >> 2) + 4 * n + (i & 3); }

struct Unit { int pm, pn; };
struct Gemm { const bf16_t* A; const bf16_t* Bt; int M, N, K; };

struct StaticOrder {
    int nM, nN, nwg, G, c;
    __host__ __device__ void init(int M, int N, int G_, int c_) { nM = M / BM; nN = N / BM; nwg = nM * nN; G = G_; c = c_; }
    __host__ __device__ bool next(int i, Unit& u) const {
        const long L = (long)i * G + c; if (L >= nwg) return false;
        int wgid = (int)L; { const int q = nwg / NXCD, r = nwg % NXCD, xcd = wgid % NXCD, off = wgid / NXCD; wgid = (xcd < r ? xcd * (q + 1) : r * (q + 1) + (xcd - r) * q) + off; }
        const int nig = WGM * nN, gid = wgid / nig, fm = gid * WGM, gsz = (nM - fm) < WGM ? (nM - fm) : WGM;
        u.pm = fm + ((wgid % nig) % gsz); u.pn = (wgid % nig) / gsz; return true;
    }
    __device__ __forceinline__ void a_ready(const Unit&) const {}
    __device__ __forceinline__ void done(const Unit&) const {}
};

typedef float f32x2 __attribute__((ext_vector_type(2)));
typedef __bf16 bf16x2_t __attribute__((ext_vector_type(2)));
__device__ __forceinline__ unsigned cvt_pk_bf16(float lo, float hi) { const f32x2 v = {lo, hi}; return __builtin_bit_cast(unsigned, __builtin_convertvector(v, bf16x2_t)); }
typedef unsigned u32x2 __attribute__((ext_vector_type(2)));
constexpr float RMS_EPS = 1e-6f;
__device__ __forceinline__ float bf_lo(unsigned w) { return __uint_as_float(w << 16); }
__device__ __forceinline__ float bf_hi(unsigned w) { return __uint_as_float(w & 0xffff0000u); }
__device__ __forceinline__ float fast_sigmoid(float v) { return __builtin_amdgcn_rcpf(1.0f + __builtin_amdgcn_exp2f(-1.4426950408889634f * v)); }
__device__ __forceinline__ float row_rstd16(const float* ssq, int row, int fq) {
    const f32x4 v = *(const f32x4*)(ssq + ((size_t)fq * 32768 + row) * 4);
    float s = (v[0] + v[1]) + (v[2] + v[3]);
    s += __shfl_xor(s, 16); s += __shfl_xor(s, 32);
    return __builtin_amdgcn_rsqf(s * (1.0f / 1024.0f) + RMS_EPS);
}
__device__ __forceinline__ float row_rstd8(const float* ssq2, int row, int fq) {
    const f32x2 v = *(const f32x2*)(ssq2 + ((size_t)(fq & 1) * 32768 + row) * 4 + 2 * (fq >> 1));
    float s = v[0] + v[1];
    s += __shfl_xor(s, 16); s += __shfl_xor(s, 32);
    return __builtin_amdgcn_rsqf(s * (1.0f / 512.0f) + RMS_EPS);
}

struct EpiSwiGLU {
    static constexpr bool PERM = true, AFTER_DRAIN = false, MIDK = false;
    bf16_t* H; const float* ssq;
    __device__ __forceinline__ void operator()(const f32x4 (&acc)[2][2][4][2], const Unit& u, int wr, int wc, int fr, int fq) const {
        const int row0 = u.pm * BM + wr * 64 + fr, hc = u.pn * 128 + wc * 32 + 8 * fq;
        float rsv[8];
#pragma unroll
        for (int i = 0; i < 8; ++i) rsv[i] = row_rstd16(ssq, row0 + (i >> 2) * HALF + (i & 3) * 16, fq);
#pragma unroll
        for (int ai = 0; ai < 2; ++ai)
#pragma unroll
            for (int m = 0; m < 4; ++m) {
                const int row = row0 + ai * HALF + m * 16;
                const float rs = rsv[ai * 4 + m];
                float o[8];
#pragma unroll
                for (int n = 0; n < 2; ++n)
#pragma unroll
                    for (int j = 0; j < 4; ++j) { const float g = acc[ai][0][m][n][j] * rs, up = acc[ai][1][m][n][j] * rs; o[4 * n + j] = g * fast_sigmoid(g) * up; }
                u32x4 w; w.x = cvt_pk_bf16(o[0], o[1]); w.y = cvt_pk_bf16(o[2], o[3]); w.z = cvt_pk_bf16(o[4], o[5]); w.w = cvt_pk_bf16(o[6], o[7]);
                *(u32x4*)(H + (size_t)row * 2816 + hc) = w;
            }
    }
};

template <bool ROWSCALE> struct EpiResid {
    static constexpr bool PERM = true, AFTER_DRAIN = false, MIDK = false;
    bf16_t* xb; float* ssq; const float* ssq2; float scale;
    __device__ __forceinline__ void operator()(const f32x4 (&acc)[2][2][4][2], const Unit& u, int wr, int wc, int fr, int fq) const {
        const int row0 = u.pm * BM + wr * 64 + fr, col0 = u.pn * BM + wc * 32 + 8 * fq;
        float scv[8];
#pragma unroll
        for (int i = 0; i < 8; ++i) scv[i] = ROWSCALE ? row_rstd8(ssq2, row0 + (i >> 2) * HALF + (i & 3) * 16, fq) : scale;
#pragma unroll
        for (int ai = 0; ai < 2; ++ai) {
            u32x4 xv[4][2];
#pragma unroll
            for (int m = 0; m < 4; ++m)
#pragma unroll
                for (int bj = 0; bj < 2; ++bj) xv[m][bj] = *(const u32x4*)(xb + (size_t)(row0 + ai * HALF + m * 16) * 1024 + col0 + bj * HALF);
#pragma unroll
            for (int m = 0; m < 4; ++m) {
                const int row = row0 + ai * HALF + m * 16;
                const float sc = scv[ai * 4 + m];
                float ss = 0.f;
#pragma unroll
                for (int bj = 0; bj < 2; ++bj) {
                    const u32x4 xw = xv[m][bj]; const f32x4 a0 = acc[ai][bj][m][0] * sc, a1 = acc[ai][bj][m][1] * sc;
                    float o[8];
                    o[0] = bf_lo(xw.x) + a0[0]; o[1] = bf_hi(xw.x) + a0[1]; o[2] = bf_lo(xw.y) + a0[2]; o[3] = bf_hi(xw.y) + a0[3];
                    o[4] = bf_lo(xw.z) + a1[0]; o[5] = bf_hi(xw.z) + a1[1]; o[6] = bf_lo(xw.w) + a1[2]; o[7] = bf_hi(xw.w) + a1[3];
#pragma unroll
                    for (int j = 0; j < 8; ++j) ss += o[j] * o[j];
                    u32x4 w; w.x = cvt_pk_bf16(o[0], o[1]); w.y = cvt_pk_bf16(o[2], o[3]); w.z = cvt_pk_bf16(o[4], o[5]); w.w = cvt_pk_bf16(o[6], o[7]);
                    *(u32x4*)(xb + (size_t)row * 1024 + col0 + bj * HALF) = w;
                }
                ss += __shfl_xor(ss, 16); ss += __shfl_xor(ss, 32); if (fq == 0) ssq[((size_t)u.pn * 32768 + row) * 4 + wc] = ss;
            }
        }
    }
};

struct EpiProj {
    static constexpr bool PERM = true, AFTER_DRAIN = false, MIDK = false;
    bf16_t* proj; bf16_t* vT; const float* ssq;
    __device__ __forceinline__ void operator()(const f32x4 (&acc)[2][2][4][2], const Unit& u, int wr, int wc, int fr, int fq) const {
        const int row0 = u.pm * BM + wr * 64 + fr;
        float rsv[8];
#pragma unroll
        for (int i = 0; i < 8; ++i) rsv[i] = row_rstd16(ssq, row0 + (i >> 2) * HALF + (i & 3) * 16, fq);
#pragma unroll
        for (int ai = 0; ai < 2; ++ai)
#pragma unroll
            for (int m = 0; m < 4; ++m) {
                const int row = row0 + ai * HALF + m * 16;
                const float rs = rsv[ai * 4 + m];
#pragma unroll
                for (int bj = 0; bj < 2; ++bj) {
                    const f32x4 v0 = acc[ai][bj][m][0] * rs, v1 = acc[ai][bj][m][1] * rs;
                    u32x4 w; w.x = cvt_pk_bf16(v0[0], v0[1]); w.y = cvt_pk_bf16(v0[2], v0[3]); w.z = cvt_pk_bf16(v1[0], v1[1]); w.w = cvt_pk_bf16(v1[2], v1[3]);
                    if (u.pn == 2 && bj == 1) {
                        const int vc = wc * 32 + 8 * fq, b = row >> 12, t = row & 4095;
                        bf16_t* dst = vT + ((size_t)(b * 2 + (vc >> 6)) * 64 + (vc & 63)) * 4096 + t;
                        dst[0 * 4096] = (bf16_t)(w.x & 0xffffu); dst[1 * 4096] = (bf16_t)(w.x >> 16);
                        dst[2 * 4096] = (bf16_t)(w.y & 0xffffu); dst[3 * 4096] = (bf16_t)(w.y >> 16);
                        dst[4 * 4096] = (bf16_t)(w.z & 0xffffu); dst[5 * 4096] = (bf16_t)(w.z >> 16);
                        dst[6 * 4096] = (bf16_t)(w.w & 0xffffu); dst[7 * 4096] = (bf16_t)(w.w >> 16);
                    } else {
                        *(u32x4*)(proj + (size_t)row * 1280 + u.pn * BM + bj * HALF + wc * 32 + 8 * fq) = w;
                    }
                }
            }
    }
};

struct EpiGlu {
    static constexpr bool PERM = true, AFTER_DRAIN = false, MIDK = false;
    const bf16_t* z; bf16_t* s; const float* bglu; float* ssq2;
    __device__ __forceinline__ void operator()(const f32x4 (&acc)[2][2][4][2], const Unit& u, int wr, int wc, int fr, int fq) const {
        const int row0 = u.pm * BM + wr * 64 + fr;
#pragma unroll
        for (int ai = 0; ai < 2; ++ai)
#pragma unroll
            for (int m = 0; m < 4; ++m) {
                const int row = row0 + ai * HALF + m * 16;
                float ss = 0.f;
#pragma unroll
                for (int bj = 0; bj < 2; ++bj) {
                    const int c0 = u.pn * BM + bj * HALF + wc * 32 + 8 * fq;
                    const u32x4 zw = *(const u32x4*)(z + (size_t)row * 512 + c0);
                    const f32x4 b0 = *(const f32x4*)(bglu + c0), b1 = *(const f32x4*)(bglu + c0 + 4);
                    const f32x4 a0 = acc[ai][bj][m][0] + b0, a1 = acc[ai][bj][m][1] + b1;
                    float o[8];
                    o[0] = bf_lo(zw.x) * fast_sigmoid(a0[0]); o[1] = bf_hi(zw.x) * fast_sigmoid(a0[1]);
                    o[2] = bf_lo(zw.y) * fast_sigmoid(a0[2]); o[3] = bf_hi(zw.y) * fast_sigmoid(a0[3]);
                    o[4] = bf_lo(zw.z) * fast_sigmoid(a1[0]); o[5] = bf_hi(zw.z) * fast_sigmoid(a1[1]);
                    o[6] = bf_lo(zw.w) * fast_sigmoid(a1[2]); o[7] = bf_hi(zw.w) * fast_sigmoid(a1[3]);
#pragma unroll
                    for (int j = 0; j < 8; ++j) ss += o[j] * o[j];
                    u32x4 w; w.x = cvt_pk_bf16(o[0], o[1]); w.y = cvt_pk_bf16(o[2], o[3]); w.z = cvt_pk_bf16(o[4], o[5]); w.w = cvt_pk_bf16(o[6], o[7]);
                    *(u32x4*)(s + (size_t)row * 1024 + 512 + c0) = w;
                }
                ss += __shfl_xor(ss, 16); ss += __shfl_xor(ss, 32); if (fq == 0) ssq2[((size_t)u.pn * 32768 + row) * 4 + wc] = ss;
            }
    }
};
template <class Epi, class Sched, bool ALIGN_EPI = false, bool SP2 = false>
__device__ __forceinline__ void gemm_phase(PG8_LAS unsigned char* lds, const Gemm g, const Sched& S, const Epi& E) {
    int tid_ = threadIdx.x; asm volatile("" : "+v"(tid_));
    const int tid = tid_, wid = __builtin_amdgcn_readfirstlane(tid >> 6), lane = tid & 63, wr = wid >> 2, wc = wid & 3, fr = lane & 15, fq = lane >> 4;
    const int K = g.K, nt = K / BK;
    unsigned voffA[2], voffB[2];
#pragma unroll
    for (int i = 0; i < 2; ++i) { int R, C; stage_rc(tid * 16 + i * 8192, R, C); const int Rb = Epi::PERM ? ((R & ~31) + perm32(R & 31)) : R;
        voffA[i] = (unsigned)(R * K + C) * 2u; voffB[i] = (unsigned)(Rb * K + C) * 2u; }
    const size_t kstep = (size_t)(BK * 2);
    const size_t hstep = (size_t)HALF * K * 2;
    const size_t tstep = 2 * hstep;
    const unsigned ldsw = (unsigned)wid * 1024u;
    const int aoff = lds_byte(wr * 64 + fr, fq * 8), boff = lds_byte(wc * 32 + fr, fq * 8);
#define PG8_SA(b, h) (((b) * 2 + (h)) * HTB)
#define PG8_SB(b, h) ((4 + (b) * 2 + (h)) * HTB)
#define PG8_STAGE(bufoff, gbase, voff) do { _Pragma("unroll") for (int _i = 0; _i < 2; ++_i) \
        __builtin_amdgcn_global_load_lds((const unsigned*)((const char*)(gbase) + (voff)[_i]), (PG8_LAS unsigned*)(lds + (bufoff) + ldsw + _i * 8192), 16, 0, 0); } while (0)
#define PG8_LDA(dst, b, h) do { _Pragma("unroll") for (int m = 0; m < 4; ++m) _Pragma("unroll") for (int k = 0; k < 2; ++k) dst[m][k] = *(const PG8_LAS bf16x8*)(lds + PG8_SA(b, h) + aoff + m * 2048 + k * 1024); } while (0)
#define PG8_LDB(dst, b, h) do { _Pragma("unroll") for (int n = 0; n < 2; ++n) _Pragma("unroll") for (int k = 0; k < 2; ++k) dst[n][k] = *(const PG8_LAS bf16x8*)(lds + PG8_SB(b, h) + boff + n * 2048 + k * 1024); } while (0)
#define PG8_MMA(ai, bj, At, Bt) do { __builtin_amdgcn_s_setprio(1); _Pragma("unroll") for (int m = 0; m < 4; ++m) _Pragma("unroll") for (int n = 0; n < 2; ++n) _Pragma("unroll") for (int k = 0; k < 2; ++k) \
        acc[ai][bj][m][n] = __builtin_amdgcn_mfma_f32_16x16x32_bf16(Bt[n][k], At[m][k], acc[ai][bj][m][n], 0, 0, 0); __builtin_amdgcn_s_setprio(0); } while (0)
#define PG8_WAIT_V(n) asm volatile("s_waitcnt vmcnt(" #n ")" ::: "memory")
#define PG8_WAIT_L(n) asm volatile("s_waitcnt lgkmcnt(" #n ")" ::: "memory")
#define PG8_BAR __builtin_amdgcn_s_barrier()
#define PG8_SCHED __builtin_amdgcn_sched_barrier(0)
    Unit cur, nxt; int ui = 0;
    if (!S.next(0, cur)) return;
    f32x4 acc[2][2][4][2];
#pragma unroll
    for (int a = 0; a < 2; ++a)
#pragma unroll
        for (int b = 0; b < 2; ++b)
#pragma unroll
            for (int m = 0; m < 4; ++m)
#pragma unroll
                for (int n = 0; n < 2; ++n) acc[a][b][m][n] = (f32x4){0.f, 0.f, 0.f, 0.f};
    bf16x8 At[4][2], B0[2][2], B1[2][2];
    const char* cA = (const char*)g.A + (size_t)cur.pm * tstep; const char* cB = (const char*)g.Bt + (size_t)cur.pn * tstep;
    S.a_ready(cur);
    if constexpr (SP2) {
        PG8_STAGE(PG8_SB(0, 0), cB, voffB); PG8_STAGE(PG8_SB(0, 1), cB + hstep, voffB); PG8_STAGE(PG8_SA(0, 0), cA, voffA); PG8_STAGE(PG8_SA(0, 1), cA + hstep, voffA);
        if (wr == 1) PG8_BAR;
        PG8_WAIT_V(2); PG8_BAR;
        PG8_STAGE(PG8_SB(1, 0), cB + kstep, voffB); PG8_STAGE(PG8_SA(1, 0), cA + kstep, voffA); PG8_STAGE(PG8_SB(1, 1), cB + hstep + kstep, voffB);
        PG8_WAIT_V(6); PG8_BAR;
    } else {
        PG8_STAGE(PG8_SB(0, 0), cB, voffB); PG8_STAGE(PG8_SA(0, 0), cA, voffA); PG8_STAGE(PG8_SB(0, 1), cB + hstep, voffB); PG8_STAGE(PG8_SA(0, 1), cA + hstep, voffA);
        if (wr == 1) PG8_BAR;
        PG8_WAIT_V(4); PG8_BAR;
        PG8_STAGE(PG8_SB(1, 0), cB + kstep, voffB); PG8_STAGE(PG8_SA(1, 0), cA + kstep, voffA); PG8_STAGE(PG8_SB(1, 1), cB + hstep + kstep, voffB);
        PG8_WAIT_V(6); PG8_BAR;
    }
    for (;;) {
        const bool has_next = S.next(ui + 1, nxt);
        const char* nA = has_next ? (const char*)g.A + (size_t)nxt.pm * tstep : cA; const char* nB = has_next ? (const char*)g.Bt + (size_t)nxt.pn * tstep : cB;
        for (int t = 0; t < nt; t += 2) {
            const bool last = (t == nt - 2);
            const char* a1 = cA + (size_t)(t + 1) * kstep;
            const char* a2 = last ? nA : cA + (size_t)(t + 2) * kstep; const char* b2 = last ? nB : cB + (size_t)(t + 2) * kstep;
            const char* a3 = a2 + kstep; const char* b3 = b2 + kstep;
            if (last && has_next) S.a_ready(nxt);
            if constexpr (SP2) {
            PG8_LDB(B0, 0, 0); PG8_LDB(B1, 0, 1); PG8_SCHED; PG8_LDA(At, 0, 0); PG8_STAGE(PG8_SA(1, 1), a1 + hstep, voffA);
            PG8_WAIT_V(8); PG8_WAIT_L(0); PG8_BAR; PG8_MMA(0, 0, At, B0); PG8_MMA(0, 1, At, B1); PG8_BAR; PG8_SCHED;
            PG8_LDA(At, 0, 1); PG8_STAGE(PG8_SB(0, 0), b2, voffB); PG8_STAGE(PG8_SB(0, 1), b2 + hstep, voffB); PG8_STAGE(PG8_SA(0, 0), a2, voffA);
            PG8_WAIT_V(8); PG8_WAIT_L(0); PG8_BAR; PG8_MMA(1, 0, At, B0); PG8_MMA(1, 1, At, B1); PG8_BAR; PG8_SCHED;
            PG8_LDB(B0, 1, 0); PG8_LDB(B1, 1, 1); PG8_SCHED; PG8_LDA(At, 1, 0); PG8_STAGE(PG8_SA(0, 1), a2 + hstep, voffA);
            PG8_WAIT_V(8); PG8_WAIT_L(0); PG8_BAR; PG8_MMA(0, 0, At, B0); PG8_MMA(0, 1, At, B1); PG8_BAR; PG8_SCHED;
            PG8_LDA(At, 1, 1); PG8_STAGE(PG8_SB(1, 0), b3, voffB); PG8_STAGE(PG8_SB(1, 1), b3 + hstep, voffB); PG8_STAGE(PG8_SA(1, 0), a3, voffA);
            PG8_WAIT_V(8); PG8_WAIT_L(0); PG8_BAR; PG8_MMA(1, 0, At, B0); PG8_MMA(1, 1, At, B1); PG8_BAR; PG8_SCHED;
            } else {
            PG8_LDB(B0, 0, 0); PG8_SCHED; PG8_LDA(At, 0, 0); PG8_STAGE(PG8_SA(1, 1), a1 + hstep, voffA);
            PG8_WAIT_L(8); PG8_BAR; PG8_WAIT_L(0); PG8_MMA(0, 0, At, B0); PG8_BAR; PG8_SCHED;
            PG8_LDB(B1, 0, 1); PG8_STAGE(PG8_SB(0, 0), b2, voffB);
            PG8_BAR; PG8_WAIT_L(0); PG8_MMA(0, 1, At, B1); PG8_BAR;
            PG8_LDA(At, 0, 1); PG8_STAGE(PG8_SA(0, 0), a2, voffA);
            PG8_BAR; PG8_WAIT_L(0); PG8_MMA(1, 0, At, B0); PG8_BAR; PG8_SCHED;
            PG8_STAGE(PG8_SB(0, 1), b2 + hstep, voffB);
            PG8_WAIT_V(6); PG8_BAR; PG8_MMA(1, 1, At, B1); PG8_BAR;
            PG8_LDB(B0, 1, 0); PG8_SCHED; PG8_LDA(At, 1, 0); PG8_STAGE(PG8_SA(0, 1), a2 + hstep, voffA);
            PG8_WAIT_L(8); PG8_BAR; PG8_WAIT_L(0); PG8_MMA(0, 0, At, B0); PG8_BAR; PG8_SCHED;
            PG8_LDB(B1, 1, 1); PG8_STAGE(PG8_SB(1, 0), b3, voffB);
            PG8_BAR; PG8_WAIT_L(0); PG8_MMA(0, 1, At, B1); PG8_BAR;
            PG8_LDA(At, 1, 1); PG8_STAGE(PG8_SA(1, 0), a3, voffA);
            PG8_BAR; PG8_WAIT_L(0); PG8_MMA(1, 0, At, B0); PG8_BAR; PG8_SCHED;
            PG8_STAGE(PG8_SB(1, 1), b3 + hstep, voffB);
            PG8_WAIT_V(6); PG8_BAR; PG8_MMA(1, 1, At, B1); PG8_BAR;
            }
        }
        if constexpr (ALIGN_EPI) { if (wr == 0) PG8_BAR; }
        if constexpr (!Epi::AFTER_DRAIN) { E(acc, cur, wr, wc, fr, fq); S.done(cur); }
        if (!has_next) break;
#pragma unroll
        for (int a = 0; a < 2; ++a)
#pragma unroll
            for (int b = 0; b < 2; ++b)
#pragma unroll
                for (int m = 0; m < 4; ++m)
#pragma unroll
                    for (int n = 0; n < 2; ++n) acc[a][b][m][n] = (f32x4){0.f, 0.f, 0.f, 0.f};
        cur = nxt; cA = nA; cB = nB; ++ui;
        if constexpr (ALIGN_EPI) { if (wr == 1) PG8_BAR; }
    }
    PG8_WAIT_V(0);
    if constexpr (!ALIGN_EPI) { if (wr == 0) PG8_BAR; }
    PG8_BAR;
    if constexpr (Epi::AFTER_DRAIN) { E.fused(acc, cur, wr, wc, fr, fq, lds, wid, lane); S.done(cur); }
#undef PG8_SA
#undef PG8_SB
#undef PG8_STAGE
#undef PG8_LDA
#undef PG8_LDB
#undef PG8_MMA
#undef PG8_WAIT_V
#undef PG8_WAIT_L
#undef PG8_BAR
#undef PG8_SCHED
}
}

#ifndef DIAG_NOCARRY
#define DIAG_NOCARRY 0
#endif
#ifndef N_ATT
#define N_ATT 1
#endif
#ifndef N_P1
#define N_P1 1
#endif
#ifndef N_P3
#define N_P3 1
#endif
#ifndef DUP_G1
#define DUP_G1 0
#endif
#ifndef DIAG_MIXER
#define DIAG_MIXER 1
#endif
#define LAS __attribute__((address_space(3)))
typedef unsigned short bf16;
typedef short bf16x8 __attribute__((ext_vector_type(8)));
typedef short s16x4 __attribute__((ext_vector_type(4)));
typedef float f32x2 __attribute__((ext_vector_type(2)));
typedef float f32x4 __attribute__((ext_vector_type(4)));
typedef float f32x16 __attribute__((ext_vector_type(16)));
typedef unsigned u32x2 __attribute__((ext_vector_type(2)));
typedef unsigned u32x4 __attribute__((ext_vector_type(4)));

constexpr int NT = 32768, SEQ = 4096, DM = 1024, DFF = 2816, DIN = 1280, NLAYER = 4;
constexpr float LOG2E = 1.4426950408889634f;
constexpr int NWAVES = 8, NTHREADS = 512;
constexpr int LDS_BYTES = 147456;
constexpr size_t MiB = 1u << 20;
constexpr size_t W_GU1 = 0, W_D1 = W_GU1 + (size_t)5632 * 1024 * 2, W_IN = W_D1 + (size_t)1024 * 2816 * 2, W_GLU = W_IN + (size_t)1280 * 1024 * 2,
                 W_OA = W_GLU + (size_t)512 * 512 * 2, W_OS = W_OA + (size_t)1024 * 512 * 2, W_GU2 = W_OS + (size_t)1024 * 512 * 2,
                 W_D2 = W_GU2 + (size_t)5632 * 1024 * 2, W_LAYER = W_D2 + (size_t)1024 * 2816 * 2;
static_assert(W_LAYER == 38 * MiB, "weights per layer");
constexpr size_t WS_W = 0, WS_XB = 152 * MiB, WS_BIG = 216 * MiB, WS_H = WS_BIG, WS_PROJ = WS_BIG, WS_MIX = WS_BIG + 80 * MiB, WS_Z = WS_BIG + 144 * MiB,
                 WS_VT = 392 * MiB, WS_YSCR = 400 * MiB, WS_SEGE = 464 * MiB, WS_SSQ = 466 * MiB, WS_SSQ2 = 468 * MiB, WS_ABAR = 469 * MiB, WS_APOW = WS_ABAR + 256 * 1024,
                 WS_BB = 470 * MiB, WS_CC = 471 * MiB, WS_CTL = 472 * MiB, CTL_BYTES = 16384, WS_END = 473 * MiB;

struct Args { const float* in[27]; float* out; unsigned char* ws; };
__device__ __forceinline__ const float* inptr(int k) {
    typedef const float* cfp;
    const __attribute__((address_space(4))) char* kp = (const __attribute__((address_space(4))) char*)__builtin_amdgcn_kernarg_segment_ptr();
    int off = k * 8; asm volatile("" : "+s"(off));
    return *(const __attribute__((address_space(4))) cfp*)(kp + off);
}
#define INP(k) inptr(k)
__device__ __forceinline__ unsigned char* kptr(int off0) {
    typedef unsigned char* ucp;
    const __attribute__((address_space(4))) char* kp = (const __attribute__((address_space(4))) char*)__builtin_amdgcn_kernarg_segment_ptr();
    int off = off0; asm volatile("" : "+s"(off));
    return *(const __attribute__((address_space(4))) ucp*)(kp + off);
}
#define WSPTR() kptr(224)
#define OUTPTR() ((float*)kptr(216))

__device__ __forceinline__ unsigned f2bf(float f) { unsigned u = __builtin_bit_cast(unsigned, f); return (u + 0x7fffu + ((u >> 16) & 1u)) >> 16; }
typedef __bf16 bf16x2_t __attribute__((ext_vector_type(2)));
__device__ __forceinline__ unsigned pk2(float lo, float hi) { const f32x2 v = {lo, hi}; return __builtin_bit_cast(unsigned, __builtin_convertvector(v, bf16x2_t)); }
__device__ __forceinline__ float bflo(unsigned w) { return __uint_as_float(w << 16); }
__device__ __forceinline__ float bfhi(unsigned w) { return __uint_as_float(w & 0xffff0000u); }
__device__ __forceinline__ float bf2f(bf16 v) { return __uint_as_float((unsigned)v << 16); }
#define LDS_FENCE() asm volatile("s_waitcnt lgkmcnt(0)" ::: "memory")
__device__ __forceinline__ float wave_sum(float v) {
#pragma unroll
    for (int o = 1; o < 64; o <<= 1) v += __shfl_xor(v, o);
    return v;
}
__device__ __forceinline__ int crow(int r, int hi) { return (r & 3) + 8 * (r >> 2) + 4 * hi; }

__device__ __forceinline__ void tr_item(const float* W, int ldw, int K, bf16* WT, int k0, int n0, int drow0, const float* gain, float cs, LAS float* scr, int lane) {
    const int r = lane >> 3, q = lane & 7;
    f32x4 v[8];
#pragma unroll
    for (int i = 0; i < 8; ++i) v[i] = *(const f32x4*)(W + (size_t)(k0 + 8 * i + r) * ldw + n0 + 4 * q);
#pragma unroll
    for (int i = 0; i < 8; ++i) { LAS float* s = scr + (8 * i + r) * 33 + 4 * q; s[0] = v[i][0]; s[1] = v[i][1]; s[2] = v[i][2]; s[3] = v[i][3]; }
    const int c = lane & 7;
    f32x4 g0 = (f32x4){cs, cs, cs, cs}, g1 = g0;
    if (gain) { g0 = *(const f32x4*)(gain + k0 + 8 * c) * cs; g1 = *(const f32x4*)(gain + k0 + 8 * c + 4) * cs; }
    LDS_FENCE();
#pragma unroll
    for (int j = 0; j < 4; ++j) { const int n = (lane >> 3) + 8 * j; const LAS float* s = scr + (8 * c) * 33 + n;
        u32x4 o; o.x = pk2(s[0 * 33] * g0[0], s[1 * 33] * g0[1]); o.y = pk2(s[2 * 33] * g0[2], s[3 * 33] * g0[3]); o.z = pk2(s[4 * 33] * g1[0], s[5 * 33] * g1[1]); o.w = pk2(s[6 * 33] * g1[2], s[7 * 33] * g1[3]);
        *(u32x4*)(WT + (size_t)(drow0 + n) * K + k0 + 8 * c) = o; }
    LDS_FENCE();
}
__device__ __forceinline__ void sincos_rr(float th, float& s, float& c) {
    const float k = rintf(th * 0.6366197723675814f);
    float r = fmaf(-k, 1.5707963705062866f, th); r = fmaf(-k, -4.371138828673793e-8f, r);
    const float r2 = r * r;
    const float sp = r + r * r2 * (-1.6666667e-1f + r2 * (8.3333333e-3f + r2 * (-1.9841270e-4f + r2 * 2.7557319e-6f)));
    const float cp = 1.0f + r2 * (-0.5f + r2 * (4.1666667e-2f + r2 * (-1.3888889e-3f + r2 * 2.4801587e-5f)));
    const int q = ((int)k) & 3;
    s = (q == 0) ? sp : (q == 1) ? cp : (q == 2) ? -sp : -cp;
    c = (q == 0) ? cp : (q == 1) ? -sp : (q == 2) ? -cp : sp;
}
__device__ __forceinline__ void prologue(const Args& a, LAS unsigned char* lds, int G) {
    int tid_ = threadIdx.x; asm volatile("" : "+v"(tid_));
    const int tid = tid_, lane = tid & 63, wave = __builtin_amdgcn_readfirstlane(tid >> 6);
    LAS float* scr = (LAS float*)(lds + wave * 16384);
    const int gw = blockIdx.x * NWAVES + wave, NGW = G * NWAVES;
    constexpr int I_GU = 16 * 88, I_D = 44 * 32, I_IN = 16 * 40, I_GLU = 8 * 16, I_O = 8 * 32;
    constexpr int C1 = I_GU, C2 = C1 + I_GU, C3 = C2 + I_D, C4 = C3 + I_IN, C5 = C4 + I_GLU, C6 = C5 + I_O, C7 = C6 + I_O, C8 = C7 + I_GU, C9 = C8 + I_GU, C10 = C9 + I_D;
    for (int it = gw; it < NLAYER * C10; it += NGW) {
        const int l = it / C10; int r = it % C10;
        unsigned char* wl = WSPTR() + WS_W + (size_t)l * W_LAYER;
        const float* W; int ldw, K, nblk; bf16* WT; const float* gain = nullptr; int mode = 0;
        if (r < C1)       { W = INP(3) + (size_t)l * 1024 * 2816; ldw = 2816; K = 1024; nblk = 88; WT = (bf16*)(wl + W_GU1); gain = INP(2) + l * 1024; mode = 1; }
        else if (r < C2)  { r -= C1; W = INP(4) + (size_t)l * 1024 * 2816; ldw = 2816; K = 1024; nblk = 88; WT = (bf16*)(wl + W_GU1); gain = INP(2) + l * 1024; mode = 2; }
        else if (r < C3)  { r -= C2; W = INP(5) + (size_t)l * 2816 * 1024; ldw = 1024; K = 2816; nblk = 32; WT = (bf16*)(wl + W_D1); }
        else if (r < C4)  { r -= C3; W = INP(7) + (size_t)l * 1024 * 1280; ldw = 1280; K = 1024; nblk = 40; WT = (bf16*)(wl + W_IN); gain = INP(6) + l * 1024; mode = 3; }
        else if (r < C5)  { r -= C4; W = INP(17) + (size_t)l * 512 * 512; ldw = 512; K = 512; nblk = 16; WT = (bf16*)(wl + W_GLU); }
        else if (r < C6)  { r -= C5; W = INP(21) + (size_t)l * 1024 * 1024; ldw = 1024; K = 1024; nblk = 32; WT = (bf16*)(wl + W_OA); gain = INP(19) + l * 512; }
        else if (r < C7)  { r -= C6; W = INP(21) + (size_t)l * 1024 * 1024 + (size_t)512 * 1024; ldw = 1024; K = 1024; nblk = 32; WT = (bf16*)(wl + W_OA) + 512; gain = INP(20) + l * 512; }
        else if (r < C8)  { r -= C7; W = INP(23) + (size_t)l * 1024 * 2816; ldw = 2816; K = 1024; nblk = 88; WT = (bf16*)(wl + W_GU2); gain = INP(22) + l * 1024; mode = 1; }
        else if (r < C9)  { r -= C8; W = INP(24) + (size_t)l * 1024 * 2816; ldw = 2816; K = 1024; nblk = 88; WT = (bf16*)(wl + W_GU2); gain = INP(22) + l * 1024; mode = 2; }
        else              { r -= C9; W = INP(25) + (size_t)l * 2816 * 1024; ldw = 1024; K = 2816; nblk = 32; WT = (bf16*)(wl + W_D2); }
        const int kb = r / nblk, nb = r % nblk, k0 = 64 * kb, n0 = 32 * nb;
        int drow0 = n0; float cs = 1.0f;
        if (mode == 1) drow0 = 256 * (n0 >> 7) + (n0 & 127);
        else if (mode == 2) drow0 = 256 * (n0 >> 7) + 128 + (n0 & 127);
        else if (mode == 3 && n0 < 512) cs = 0.125f * LOG2E;
        tr_item(W, ldw, K, WT, k0, n0, drow0, gain, cs, scr, lane);
    }
    {
        const float* x = INP(0); bf16* xb = (bf16*)(WSPTR() + WS_XB); float* ssq = (float*)(WSPTR() + WS_SSQ);
        for (int m = gw; m < NT; m += NGW) {
            const f32x4* xr = (const f32x4*)(x + (size_t)m * DM) + lane; u32x2* brow = (u32x2*)(xb + (size_t)m * DM) + lane;
            float s = 0.f;
#pragma unroll
            for (int j = 0; j < 4; ++j) { const f32x4 v = xr[64 * j]; u32x2 w; w.x = pk2(v[0], v[1]); w.y = pk2(v[2], v[3]); brow[64 * j] = w; s += (v[0] * v[0] + v[1] * v[1]) + (v[2] * v[2] + v[3] * v[3]); }
            s = wave_sum(s);
            if (lane < 16) ssq[((size_t)(lane >> 2) * NT + m) * 4 + (lane & 3)] = (lane == 0) ? s : 0.f;
        }
    }
    {
        f32x2* AB = (f32x2*)(WSPTR() + WS_ABAR); f32x2* AP = (f32x2*)(WSPTR() + WS_APOW); bf16* BB = (bf16*)(WSPTR() + WS_BB); bf16* CC = (bf16*)(WSPTR() + WS_CC);
        for (int cb = gw; cb < NLAYER * 2 * 32; cb += NGW) {
            const int p = lane;
            const float dt = __expf(INP(11)[cb]);
            const float are = INP(9)[cb * 64 + p], aim = INP(10)[cb * 64 + p];
            const float mag = __expf(dt * are); float sn, cs; sincos_rr(dt * aim, sn, cs);
            const float abr = mag * cs, abi = mag * sn;
            const float den = are * are + aim * aim, nr = abr - 1.0f, ni = abi;
            const float kr = (nr * are + ni * aim) / den, ki = (ni * are - nr * aim) / den;
            AB[cb * 64 + p] = (f32x2){abr, abi};
            float pr = abr, pi = abi;
#pragma unroll
            for (int q = 0; q < 9; ++q) { const float t0 = pr * pr - pi * pi, t1 = 2.0f * pr * pi; pr = t0; pi = t1; }
            AP[cb * 64 + p] = (f32x2){pr, pi};
            scr[2 * p] = kr; scr[2 * p + 1] = ki;
            LDS_FENCE();
            const float* bre = INP(12) + (size_t)cb * 64 * 16; const float* bim = INP(13) + (size_t)cb * 64 * 16;
            const float* cre = INP(14) + (size_t)cb * 16 * 64; const float* cim = INP(15) + (size_t)cb * 16 * 64;
#pragma unroll
            for (int tile = 0; tile < 4; ++tile) {
                const int pp = 32 * (tile & 1) + (lane & 31); const float kr2 = scr[2 * pp], ki2 = scr[2 * pp + 1];
                unsigned w[4];
#pragma unroll
                for (int j2 = 0; j2 < 4; ++j2) { float v[2];
#pragma unroll
                    for (int e = 0; e < 2; ++e) { const int h = 8 * (lane >> 5) + 2 * j2 + e; const float br = bre[pp * 16 + h], bi = bim[pp * 16 + h];
                        v[e] = (tile >> 1) ? (kr2 * bi + ki2 * br) : (kr2 * br - ki2 * bi); }
                    w[j2] = pk2(v[0], v[1]); }
                *(u32x4*)(BB + ((size_t)(cb * 4 + tile) * 64 + lane) * 8) = (u32x4){w[0], w[1], w[2], w[3]};
            }
#pragma unroll
            for (int kk = 0; kk < 4; ++kk) {
                unsigned w[4];
#pragma unroll
                for (int j2 = 0; j2 < 4; ++j2) { const int kap = 32 * kk + 8 * (lane >> 4) + 2 * j2, pp = kap >> 1, h = lane & 15;
                    w[j2] = pk2(cre[h * 64 + pp], -cim[h * 64 + pp]); }
                *(u32x4*)(CC + ((size_t)(cb * 4 + kk) * 64 + lane) * 8) = (u32x4){w[0], w[1], w[2], w[3]};
            }
            LDS_FENCE();
        }
    }
}

__device__ __forceinline__ void attn_phase(const Args& a, LAS unsigned char* lds, int layer, int G) {
    int tid_ = threadIdx.x; asm volatile("" : "+v"(tid_));
    const int tid = tid_, lane = tid & 63, h = __builtin_amdgcn_readfirstlane(tid >> 6), kvh = h >> 2;
    LAS float* biasT = (LAS float*)lds;
    LAS float* red = (LAS float*)(lds + 10240);
    const float* tab = INP(1);
    for (int e = tid; e < 8 * 320; e += NTHREADS) {
        const int hh = e / 320, ri = e % 320 - 32; float v = -1e30f;
        if (ri >= 0 && ri <= 256) { const int rel = ri - 128, n = rel < 0 ? -rel : rel; int bk = (rel > 0) ? 16 : 0;
            if (n < 8) bk += n; else { int lg = 2 + (31 - __builtin_clz((unsigned)(n * n))); bk += (lg < 15 ? lg : 15); }
            v = tab[bk * 8 + hh] * LOG2E; }
        biasT[e] = v;
    }
    __syncthreads();
    const bf16* proj = (const bf16*)(WSPTR() + WS_PROJ); const bf16* vT = (const bf16*)(WSPTR() + WS_VT); bf16* an = (bf16*)(WSPTR() + WS_MIX); const float* ssq2p = (const float*)(WSPTR() + WS_SSQ2);
    const float sinkv = INP(8)[layer * 8 + h] * LOG2E;
    const int ql = lane & 31, hi = lane >> 5;
    int par = 0;
    for (int ui = blockIdx.x; ui < 1024; ui += G, par ^= 1) {
        const int b = ui >> 7, q0 = (ui & 127) * 32, rowq = b * SEQ + q0;
        const bf16* qp = proj + (size_t)(rowq + ql) * DIN + h * 64 + 8 * hi;
        bf16x8 qf[4];
#pragma unroll
        for (int kk = 0; kk < 4; ++kk) qf[kk] = *(const bf16x8*)(qp + 16 * kk);
        float m = sinkv, lsum = 1.0f;
        f32x16 o0, o1;
#pragma unroll
        for (int r = 0; r < 16; ++r) { o0[r] = 0.f; o1[r] = 0.f; }
        const bf16* vbase = vT + ((size_t)(b * 2 + kvh) * 64 + ql) * SEQ + 4 * hi;
        for (int kt = 0; kt < 9; ++kt) {
            const int key0 = q0 - 128 + 32 * kt;
            if (key0 < 0 || key0 >= SEQ) continue;
            const bf16* kp = proj + (size_t)(b * SEQ + key0 + ql) * DIN + 512 + kvh * 64 + 8 * hi;
            bf16x8 kf[4];
#pragma unroll
            for (int kk = 0; kk < 4; ++kk) kf[kk] = *(const bf16x8*)(kp + 16 * kk);
            s16x4 vf[2][2][2];
#pragma unroll
            for (int dt = 0; dt < 2; ++dt)
#pragma unroll
                for (int s = 0; s < 2; ++s) { const bf16* vp = vbase + (size_t)(32 * dt) * SEQ + key0 + 16 * s; vf[dt][s][0] = *(const s16x4*)vp; vf[dt][s][1] = *(const s16x4*)(vp + 8); }
            f32x16 st;
#pragma unroll
            for (int r = 0; r < 16; ++r) st[r] = 0.f;
#pragma unroll
            for (int kk = 0; kk < 4; ++kk) st = __builtin_amdgcn_mfma_f32_32x32x16_bf16(kf[kk], qf[kk], st, 0, 0, 0);
            const LAS float* bt = biasT + h * 320 + 32 * kt + 32 - ql + 4 * hi;
            float tmax = -3.0e38f;
#pragma unroll
            for (int r = 0; r < 16; ++r) { st[r] += bt[(r & 3) + 8 * (r >> 2)]; tmax = fmaxf(tmax, st[r]); }
            tmax = fmaxf(tmax, __shfl_xor(tmax, 32));
            const float mnew = fmaxf(m, tmax), alpha = __builtin_amdgcn_exp2f(m - mnew); m = mnew;
            float ps = 0.f;
#pragma unroll
            for (int r = 0; r < 16; ++r) { st[r] = __builtin_amdgcn_exp2f(st[r] - mnew); ps += st[r]; }
            ps += __shfl_xor(ps, 32); lsum = lsum * alpha + ps;
#pragma unroll
            for (int r = 0; r < 16; ++r) { o0[r] *= alpha; o1[r] *= alpha; }
            bf16x8 pf[2];
#pragma unroll
            for (int s = 0; s < 2; ++s) { u32x4 w; w.x = pk2(st[8 * s + 0], st[8 * s + 1]); w.y = pk2(st[8 * s + 2], st[8 * s + 3]); w.z = pk2(st[8 * s + 4], st[8 * s + 5]); w.w = pk2(st[8 * s + 6], st[8 * s + 7]);
                pf[s] = __builtin_bit_cast(bf16x8, w); }
#pragma unroll
            for (int s = 0; s < 2; ++s) {
                bf16x8 v0 = __builtin_shufflevector(vf[0][s][0], vf[0][s][1], 0, 1, 2, 3, 4, 5, 6, 7);
                bf16x8 v1 = __builtin_shufflevector(vf[1][s][0], vf[1][s][1], 0, 1, 2, 3, 4, 5, 6, 7);
                o0 = __builtin_amdgcn_mfma_f32_32x32x16_bf16(v0, pf[s], o0, 0, 0, 0);
                o1 = __builtin_amdgcn_mfma_f32_32x32x16_bf16(v1, pf[s], o1, 0, 0, 0);
            }
        }
        const float inv = 1.0f / lsum;
        float ss = 0.f;
#pragma unroll
        for (int r = 0; r < 16; ++r) { o0[r] *= inv; o1[r] *= inv; ss += o0[r] * o0[r] + o1[r] * o1[r]; }
        ss += __shfl_xor(ss, 32);
        LAS float* rd = red + par * 256;
        if (hi == 0) rd[h * 32 + ql] = ss;
        __syncthreads();
        float tot = 0.f;
#pragma unroll
        for (int hh = 0; hh < 8; ++hh) tot += rd[hh * 32 + ql];
        const f32x4 sq = *(const f32x4*)(ssq2p + ((size_t)hi * NT + rowq + ql) * 4);
        float ts = (sq[0] + sq[1]) + (sq[2] + sq[3]); ts += __shfl_xor(ts, 32);
        const float rstd = __builtin_amdgcn_rsqf(tot * (1.0f / 512.0f) + 1e-6f) * __builtin_amdgcn_sqrtf(ts * (1.0f / 512.0f) + 1e-6f);
        bf16* op = an + (size_t)(rowq + ql) * 1024 + h * 64 + 4 * hi;
#pragma unroll
        for (int g4 = 0; g4 < 4; ++g4) {
            u32x2 w0, w1;
            w0.x = pk2(o0[4 * g4] * rstd, o0[4 * g4 + 1] * rstd); w0.y = pk2(o0[4 * g4 + 2] * rstd, o0[4 * g4 + 3] * rstd);
            w1.x = pk2(o1[4 * g4] * rstd, o1[4 * g4 + 1] * rstd); w1.y = pk2(o1[4 * g4 + 2] * rstd, o1[4 * g4 + 3] * rstd);
            *(u32x2*)(op + 8 * g4) = w0; *(u32x2*)(op + 32 + 8 * g4) = w1;
        }
    }
}

constexpr int XS_STRIDE = 68;
template <bool BWD, int MODE  >
__device__ __forceinline__ void ssm_pass(const bf16* proj, int rowbase, int g, const bf16x8* BBp, const bf16x8* CCp, float ar, float ai, float& sr, float& si,
                                         LAS unsigned* XS, int lane, f32x4* ysc, const float* Dp, bf16* zbuf) {
    bf16x8 bb[4], cc[4];
#pragma unroll
    for (int t = 0; t < 4; ++t) { bb[t] = BBp[t * 64 + lane]; if (MODE > 0) cc[t] = CCp[t * 64 + lane]; }
    const int ql = lane & 31, hi = lane >> 5;
    const bf16* up = proj + (size_t)(rowbase + ql) * DIN + 768 + g * 16 + 8 * hi;
    bf16x8 ucur = *(const bf16x8*)(up + (size_t)(BWD ? 15 : 0) * 32 * DIN);
    float dval = 0.f; if (MODE == 2) dval = Dp[g * 16 + (lane & 15)];
    for (int c = 0; c < 16; ++c) {
        const int ch = BWD ? 15 - c : c;
        bf16x8 unext = ucur;
        if (c < 15) unext = *(const bf16x8*)(up + (size_t)(BWD ? ch - 1 : ch + 1) * 32 * DIN);
        f32x16 z16;
#pragma unroll
        for (int r = 0; r < 16; ++r) z16[r] = 0.f;
        const f32x16 x0 = __builtin_amdgcn_mfma_f32_32x32x16_bf16(ucur, bb[0], z16, 0, 0, 0);
        const f32x16 x1 = __builtin_amdgcn_mfma_f32_32x32x16_bf16(ucur, bb[1], z16, 0, 0, 0);
        const f32x16 x2 = __builtin_amdgcn_mfma_f32_32x32x16_bf16(ucur, bb[2], z16, 0, 0, 0);
        const f32x16 x3 = __builtin_amdgcn_mfma_f32_32x32x16_bf16(ucur, bb[3], z16, 0, 0, 0);
#pragma unroll
        for (int r = 0; r < 16; ++r) { const int t = crow(r, hi); XS[t * XS_STRIDE + ql] = pk2(x0[r], x2[r]); XS[t * XS_STRIDE + 32 + ql] = pk2(x1[r], x3[r]); }
        LDS_FENCE();
#pragma unroll
        for (int tt = 0; tt < 32; ++tt) {
            const int t = BWD ? 31 - tt : tt;
            const unsigned v = XS[t * XS_STRIDE + lane];
            const float nr = fmaf(ar, sr, fmaf(-ai, si, bflo(v))), ni = fmaf(ar, si, fmaf(ai, sr, bfhi(v)));
            sr = nr; si = ni;
            if (MODE > 0) XS[t * XS_STRIDE + lane] = pk2(sr, si);
        }
        if (MODE > 0) {
            LDS_FENCE();
            f32x4 y0 = (f32x4){0.f, 0.f, 0.f, 0.f}, y1 = y0;
            if (MODE == 2) { y0 = ysc[(ch * 2 + 0) * 64 + lane]; y1 = ysc[(ch * 2 + 1) * 64 + lane]; }
            const LAS unsigned char* ab = (const LAS unsigned char*)XS + (lane & 15) * (XS_STRIDE * 4) + (lane >> 4) * 16;
#pragma unroll
            for (int kk = 0; kk < 4; ++kk) {
                const bf16x8 a0 = *(const LAS bf16x8*)(ab + kk * 64), a1 = *(const LAS bf16x8*)(ab + 16 * XS_STRIDE * 4 + kk * 64);
                y0 = __builtin_amdgcn_mfma_f32_16x16x32_bf16(a0, cc[kk], y0, 0, 0, 0);
                y1 = __builtin_amdgcn_mfma_f32_16x16x32_bf16(a1, cc[kk], y1, 0, 0, 0);
            }
            if (MODE == 1) { ysc[(ch * 2 + 0) * 64 + lane] = y0; ysc[(ch * 2 + 1) * 64 + lane] = y1; }
            else {
                const int hcol = g * 16 + (lane & 15);
#pragma unroll
                for (int rt = 0; rt < 2; ++rt)
#pragma unroll
                    for (int i = 0; i < 4; ++i) {
                        const int row = rowbase + 32 * ch + 16 * rt + 4 * (lane >> 4) + i;
                        const float uv = bf2f(proj[(size_t)row * DIN + 768 + hcol]);
                        const float y = (rt ? y1[i] : y0[i]) + dval * uv;
                        const float zz = y * __builtin_amdgcn_rcpf(1.0f + __builtin_amdgcn_exp2f(-2.3022082f * (y + 0.044715f * y * y * y)));
                        zbuf[(size_t)row * 512 + hcol] = (bf16)f2bf(zz);
                    }
            }
            LDS_FENCE();
        }
        ucur = unext;
    }
}

__device__ __forceinline__ void ssm_p1(const Args& a, LAS unsigned char* lds, int layer, int G) {
    int tid_ = threadIdx.x; asm volatile("" : "+v"(tid_));
    const int tid = tid_, lane = tid & 63, wave = __builtin_amdgcn_readfirstlane(tid >> 6);
    LAS unsigned* XS = (LAS unsigned*)(lds + 16384 + wave * (32 * XS_STRIDE * 4));
    const bf16* proj = (const bf16*)(WSPTR() + WS_PROJ);
    const f32x2* AB = (const f32x2*)(WSPTR() + WS_ABAR); f32x2* SE = (f32x2*)(WSPTR() + WS_SEGE);
    const int gw = blockIdx.x * NWAVES + wave, NGW = G * NWAVES;
    for (int wt = gw; wt < 4096; wt += NGW) {
        const int dir = wt & 1, seg = (wt >> 1) & 7, g = (wt >> 4) & 31, b = wt >> 9;
        const int cb = (layer * 2 + dir) * 32 + g;
        const f32x2 ab = AB[cb * 64 + lane];
        float sr = 0.f, si = 0.f;
        const bf16x8* BBp = (const bf16x8*)(WSPTR() + WS_BB) + (size_t)cb * 4 * 64;
        const int rowbase = b * SEQ + seg * 512;
        if (dir) ssm_pass<true, 0>(proj, rowbase, g, BBp, nullptr, ab[0], ab[1], sr, si, XS, lane, nullptr, nullptr, nullptr);
        else     ssm_pass<false, 0>(proj, rowbase, g, BBp, nullptr, ab[0], ab[1], sr, si, XS, lane, nullptr, nullptr, nullptr);
        SE[((size_t)((b * 32 + g) * 2 + dir) * 8 + seg) * 64 + lane] = (f32x2){sr, si};
    }
}
__device__ __forceinline__ void ssm_p3(const Args& a, LAS unsigned char* lds, int layer, int G) {
    int tid_ = threadIdx.x; asm volatile("" : "+v"(tid_));
    const int tid = tid_, lane = tid & 63, wave = __builtin_amdgcn_readfirstlane(tid >> 6);
    LAS unsigned* XS = (LAS unsigned*)(lds + 16384 + wave * (32 * XS_STRIDE * 4));
    const bf16* proj = (const bf16*)(WSPTR() + WS_PROJ); bf16* zbuf = (bf16*)(WSPTR() + WS_Z);
    const f32x2* AB = (const f32x2*)(WSPTR() + WS_ABAR); const f32x2* AP = (const f32x2*)(WSPTR() + WS_APOW); const f32x2* SE = (const f32x2*)(WSPTR() + WS_SEGE);
    const int gw = blockIdx.x * NWAVES + wave, NGW = G * NWAVES;
    (void)gw; (void)NGW;
    for (int wg = blockIdx.x; wg < 256; wg += G) {
        const int wt = wg * 8 + wave, g = (wg & 3) * 8 + wave, seg = (wg >> 2) & 7, b = wg >> 5;
        const int rowbase = b * SEQ + seg * 512;
        f32x4* ysc = (f32x4*)(WSPTR() + WS_YSCR) + (size_t)wt * (16 * 2 * 64);
        {
            const int cb = (layer * 2 + 1) * 32 + g;
            const f32x2 ab = AB[cb * 64 + lane], ap = AP[cb * 64 + lane];
            const f32x2* se = SE + ((size_t)((b * 32 + g) * 2 + 1) * 8) * 64 + lane;
            float sr = 0.f, si = 0.f;
            for (int k = 7; k > seg && !DIAG_NOCARRY; --k) { const f32x2 e = se[k * 64]; const float nr = ap[0] * sr - ap[1] * si + e[0], ni = ap[0] * si + ap[1] * sr + e[1]; sr = nr; si = ni; }
            ssm_pass<true, 1>(proj, rowbase, g, (const bf16x8*)(WSPTR() + WS_BB) + (size_t)cb * 256, (const bf16x8*)(WSPTR() + WS_CC) + (size_t)cb * 256, ab[0], ab[1], sr, si, XS, lane, ysc, nullptr, nullptr);
        }
        {
            const int cb = (layer * 2 + 0) * 32 + g;
            const f32x2 ab = AB[cb * 64 + lane], ap = AP[cb * 64 + lane];
            const f32x2* se = SE + ((size_t)((b * 32 + g) * 2 + 0) * 8) * 64 + lane;
            float sr = 0.f, si = 0.f;
            for (int k = 0; k < seg && !DIAG_NOCARRY; ++k) { const f32x2 e = se[k * 64]; const float nr = ap[0] * sr - ap[1] * si + e[0], ni = ap[0] * si + ap[1] * sr + e[1]; sr = nr; si = ni; }
            ssm_pass<false, 2>(proj, rowbase, g, (const bf16x8*)(WSPTR() + WS_BB) + (size_t)cb * 256, (const bf16x8*)(WSPTR() + WS_CC) + (size_t)cb * 256, ab[0], ab[1], sr, si, XS, lane, ysc, INP(16) + layer * 512, zbuf);
        }
    }
}

__device__ __forceinline__ void final_norm(const Args& a, int G) {
    int tid_ = threadIdx.x; asm volatile("" : "+v"(tid_));
    const int tid = tid_, lane = tid & 63, wave = __builtin_amdgcn_readfirstlane(tid >> 6);
    const int gw = blockIdx.x * NWAVES + wave, NGW = G * NWAVES;
    const float* ssq = (const float*)(WSPTR() + WS_SSQ); const bf16* xb = (const bf16*)(WSPTR() + WS_XB); float* out = OUTPTR();
    const f32x4* gn = (const f32x4*)INP(26) + 2 * lane;
    f32x4 gv[2][2];
#pragma unroll
    for (int j = 0; j < 2; ++j) { gv[j][0] = gn[128 * j]; gv[j][1] = gn[128 * j + 1]; }
    for (int m = gw; m < NT; m += NGW) {
        float s = (lane < 16) ? ssq[((size_t)(lane >> 2) * NT + m) * 4 + (lane & 3)] : 0.f; s = wave_sum(s);
        const float rs = __builtin_amdgcn_rsqf(s * (1.0f / 1024.0f) + 1e-6f);
        const u32x4* xr = (const u32x4*)(xb + (size_t)m * DM) + lane; f32x4* orow = (f32x4*)(out + (size_t)m * DM) + 2 * lane;
#pragma unroll
        for (int j = 0; j < 2; ++j) { const u32x4 w = xr[64 * j];
            orow[128 * j] = (f32x4){bflo(w.x), bfhi(w.x), bflo(w.y), bfhi(w.y)} * rs * gv[j][0];
            orow[128 * j + 1] = (f32x4){bflo(w.z), bfhi(w.z), bflo(w.w), bfhi(w.w)} * rs * gv[j][1]; }
    }
}

#define XB_TMO      128
#define XB_XCNT(j)  (256  + 64 * (j))
#define XB_XSUB(j)  (1280 + 64 * (j))
#define XB_XGEN(j)  (2304 + 64 * (j))
#define XB_TOP      3328
#define XB_TOPGEN   3392
#define XCD_BAR_WORDS 3456
#define XB_SPIN_CAP (1u << 18)

__device__ __forceinline__ unsigned xb_ld(unsigned* p)              { return __hip_atomic_load(p, __ATOMIC_RELAXED, __HIP_MEMORY_SCOPE_AGENT); }
__device__ __forceinline__ unsigned xb_add(unsigned* p, unsigned v) { return __hip_atomic_fetch_add(p, v, __ATOMIC_RELAXED, __HIP_MEMORY_SCOPE_AGENT); }
__device__ __forceinline__ unsigned xb_xcc_id() { return (unsigned)__builtin_amdgcn_s_getreg((3 << 11) | 20) & 0xFu; }
#define XB_SPIN(cond, bar) do { unsigned _sp = 0; while (cond) { __builtin_amdgcn_s_sleep(1); \
    if ((++_sp & 255u) == 0u) { if (xb_ld(&(bar)[XB_TMO])) break; if (_sp > XB_SPIN_CAP) { atomicAdd(&(bar)[XB_TMO], 1u); break; } } } } while (0)

struct XcdBarrier {
    unsigned* bar; unsigned x;
    volatile LAS unsigned* st;
};

__device__ __forceinline__ XcdBarrier xcd_barrier_post(unsigned* bar, volatile LAS unsigned* st) {
    XcdBarrier b; b.bar = bar; b.x = xb_xcc_id(); b.st = st;
    if (threadIdx.x == 0) (void)xb_add(&bar[XB_XCNT(b.x)], 1u);
    return b;
}
__device__ __forceinline__ void xcd_barrier_complete(unsigned* bar, unsigned x, unsigned& nloc, unsigned& nx) {
    const unsigned G = gridDim.x * gridDim.y * gridDim.z;
    unsigned sum, cnt, mine, sp = 0u;
    for (;;) {
        sum = 0u; cnt = 0u; mine = 0u;
#pragma unroll
        for (unsigned j = 0; j < 16; ++j) { const unsigned c = xb_ld(&bar[XB_XCNT(j)]); sum += c; cnt += (c > 0u) ? 1u : 0u; mine = (j == x) ? c : mine; }
        if (sum == G) break;
        __builtin_amdgcn_s_sleep(1);
        if ((++sp & 255u) == 0u) { if (xb_ld(&bar[XB_TMO])) break; if (sp > XB_SPIN_CAP) { atomicAdd(&bar[XB_TMO], 1u); break; } }
    }
    nloc = mine > 0u ? mine : 1u; nx = cnt > 0u ? cnt : 1u;
}

__device__ __forceinline__ void xcd_barrier(const XcdBarrier& b) {
    asm volatile("s_waitcnt vmcnt(0)" ::: "memory");
    __syncthreads();
    if (threadIdx.x == 0) {
        unsigned* bar = b.bar;
        __builtin_amdgcn_s_waitcnt(0);
        unsigned nloc = b.st[0], nx = b.st[1];
        if (nloc == 0u) { xcd_barrier_complete(bar, b.x, nloc, nx); b.st[0] = nloc; b.st[1] = nx; }
        const unsigned old = xb_add(&bar[XB_XSUB(b.x)], 1u);
        const unsigned gen = old / nloc;
        if (old + 1u == (gen + 1u) * nloc) {
            __builtin_amdgcn_fence(__ATOMIC_RELEASE, "agent");
            asm volatile("s_waitcnt vmcnt(0)" ::: "memory");
            const unsigned og = xb_add(&bar[XB_TOP], 1u);
            const unsigned tg = og / nx;
            if (og + 1u == (tg + 1u) * nx) xb_add(&bar[XB_TOPGEN], 1u);
            else XB_SPIN(xb_ld(&bar[XB_TOPGEN]) == tg, bar);
            __builtin_amdgcn_fence(__ATOMIC_ACQUIRE, "agent");
            xb_add(&bar[XB_XGEN(b.x)], 1u);
            asm volatile("s_waitcnt vmcnt(0)" ::: "memory");
        } else {
            XB_SPIN(xb_ld(&bar[XB_XGEN(b.x)]) == gen, bar);
            __builtin_amdgcn_fence(__ATOMIC_ACQUIRE, "agent");
            asm volatile("s_waitcnt vmcnt(0)" ::: "memory");
        }
    }
    __syncthreads();
}

#define GRID_SYNC() do { XcdBarrier xb_; xb_.bar = (unsigned*)(WSPTR() + WS_CTL); xb_.x = xb_xcc_id(); xb_.st = (volatile LAS unsigned*)((LAS unsigned char*)lds_raw + (LDS_BYTES - 64)); xcd_barrier(xb_); } while (0)
__global__ void __launch_bounds__(NTHREADS, 2) hymba_fwd(Args a) {
    extern __shared__ __attribute__((aligned(16))) unsigned char lds_raw[];
    LAS unsigned char* lds = (LAS unsigned char*)lds_raw;
    cg::grid_group grid = cg::this_grid();
    const int G = gridDim.x, bid = blockIdx.x;
    volatile LAS unsigned* misc = (volatile LAS unsigned*)(lds + LDS_BYTES - 64);
    if (threadIdx.x < 16) misc[threadIdx.x] = 0u;
    __syncthreads();
    (void)xcd_barrier_post((unsigned*)(WSPTR() + WS_CTL), misc);
    grid.sync();
#define ws WSPTR()
#define xf OUTPTR()
#define xb ((pg8::bf16_t*)(WSPTR() + WS_XB))
#define ssq ((float*)(WSPTR() + WS_SSQ))
#define ssq2 ((float*)(WSPTR() + WS_SSQ2))
#define Hb ((pg8::bf16_t*)(WSPTR() + WS_H))
#define projb ((pg8::bf16_t*)(WSPTR() + WS_PROJ))
#define vTb ((pg8::bf16_t*)(WSPTR() + WS_VT))
#define mixb ((pg8::bf16_t*)(WSPTR() + WS_MIX))
#define zb ((pg8::bf16_t*)(WSPTR() + WS_Z))

    prologue(a, lds, G);
    GRID_SYNC();
    for (int st = 0; st < 2 * NLAYER; ++st) {
        const int layer = st >> 1, second = st & 1;
        const unsigned char* wl = ws + WS_W + (size_t)layer * W_LAYER;
        {
            pg8::Gemm g{xb, (const pg8::bf16_t*)(wl + (second ? W_GU2 : W_GU1)), NT, 2 * DFF, DM}; pg8::StaticOrder S; S.init(NT, 2 * DFF, G, bid);
            pg8::EpiSwiGLU E{Hb, ssq};
            for (int rep = 0; rep < 1 + DUP_G1; ++rep) {
            pg8::gemm_phase<pg8::EpiSwiGLU, pg8::StaticOrder, true, true>(lds, g, S, E);
            GRID_SYNC(); }
            pg8::Gemm g2{Hb, (const pg8::bf16_t*)(wl + (second ? W_D2 : W_D1)), NT, DM, DFF}; pg8::StaticOrder S2; S2.init(NT, DM, G, bid);
            pg8::EpiResid<false> E2{xb, ssq, nullptr, 0.5f};
            pg8::gemm_phase<pg8::EpiResid<false>, pg8::StaticOrder, true, true>(lds, g2, S2, E2);
            GRID_SYNC();
        }
        if (!second && DIAG_MIXER) {
            {
                pg8::Gemm g{xb, (const pg8::bf16_t*)(wl + W_IN), NT, DIN, DM}; pg8::StaticOrder S; S.init(NT, DIN, G, bid);
                pg8::EpiProj E{projb, vTb, ssq};
                pg8::gemm_phase<pg8::EpiProj, pg8::StaticOrder, true, true>(lds, g, S, E);
                GRID_SYNC();
            }
            for (int rep = 0; rep < N_P1; ++rep) ssm_p1(a, lds, layer, G);
            GRID_SYNC();
            for (int rep = 0; rep < N_P3; ++rep) ssm_p3(a, lds, layer, G);
            GRID_SYNC();
            {
                pg8::Gemm g{zb, (const pg8::bf16_t*)(wl + W_GLU), NT, 512, 512}; pg8::StaticOrder S; S.init(NT, 512, G, bid);
                pg8::EpiGlu E{zb, mixb, INP(18) + layer * 512, ssq2};
                pg8::gemm_phase<pg8::EpiGlu, pg8::StaticOrder, true, true>(lds, g, S, E);
                GRID_SYNC();
            }
            for (int rep = 0; rep < N_ATT; ++rep) attn_phase(a, lds, layer, G);
            GRID_SYNC();
            {
                pg8::Gemm g{mixb, (const pg8::bf16_t*)(wl + W_OA), NT, DM, 1024}; pg8::StaticOrder S; S.init(NT, DM, G, bid);
                pg8::EpiResid<true> E{xb, ssq, ssq2, 1.0f};
                pg8::gemm_phase<pg8::EpiResid<true>, pg8::StaticOrder, true, true>(lds, g, S, E);
                GRID_SYNC();
            }
        }
    }
    final_norm(a, G);
}

#undef ws
#undef xf
#undef xb
#undef ssq
#undef ssq2
#undef Hb
#undef projb
#undef vTb
#undef mixb
#undef zb
extern "C" void kernel_launch(void* const* d_in, const int* in_sizes, int n_in, void* d_out, int out_size, void* d_ws, size_t ws_size, hipStream_t stream) {
    static int grid = 0;
    if (grid == 0) {
        if (n_in != 27 || out_size != NT * DM || ws_size < WS_END) { fprintf(stderr, "kernel_launch: unexpected shapes: n_in %d out %d ws %zu (need %zu)\n", n_in, out_size, ws_size, (size_t)WS_END); grid = -1; return; }
        int dev = 0, cus = 0, per_cu = 0;
        hipGetDevice(&dev); hipDeviceGetAttribute(&cus, hipDeviceAttributeMultiprocessorCount, dev);
        hipFuncSetAttribute((const void*)hymba_fwd, hipFuncAttributeMaxDynamicSharedMemorySize, LDS_BYTES);
        hipOccupancyMaxActiveBlocksPerMultiprocessor(&per_cu, (const void*)hymba_fwd, NTHREADS, LDS_BYTES);
        if (per_cu < 1) { fprintf(stderr, "kernel_launch: occupancy query says %d blocks per CU\n", per_cu); per_cu = 1; }
        (void)hipGetLastError();
        grid = cus * per_cu;
        fprintf(stderr, "kernel_launch: grid %d (%d CUs x %d)\n", grid, cus, per_cu);
    }
    if (grid < 0) return;
    if (hipMemsetAsync((char*)d_ws + WS_CTL, 0, CTL_BYTES, stream) != hipSuccess) { fprintf(stderr, "kernel_launch: memset of the barrier words failed\n"); return; }
    Args a{};
    for (int i = 0; i < 27; ++i) a.in[i] = (const float*)d_in[i];
    a.out = (float*)d_out; a.ws = (unsigned char*)d_ws;
    void* args[] = {&a};
    hipError_t e = hipLaunchCooperativeKernel((const void*)hymba_fwd, dim3(grid), dim3(NTHREADS), args, LDS_BYTES, stream);
    if (e != hipSuccess) fprintf(stderr, "cooperative launch failed: %s (grid %d)\n", hipGetErrorString(e), grid);
}
```

```cpp
#include <hip/hip_runtime.h>
#include <hip/hip_cooperative_groups.h>
#include <cstdio>
#include <cstdint>
namespace cg = cooperative_groups;
namespace pg8 {
#define PG8_LAS __attribute__((address_space(3)))
typedef unsigned short bf16_t;
typedef short bf16x8 __attribute__((ext_vector_type(8)));
typedef float f32x4 __attribute__((ext_vector_type(4)));
typedef unsigned u32x4 __attribute__((ext_vector_type(4)));
constexpr int BM = 256, BK = 64, HALF = 128, HTB = HALF * BK * 2  , STAGE_BYTES = 8 * HTB, NXCD = 8, WGM = 8;

__host__ __device__ __forceinline__ int lds_byte(int r, int c) { const int st = (r >> 4) * 2 + (c >> 5), rr = r & 15, cc = c & 31, ob = rr * 64 + cc * 2; return st * 1024 + (ob ^ (((ob >> 9) & 1) << 5)); }
__host__ __device__ __forceinline__ void stage_rc(int b, int& R, int& C) { const int st = b / 1024, sb = b % 1024, swz = sb ^ (((sb >> 9) & 1) << 5); R = (st >> 1) * 16 + swz / 64; C = (st & 1) * 32 + (swz % 64) / 2; }
__host__ __device__ __forceinline__ int perm32(int rho) { const int n = rho >> 4, i = rho & 15; return 8 * (i >> 2) + 4 * n + (i & 3); }

struct Unit { int pm, pn; };
struct Gemm { const bf16_t* A; const bf16_t* Bt; int M, N, K; };

struct StaticOrder {
    int nM, nN, nwg, G, c;
    __host__ __device__ void init(int M, int N, int G_, int c_) { nM = M / BM; nN = N / BM; nwg = nM * nN; G = G_; c = c_; }
    __host__ __device__ bool next(int i, Unit& u) const {
        const long L = (long)i * G + c; if (L >= nwg) return false;
        int wgid = (int)L; { const int q = nwg / NXCD, r = nwg % NXCD, xcd = wgid % NXCD, off = wgid / NXCD; wgid = (xcd < r ? xcd * (q + 1) : r * (q + 1) + (xcd - r) * q) + off; }
        const int nig = WGM * nN, gid = wgid / nig, fm = gid * WGM, gsz = (nM - fm) < WGM ? (nM - fm) : WGM;
        u.pm = fm + ((wgid % nig) % gsz); u.pn = (wgid % nig) / gsz; return true;
    }
    __device__ __forceinline__ void a_ready(const Unit&) const {}
    __device__ __forceinline__ void done(const Unit&) const {}
};

typedef float f32x2 __attribute__((ext_vector_type(2)));
typedef __bf16 bf16x2_t __attribute__((ext_vector_type(2)));
__device__ __forceinline__ unsigned cvt_pk_bf16(float lo, float hi) { const f32x2 v = {lo, hi}; return __builtin_bit_cast(unsigned, __builtin_convertvector(v, bf16x2_t)); }
typedef unsigned u32x2 __attribute__((ext_vector_type(2)));
constexpr float RMS_EPS = 1e-6f;
__device__ __forceinline__ float bf_lo(unsigned w) { return __uint_as_float(w << 16); }
__device__ __forceinline__ float bf_hi(unsigned w) { return __uint_as_float(w & 0xffff0000u); }
__device__ __forceinline__ float fast_sigmoid(float v) { return __builtin_amdgcn_rcpf(1.0f + __builtin_amdgcn_exp2f(-1.4426950408889634f * v)); }
__device__ __forceinline__ float row_rstd16(const float* ssq, int row, int fq) {
    const f32x4 v = *(const f32x4*)(ssq + ((size_t)fq * 32768 + row) * 4);
    float s = (v[0] + v[1]) + (v[2] + v[3]);
    s += __shfl_xor(s, 16); s += __shfl_xor(s, 32);
    return __builtin_amdgcn_rsqf(s * (1.0f / 1024.0f) + RMS_EPS);
}
__device__ __forceinline__ float row_rstd8(const float* ssq2, int row, int fq) {
    const f32x2 v = *(const f32x2*)(ssq2 + ((size_t)(fq & 1) * 32768 + row) * 4 + 2 * (fq >> 1));
    float s = v[0] + v[1];
    s += __shfl_xor(s, 16); s += __shfl_xor(s, 32);
    return __builtin_amdgcn_rsqf(s * (1.0f / 512.0f) + RMS_EPS);
}

struct EpiSwiGLU {
    static constexpr bool PERM = true, AFTER_DRAIN = false, MIDK = false;
    bf16_t* H; const float* ssq;
    __device__ __forceinline__ void operator()(const f32x4 (&acc)[2][2][4][2], const Unit& u, int wr, int wc, int fr, int fq) const {
        const int row0 = u.pm * BM + wr * 64 + fr, hc = u.pn * 128 + wc * 32 + 8 * fq;
        float rsv[8];
#pragma unroll
        for (int i = 0; i < 8; ++i) rsv[i] = row_rstd16(ssq, row0 + (i >> 2) * HALF + (i & 3) * 16, fq);
#pragma unroll
        for (int ai = 0; ai < 2; ++ai)
#pragma unroll
            for (int m = 0; m < 4; ++m) {
                const int row = row0 + ai * HALF + m * 16;
                const float rs = rsv[ai * 4 + m], c1 = -1.4426950408889634f * rs, c2 = rs * rs;
                float o[8];
#pragma unroll
                for (int n = 0; n < 2; ++n)
#pragma unroll
                    for (int jp = 0; jp < 2; ++jp) {
                        const f32x2 ag = {acc[ai][0][m][n][2 * jp], acc[ai][0][m][n][2 * jp + 1]}, au = {acc[ai][1][m][n][2 * jp], acc[ai][1][m][n][2 * jp + 1]};
                        const f32x2 e = ag * c1; f32x2 t; t.x = __builtin_amdgcn_exp2f(e.x); t.y = __builtin_amdgcn_exp2f(e.y);
                        const f32x2 dd = t + 1.0f; f32x2 r; r.x = __builtin_amdgcn_rcpf(dd.x); r.y = __builtin_amdgcn_rcpf(dd.y);
                        const f32x2 p = (ag * au) * (r * c2);
                        o[4 * n + 2 * jp] = p.x; o[4 * n + 2 * jp + 1] = p.y;
                    }
                u32x4 w; w.x = cvt_pk_bf16(o[0], o[1]); w.y = cvt_pk_bf16(o[2], o[3]); w.z = cvt_pk_bf16(o[4], o[5]); w.w = cvt_pk_bf16(o[6], o[7]);
                *(u32x4*)(H + (size_t)row * 2816 + hc) = w;
            }
    }
};

template <bool ROWSCALE> struct EpiResid {
    static constexpr bool PERM = true, AFTER_DRAIN = false, MIDK = false;
    bf16_t* xb; float* ssq; const float* ssq2; float scale;
    __device__ __forceinline__ void operator()(const f32x4 (&acc)[2][2][4][2], const Unit& u, int wr, int wc, int fr, int fq) const {
        const int row0 = u.pm * BM + wr * 64 + fr, col0 = u.pn * BM + wc * 32 + 8 * fq;
        float scv[8];
#pragma unroll
        for (int i = 0; i < 8; ++i) scv[i] = ROWSCALE ? row_rstd8(ssq2, row0 + (i >> 2) * HALF + (i & 3) * 16, fq) : scale;
#pragma unroll
        for (int ai = 0; ai < 2; ++ai) {
            u32x4 xv[4][2];
#pragma unroll
            for (int m = 0; m < 4; ++m)
#pragma unroll
                for (int bj = 0; bj < 2; ++bj) xv[m][bj] = *(const u32x4*)(xb + (size_t)(row0 + ai * HALF + m * 16) * 1024 + col0 + bj * HALF);
#pragma unroll
            for (int m = 0; m < 4; ++m) {
                const int row = row0 + ai * HALF + m * 16;
                const float sc = scv[ai * 4 + m];
                float ss = 0.f;
#pragma unroll
                for (int bj = 0; bj < 2; ++bj) {
                    const u32x4 xw = xv[m][bj]; const f32x4 a0 = acc[ai][bj][m][0] * sc, a1 = acc[ai][bj][m][1] * sc;
                    float o[8];
                    o[0] = bf_lo(xw.x) + a0[0]; o[1] = bf_hi(xw.x) + a0[1]; o[2] = bf_lo(xw.y) + a0[2]; o[3] = bf_hi(xw.y) + a0[3];
                    o[4] = bf_lo(xw.z) + a1[0]; o[5] = bf_hi(xw.z) + a1[1]; o[6] = bf_lo(xw.w) + a1[2]; o[7] = bf_hi(xw.w) + a1[3];
#pragma unroll
                    for (int j = 0; j < 8; ++j) ss += o[j] * o[j];
                    u32x4 w; w.x = cvt_pk_bf16(o[0], o[1]); w.y = cvt_pk_bf16(o[2], o[3]); w.z = cvt_pk_bf16(o[4], o[5]); w.w = cvt_pk_bf16(o[6], o[7]);
                    *(u32x4*)(xb + (size_t)row * 1024 + col0 + bj * HALF) = w;
                }
                ss += __shfl_xor(ss, 16); ss += __shfl_xor(ss, 32); if (fq == 0) ssq[((size_t)u.pn * 32768 + row) * 4 + wc] = ss;
            }
        }
    }
};

struct EpiProj {
    static constexpr bool PERM = true, AFTER_DRAIN = false, MIDK = false;
    bf16_t* proj; bf16_t* vT; const float* ssq;
    __device__ __forceinline__ void operator()(const f32x4 (&acc)[2][2][4][2], const Unit& u, int wr, int wc, int fr, int fq) const {
        const int row0 = u.pm * BM + wr * 64 + fr;
        float rsv[8];
#pragma unroll
        for (int i = 0; i < 8; ++i) rsv[i] = row_rstd16(ssq, row0 + (i >> 2) * HALF + (i & 3) * 16, fq);
#pragma unroll
        for (int ai = 0; ai < 2; ++ai)
#pragma unroll
            for (int m = 0; m < 4; ++m) {
                const int row = row0 + ai * HALF + m * 16;
                const float rs = rsv[ai * 4 + m];
#pragma unroll
                for (int bj = 0; bj < 2; ++bj) {
                    const f32x4 v0 = acc[ai][bj][m][0] * rs, v1 = acc[ai][bj][m][1] * rs;
                    u32x4 w; w.x = cvt_pk_bf16(v0[0], v0[1]); w.y = cvt_pk_bf16(v0[2], v0[3]); w.z = cvt_pk_bf16(v1[0], v1[1]); w.w = cvt_pk_bf16(v1[2], v1[3]);
                    if (u.pn == 2 && bj == 1) {
                        const int vc = wc * 32 + 8 * fq, b = row >> 12, t = row & 4095;
                        bf16_t* dst = vT + ((size_t)(b * 2 + (vc >> 6)) * 64 + (vc & 63)) * 4096 + t;
                        dst[0 * 4096] = (bf16_t)(w.x & 0xffffu); dst[1 * 4096] = (bf16_t)(w.x >> 16);
                        dst[2 * 4096] = (bf16_t)(w.y & 0xffffu); dst[3 * 4096] = (bf16_t)(w.y >> 16);
                        dst[4 * 4096] = (bf16_t)(w.z & 0xffffu); dst[5 * 4096] = (bf16_t)(w.z >> 16);
                        dst[6 * 4096] = (bf16_t)(w.w & 0xffffu); dst[7 * 4096] = (bf16_t)(w.w >> 16);
                    } else {
                        *(u32x4*)(proj + (size_t)row * 1280 + u.pn * BM + bj * HALF + wc * 32 + 8 * fq) = w;
                    }
                }
            }
    }
};

struct EpiGlu {
    static constexpr bool PERM = true, AFTER_DRAIN = false, MIDK = false;
    const bf16_t* z; bf16_t* s; const float* bglu; float* ssq2;
    __device__ __forceinline__ void operator()(const f32x4 (&acc)[2][2][4][2], const Unit& u, int wr, int wc, int fr, int fq) const {
        const int row0 = u.pm * BM + wr * 64 + fr;
#pragma unroll
        for (int ai = 0; ai < 2; ++ai)
#pragma unroll
            for (int m = 0; m < 4; ++m) {
                const int row = row0 + ai * HALF + m * 16;
                float ss = 0.f;
#pragma unroll
                for (int bj = 0; bj < 2; ++bj) {
                    const int c0 = u.pn * BM + bj * HALF + wc * 32 + 8 * fq;
                    const u32x4 zw = *(const u32x4*)(z + (size_t)row * 512 + c0);
                    const f32x4 b0 = *(const f32x4*)(bglu + c0), b1 = *(const f32x4*)(bglu + c0 + 4);
                    const f32x4 a0 = acc[ai][bj][m][0] + b0, a1 = acc[ai][bj][m][1] + b1;
                    float o[8];
                    o[0] = bf_lo(zw.x) * fast_sigmoid(a0[0]); o[1] = bf_hi(zw.x) * fast_sigmoid(a0[1]);
                    o[2] = bf_lo(zw.y) * fast_sigmoid(a0[2]); o[3] = bf_hi(zw.y) * fast_sigmoid(a0[3]);
                    o[4] = bf_lo(zw.z) * fast_sigmoid(a1[0]); o[5] = bf_hi(zw.z) * fast_sigmoid(a1[1]);
                    o[6] = bf_lo(zw.w) * fast_sigmoid(a1[2]); o[7] = bf_hi(zw.w) * fast_sigmoid(a1[3]);
#pragma unroll
                    for (int j = 0; j < 8; ++j) ss += o[j] * o[j];
                    u32x4 w; w.x = cvt_pk_bf16(o[0], o[1]); w.y = cvt_pk_bf16(o[2], o[3]); w.z = cvt_pk_bf16(o[4], o[5]); w.w = cvt_pk_bf16(o[6], o[7]);
                    *(u32x4*)(s + (size_t)row * 1024 + 512 + c0) = w;
                }
                ss += __shfl_xor(ss, 16); ss += __shfl_xor(ss, 32); if (fq == 0) ssq2[((size_t)u.pn * 32768 + row) * 4 + wc] = ss;
            }
    }
};
template <class Epi, class Sched, bool ALIGN_EPI = false, bool SP2 = false>
__device__ __forceinline__ void gemm_phase(PG8_LAS unsigned char* lds, const Gemm g, const Sched& S, const Epi& E) {
    int tid_ = threadIdx.x; asm volatile("" : "+v"(tid_));
    const int tid = tid_, wid = __builtin_amdgcn_readfirstlane(tid >> 6), lane = tid & 63, wr = wid >> 2, wc = wid & 3, fr = lane & 15, fq = lane >> 4;
    const int K = g.K, nt = K / BK;
    unsigned voffA[2], voffB[2];
#pragma unroll
    for (int i = 0; i < 2; ++i) { int R, C; stage_rc(tid * 16 + i * 8192, R, C); const int Rb = Epi::PERM ? ((R & ~31) + perm32(R & 31)) : R;
        voffA[i] = (unsigned)(R * K + C) * 2u; voffB[i] = (unsigned)(Rb * K + C) * 2u; }
    const size_t kstep = (size_t)(BK * 2);
    const size_t hstep = (size_t)HALF * K * 2;
    const size_t tstep = 2 * hstep;
    const unsigned ldsw = (unsigned)wid * 1024u;
    const int aoff = lds_byte(wr * 64 + fr, fq * 8), boff = lds_byte(wc * 32 + fr, fq * 8);
#define PG8_SA(b, h) (((b) * 2 + (h)) * HTB)
#define PG8_SB(b, h) ((4 + (b) * 2 + (h)) * HTB)
#define PG8_STAGE(bufoff, gbase, voff) do { _Pragma("unroll") for (int _i = 0; _i < 2; ++_i) \
        __builtin_amdgcn_global_load_lds((const unsigned*)((const char*)(gbase) + (voff)[_i]), (PG8_LAS unsigned*)(lds + (bufoff) + ldsw + _i * 8192), 16, 0, 0); } while (0)
#define PG8_LDA(dst, b, h) do { _Pragma("unroll") for (int m = 0; m < 4; ++m) _Pragma("unroll") for (int k = 0; k < 2; ++k) dst[m][k] = *(const PG8_LAS bf16x8*)(lds + PG8_SA(b, h) + aoff + m * 2048 + k * 1024); } while (0)
#define PG8_LDB(dst, b, h) do { _Pragma("unroll") for (int n = 0; n < 2; ++n) _Pragma("unroll") for (int k = 0; k < 2; ++k) dst[n][k] = *(const PG8_LAS bf16x8*)(lds + PG8_SB(b, h) + boff + n * 2048 + k * 1024); } while (0)
#define PG8_MMA(ai, bj, At, Bt) do { __builtin_amdgcn_s_setprio(1); _Pragma("unroll") for (int m = 0; m < 4; ++m) _Pragma("unroll") for (int n = 0; n < 2; ++n) _Pragma("unroll") for (int k = 0; k < 2; ++k) \
        acc[ai][bj][m][n] = __builtin_amdgcn_mfma_f32_16x16x32_bf16(Bt[n][k], At[m][k], acc[ai][bj][m][n], 0, 0, 0); __builtin_amdgcn_s_setprio(0); } while (0)
#define PG8_WAIT_V(n) asm volatile("s_waitcnt vmcnt(" #n ")" ::: "memory")
#define PG8_WAIT_L(n) asm volatile("s_waitcnt lgkmcnt(" #n ")" ::: "memory")
#define PG8_BAR __builtin_amdgcn_s_barrier()
#define PG8_SCHED __builtin_amdgcn_sched_barrier(0)
    Unit cur, nxt; int ui = 0;
    if (!S.next(0, cur)) return;
    f32x4 acc[2][2][4][2];
#pragma unroll
    for (int a = 0; a < 2; ++a)
#pragma unroll
        for (int b = 0; b < 2; ++b)
#pragma unroll
            for (int m = 0; m < 4; ++m)
#pragma unroll
                for (int n = 0; n < 2; ++n) acc[a][b][m][n] = (f32x4){0.f, 0.f, 0.f, 0.f};
    bf16x8 At[4][2], B0[2][2], B1[2][2];
    const char* cA = (const char*)g.A + (size_t)cur.pm * tstep; const char* cB = (const char*)g.Bt + (size_t)cur.pn * tstep;
    S.a_ready(cur);
    if constexpr (SP2) {
        PG8_STAGE(PG8_SB(0, 0), cB, voffB); PG8_STAGE(PG8_SB(0, 1), cB + hstep, voffB); PG8_STAGE(PG8_SA(0, 0), cA, voffA); PG8_STAGE(PG8_SA(0, 1), cA + hstep, voffA);
        if (wr == 1) PG8_BAR;
        PG8_WAIT_V(2); PG8_BAR;
        PG8_STAGE(PG8_SB(1, 0), cB + kstep, voffB); PG8_STAGE(PG8_SA(1, 0), cA + kstep, voffA); PG8_STAGE(PG8_SB(1, 1), cB + hstep + kstep, voffB);
        PG8_WAIT_V(6); PG8_BAR;
    } else {
        PG8_STAGE(PG8_SB(0, 0), cB, voffB); PG8_STAGE(PG8_SA(0, 0), cA, voffA); PG8_STAGE(PG8_SB(0, 1), cB + hstep, voffB); PG8_STAGE(PG8_SA(0, 1), cA + hstep, voffA);
        if (wr == 1) PG8_BAR;
        PG8_WAIT_V(4); PG8_BAR;
        PG8_STAGE(PG8_SB(1, 0), cB + kstep, voffB); PG8_STAGE(PG8_SA(1, 0), cA + kstep, voffA); PG8_STAGE(PG8_SB(1, 1), cB + hstep + kstep, voffB);
        PG8_WAIT_V(6); PG8_BAR;
    }
    for (;;) {
        const bool has_next = S.next(ui + 1, nxt);
        const char* nA = has_next ? (const char*)g.A + (size_t)nxt.pm * tstep : cA; const char* nB = has_next ? (const char*)g.Bt + (size_t)nxt.pn * tstep : cB;
        for (int t = 0; t < nt; t += 2) {
            const bool last = (t == nt - 2);
            const char* a1 = cA + (size_t)(t + 1) * kstep;
            const char* a2 = last ? nA : cA + (size_t)(t + 2) * kstep; const char* b2 = last ? nB : cB + (size_t)(t + 2) * kstep;
            const char* a3 = a2 + kstep; const char* b3 = b2 + kstep;
            if (last && has_next) S.a_ready(nxt);
            if constexpr (SP2) {
            PG8_LDB(B0, 0, 0); PG8_LDB(B1, 0, 1); PG8_SCHED; PG8_LDA(At, 0, 0); PG8_STAGE(PG8_SA(1, 1), a1 + hstep, voffA);
            PG8_WAIT_V(8); PG8_WAIT_L(0); PG8_BAR; PG8_MMA(0, 0, At, B0); PG8_MMA(0, 1, At, B1); PG8_BAR; PG8_SCHED;
            PG8_LDA(At, 0, 1); PG8_STAGE(PG8_SB(0, 0), b2, voffB); PG8_STAGE(PG8_SB(0, 1), b2 + hstep, voffB); PG8_STAGE(PG8_SA(0, 0), a2, voffA);
            PG8_WAIT_V(8); PG8_WAIT_L(0); PG8_BAR; PG8_MMA(1, 0, At, B0); PG8_MMA(1, 1, At, B1); PG8_BAR; PG8_SCHED;
            PG8_LDB(B0, 1, 0); PG8_LDB(B1, 1, 1); PG8_SCHED; PG8_LDA(At, 1, 0); PG8_STAGE(PG8_SA(0, 1), a2 + hstep, voffA);
            PG8_WAIT_V(8); PG8_WAIT_L(0); PG8_BAR; PG8_MMA(0, 0, At, B0); PG8_MMA(0, 1, At, B1); PG8_BAR; PG8_SCHED;
            PG8_LDA(At, 1, 1); PG8_STAGE(PG8_SB(1, 0), b3, voffB); PG8_STAGE(PG8_SB(1, 1), b3 + hstep, voffB); PG8_STAGE(PG8_SA(1, 0), a3, voffA);
            PG8_WAIT_V(8); PG8_WAIT_L(0); PG8_BAR; PG8_MMA(1, 0, At, B0); PG8_MMA(1, 1, At, B1); PG8_BAR; PG8_SCHED;
            } else {
            PG8_LDB(B0, 0, 0); PG8_SCHED; PG8_LDA(At, 0, 0); PG8_STAGE(PG8_SA(1, 1), a1 + hstep, voffA);
            PG8_WAIT_L(8); PG8_BAR; PG8_WAIT_L(0); PG8_MMA(0, 0, At, B0); PG8_BAR; PG8_SCHED;
            PG8_LDB(B1, 0, 1); PG8_STAGE(PG8_SB(0, 0), b2, voffB);
            PG8_BAR; PG8_WAIT_L(0); PG8_MMA(0, 1, At, B1); PG8_BAR;
            PG8_LDA(At, 0, 1); PG8_STAGE(PG8_SA(0, 0), a2, voffA);
            PG8_BAR; PG8_WAIT_L(0); PG8_MMA(1, 0, At, B0); PG8_BAR; PG8_SCHED;
            PG8_STAGE(PG8_SB(0, 1), b2 + hstep, voffB);
            PG8_WAIT_V(6); PG8_BAR; PG8_MMA(1, 1, At, B1); PG8_BAR;
            PG8_LDB(B0, 1, 0); PG8_SCHED; PG8_LDA(At, 1, 0); PG8_STAGE(PG8_SA(0, 1), a2 + hstep, voffA);
            PG8_WAIT_L(8); PG8_BAR; PG8_WAIT_L(0); PG8_MMA(0, 0, At, B0); PG8_BAR; PG8_SCHED;
            PG8_LDB(B1, 1, 1); PG8_STAGE(PG8_SB(1, 0), b3, voffB);
            PG8_BAR; PG8_WAIT_L(0); PG8_MMA(0, 1, At, B1); PG8_BAR;
            PG8_LDA(At, 1, 1); PG8_STAGE(PG8_SA(1, 0), a3, voffA);
            PG8_BAR; PG8_WAIT_L(0); PG8_MMA(1, 0, At, B0); PG8_BAR; PG8_SCHED;
            PG8_STAGE(PG8_SB(1, 1), b3 + hstep, voffB);
            PG8_WAIT_V(6); PG8_BAR; PG8_MMA(1, 1, At, B1); PG8_BAR;
            }
        }
        if constexpr (ALIGN_EPI) { if (wr == 0) PG8_BAR; }
        if constexpr (!Epi::AFTER_DRAIN) { E(acc, cur, wr, wc, fr, fq); S.done(cur); }
        if (!has_next) break;
#pragma unroll
        for (int a = 0; a < 2; ++a)
#pragma unroll
            for (int b = 0; b < 2; ++b)
#pragma unroll
                for (int m = 0; m < 4; ++m)
#pragma unroll
                    for (int n = 0; n < 2; ++n) acc[a][b][m][n] = (f32x4){0.f, 0.f, 0.f, 0.f};
        cur = nxt; cA = nA; cB = nB; ++ui;
        if constexpr (ALIGN_EPI) { if (wr == 1) PG8_BAR; }
    }
    PG8_WAIT_V(0);
    if constexpr (!ALIGN_EPI) { if (wr == 0) PG8_BAR; }
    PG8_BAR;
    if constexpr (Epi::AFTER_DRAIN) { E.fused(acc, cur, wr, wc, fr, fq, lds, wid, lane); S.done(cur); }
#undef PG8_SA
#undef PG8_SB
#undef PG8_STAGE
#undef PG8_LDA
#undef PG8_LDB
#undef PG8_MMA
#undef PG8_WAIT_V
#undef PG8_WAIT_L
#undef PG8_BAR
#undef PG8_SCHED
}
}

#ifndef DIAG_NOCARRY
#define DIAG_NOCARRY 0
#endif
#ifndef N_ATT
#define N_ATT 1
#endif
#ifndef N_P1
#define N_P1 1
#endif
#ifndef N_P3
#define N_P3 1
#endif
#ifndef DUP_G1
#define DUP_G1 0
#endif
#ifndef DIAG_MIXER
#define DIAG_MIXER 1
#endif
#define LAS __attribute__((address_space(3)))
typedef unsigned short bf16;
typedef short bf16x8 __attribute__((ext_vector_type(8)));
typedef short s16x4 __attribute__((ext_vector_type(4)));
typedef float f32x2 __attribute__((ext_vector_type(2)));
typedef float f32x4 __attribute__((ext_vector_type(4)));
typedef float f32x16 __attribute__((ext_vector_type(16)));
typedef unsigned u32x2 __attribute__((ext_vector_type(2)));
typedef unsigned u32x4 __attribute__((ext_vector_type(4)));

constexpr int NT = 32768, SEQ = 4096, DM = 1024, DFF = 2816, DIN = 1280, NLAYER = 4;
constexpr float LOG2E = 1.4426950408889634f;
constexpr int NWAVES = 8, NTHREADS = 512;
constexpr int LDS_BYTES = 147456;
constexpr size_t MiB = 1u << 20;
constexpr size_t W_GU1 = 0, W_D1 = W_GU1 + (size_t)5632 * 1024 * 2, W_IN = W_D1 + (size_t)1024 * 2816 * 2, W_GLU = W_IN + (size_t)1280 * 1024 * 2,
                 W_OA = W_GLU + (size_t)512 * 512 * 2, W_OS = W_OA + (size_t)1024 * 512 * 2, W_GU2 = W_OS + (size_t)1024 * 512 * 2,
                 W_D2 = W_GU2 + (size_t)5632 * 1024 * 2, W_LAYER = W_D2 + (size_t)1024 * 2816 * 2;
static_assert(W_LAYER == 38 * MiB, "weights per layer");
constexpr size_t WS_W = 0, WS_XB = 152 * MiB, WS_BIG = 216 * MiB, WS_H = WS_BIG, WS_PROJ = WS_BIG, WS_MIX = WS_BIG + 80 * MiB, WS_Z = WS_BIG + 144 * MiB,
                 WS_VT = 392 * MiB, WS_YSCR = 400 * MiB, WS_SEGE = 464 * MiB, WS_SSQ = 466 * MiB, WS_SSQ2 = 468 * MiB, WS_ABAR = 469 * MiB, WS_APOW = WS_ABAR + 256 * 1024,
                 WS_BB = 470 * MiB, WS_CC = 471 * MiB, WS_CTL = 472 * MiB, CTL_BYTES = 16384, WS_END = 473 * MiB;

struct Args { const float* in[27]; float* out; unsigned char* ws; };
__device__ __forceinline__ const float* inptr(int k) {
    typedef const float* cfp;
    const __attribute__((address_space(4))) char* kp = (const __attribute__((address_space(4))) char*)__builtin_amdgcn_kernarg_segment_ptr();
    int off = k * 8; asm volatile("" : "+s"(off));
    return *(const __attribute__((address_space(4))) cfp*)(kp + off);
}
#define INP(k) inptr(k)
__device__ __forceinline__ unsigned char* kptr(int off0) {
    typedef unsigned char* ucp;
    const __attribute__((address_space(4))) char* kp = (const __attribute__((address_space(4))) char*)__builtin_amdgcn_kernarg_segment_ptr();
    int off = off0; asm volatile("" : "+s"(off));
    return *(const __attribute__((address_space(4))) ucp*)(kp + off);
}
#define WSPTR() kptr(224)
#define OUTPTR() ((float*)kptr(216))

__device__ __forceinline__ unsigned f2bf(float f) { unsigned u = __builtin_bit_cast(unsigned, f); return (u + 0x7fffu + ((u >> 16) & 1u)) >> 16; }
typedef __bf16 bf16x2_t __attribute__((ext_vector_type(2)));
__device__ __forceinline__ unsigned pk2(float lo, float hi) { const f32x2 v = {lo, hi}; return __builtin_bit_cast(unsigned, __builtin_convertvector(v, bf16x2_t)); }
__device__ __forceinline__ float bflo(unsigned w) { return __uint_as_float(w << 16); }
__device__ __forceinline__ float bfhi(unsigned w) { return __uint_as_float(w & 0xffff0000u); }
__device__ __forceinline__ float bf2f(bf16 v) { return __uint_as_float((unsigned)v << 16); }
#define LDS_FENCE() asm volatile("s_waitcnt lgkmcnt(0)" ::: "memory")
__device__ __forceinline__ float wave_sum(float v) {
#pragma unroll
    for (int o = 1; o < 64; o <<= 1) v += __shfl_xor(v, o);
    return v;
}
__device__ __forceinline__ int crow(int r, int hi) { return (r & 3) + 8 * (r >> 2) + 4 * hi; }

__device__ __forceinline__ void tr_item(const float* W, int ldw, int K, bf16* WT, int k0, int n0, int drow0, const float* gain, float cs, LAS float* scr, int lane) {
    const int r = lane >> 3, q = lane & 7;
    f32x4 v[8];
#pragma unroll
    for (int i = 0; i < 8; ++i) v[i] = *(const f32x4*)(W + (size_t)(k0 + 8 * i + r) * ldw + n0 + 4 * q);
#pragma unroll
    for (int i = 0; i < 8; ++i) { LAS float* s = scr + (8 * i + r) * 33 + 4 * q; s[0] = v[i][0]; s[1] = v[i][1]; s[2] = v[i][2]; s[3] = v[i][3]; }
    const int c = lane & 7;
    f32x4 g0 = (f32x4){cs, cs, cs, cs}, g1 = g0;
    if (gain) { g0 = *(const f32x4*)(gain + k0 + 8 * c) * cs; g1 = *(const f32x4*)(gain + k0 + 8 * c + 4) * cs; }
    LDS_FENCE();
#pragma unroll
    for (int j = 0; j < 4; ++j) { const int n = (lane >> 3) + 8 * j; const LAS float* s = scr + (8 * c) * 33 + n;
        u32x4 o; o.x = pk2(s[0 * 33] * g0[0], s[1 * 33] * g0[1]); o.y = pk2(s[2 * 33] * g0[2], s[3 * 33] * g0[3]); o.z = pk2(s[4 * 33] * g1[0], s[5 * 33] * g1[1]); o.w = pk2(s[6 * 33] * g1[2], s[7 * 33] * g1[3]);
        *(u32x4*)(WT + (size_t)(drow0 + n) * K + k0 + 8 * c) = o; }
    LDS_FENCE();
}
__device__ __forceinline__ void sincos_rr(float th, float& s, float& c) {
    const float k = rintf(th * 0.6366197723675814f);
    float r = fmaf(-k, 1.5707963705062866f, th); r = fmaf(-k, -4.371138828673793e-8f, r);
    const float r2 = r * r;
    const float sp = r + r * r2 * (-1.6666667e-1f + r2 * (8.3333333e-3f + r2 * (-1.9841270e-4f + r2 * 2.7557319e-6f)));
    const float cp = 1.0f + r2 * (-0.5f + r2 * (4.1666667e-2f + r2 * (-1.3888889e-3f + r2 * 2.4801587e-5f)));
    const int q = ((int)k) & 3;
    s = (q == 0) ? sp : (q == 1) ? cp : (q == 2) ? -sp : -cp;
    c = (q == 0) ? cp : (q == 1) ? -sp : (q == 2) ? -cp : sp;
}
__device__ __forceinline__ void prologue(const Args& a, LAS unsigned char* lds, int G) {
    int tid_ = threadIdx.x; asm volatile("" : "+v"(tid_));
    const int tid = tid_, lane = tid & 63, wave = __builtin_amdgcn_readfirstlane(tid >> 6);
    LAS float* scr = (LAS float*)(lds + wave * 16384);
    const int gw = blockIdx.x * NWAVES + wave, NGW = G * NWAVES;
    constexpr int I_GU = 16 * 88, I_D = 44 * 32, I_IN = 16 * 40, I_GLU = 8 * 16, I_O = 8 * 32;
    constexpr int C1 = I_GU, C2 = C1 + I_GU, C3 = C2 + I_D, C4 = C3 + I_IN, C5 = C4 + I_GLU, C6 = C5 + I_O, C7 = C6 + I_O, C8 = C7 + I_GU, C9 = C8 + I_GU, C10 = C9 + I_D;
    for (int it = gw; it < NLAYER * C10; it += NGW) {
        const int l = it / C10; int r = it % C10;
        unsigned char* wl = WSPTR() + WS_W + (size_t)l * W_LAYER;
        const float* W; int ldw, K, nblk; bf16* WT; const float* gain = nullptr; int mode = 0;
        if (r < C1)       { W = INP(3) + (size_t)l * 1024 * 2816; ldw = 2816; K = 1024; nblk = 88; WT = (bf16*)(wl + W_GU1); gain = INP(2) + l * 1024; mode = 1; }
        else if (r < C2)  { r -= C1; W = INP(4) + (size_t)l * 1024 * 2816; ldw = 2816; K = 1024; nblk = 88; WT = (bf16*)(wl + W_GU1); gain = INP(2) + l * 1024; mode = 2; }
        else if (r < C3)  { r -= C2; W = INP(5) + (size_t)l * 2816 * 1024; ldw = 1024; K = 2816; nblk = 32; WT = (bf16*)(wl + W_D1); }
        else if (r < C4)  { r -= C3; W = INP(7) + (size_t)l * 1024 * 1280; ldw = 1280; K = 1024; nblk = 40; WT = (bf16*)(wl + W_IN); gain = INP(6) + l * 1024; mode = 3; }
        else if (r < C5)  { r -= C4; W = INP(17) + (size_t)l * 512 * 512; ldw = 512; K = 512; nblk = 16; WT = (bf16*)(wl + W_GLU); }
        else if (r < C6)  { r -= C5; W = INP(21) + (size_t)l * 1024 * 1024; ldw = 1024; K = 1024; nblk = 32; WT = (bf16*)(wl + W_OA); gain = INP(19) + l * 512; }
        else if (r < C7)  { r -= C6; W = INP(21) + (size_t)l * 1024 * 1024 + (size_t)512 * 1024; ldw = 1024; K = 1024; nblk = 32; WT = (bf16*)(wl + W_OA) + 512; gain = INP(20) + l * 512; }
        else if (r < C8)  { r -= C7; W = INP(23) + (size_t)l * 1024 * 2816; ldw = 2816; K = 1024; nblk = 88; WT = (bf16*)(wl + W_GU2); gain = INP(22) + l * 1024; mode = 1; }
        else if (r < C9)  { r -= C8; W = INP(24) + (size_t)l * 1024 * 2816; ldw = 2816; K = 1024; nblk = 88; WT = (bf16*)(wl + W_GU2); gain = INP(22) + l * 1024; mode = 2; }
        else              { r -= C9; W = INP(25) + (size_t)l * 2816 * 1024; ldw = 1024; K = 2816; nblk = 32; WT = (bf16*)(wl + W_D2); }
        const int kb = r / nblk, nb = r % nblk, k0 = 64 * kb, n0 = 32 * nb;
        int drow0 = n0; float cs = 1.0f;
        if (mode == 1) drow0 = 256 * (n0 >> 7) + (n0 & 127);
        else if (mode == 2) drow0 = 256 * (n0 >> 7) + 128 + (n0 & 127);
        else if (mode == 3 && n0 < 512) cs = 0.125f * LOG2E;
        tr_item(W, ldw, K, WT, k0, n0, drow0, gain, cs, scr, lane);
    }
    {
        const float* x = INP(0); bf16* xb = (bf16*)(WSPTR() + WS_XB); float* ssq = (float*)(WSPTR() + WS_SSQ);
        for (int m = gw; m < NT; m += NGW) {
            const f32x4* xr = (const f32x4*)(x + (size_t)m * DM) + lane; u32x2* brow = (u32x2*)(xb + (size_t)m * DM) + lane;
            float s = 0.f;
#pragma unroll
            for (int j = 0; j < 4; ++j) { const f32x4 v = xr[64 * j]; u32x2 w; w.x = pk2(v[0], v[1]); w.y = pk2(v[2], v[3]); brow[64 * j] = w; s += (v[0] * v[0] + v[1] * v[1]) + (v[2] * v[2] + v[3] * v[3]); }
            s = wave_sum(s);
            if (lane < 16) ssq[((size_t)(lane >> 2) * NT + m) * 4 + (lane & 3)] = (lane == 0) ? s : 0.f;
        }
    }
    {
        f32x2* AB = (f32x2*)(WSPTR() + WS_ABAR); f32x2* AP = (f32x2*)(WSPTR() + WS_APOW); bf16* BB = (bf16*)(WSPTR() + WS_BB); bf16* CC = (bf16*)(WSPTR() + WS_CC);
        for (int cb = gw; cb < NLAYER * 2 * 32; cb += NGW) {
            const int p = lane;
            const float dt = __expf(INP(11)[cb]);
            const float are = INP(9)[cb * 64 + p], aim = INP(10)[cb * 64 + p];
            const float mag = __expf(dt * are); float sn, cs; sincos_rr(dt * aim, sn, cs);
            const float abr = mag * cs, abi = mag * sn;
            const float den = are * are + aim * aim, nr = abr - 1.0f, ni = abi;
            const float kr = (nr * are + ni * aim) / den, ki = (ni * are - nr * aim) / den;
            AB[cb * 64 + p] = (f32x2){abr, abi};
            float pr = abr, pi = abi;
#pragma unroll
            for (int q = 0; q < 9; ++q) { const float t0 = pr * pr - pi * pi, t1 = 2.0f * pr * pi; pr = t0; pi = t1; }
            AP[cb * 64 + p] = (f32x2){pr, pi};
            scr[2 * p] = kr; scr[2 * p + 1] = ki;
            LDS_FENCE();
            const float* bre = INP(12) + (size_t)cb * 64 * 16; const float* bim = INP(13) + (size_t)cb * 64 * 16;
            const float* cre = INP(14) + (size_t)cb * 16 * 64; const float* cim = INP(15) + (size_t)cb * 16 * 64;
#pragma unroll
            for (int tile = 0; tile < 4; ++tile) {
                const int pp = 32 * (tile & 1) + (lane & 31); const float kr2 = scr[2 * pp], ki2 = scr[2 * pp + 1];
                unsigned w[4];
#pragma unroll
                for (int j2 = 0; j2 < 4; ++j2) { float v[2];
#pragma unroll
                    for (int e = 0; e < 2; ++e) { const int h = 8 * (lane >> 5) + 2 * j2 + e; const float br = bre[pp * 16 + h], bi = bim[pp * 16 + h];
                        v[e] = (tile >> 1) ? (kr2 * bi + ki2 * br) : (kr2 * br - ki2 * bi); }
                    w[j2] = pk2(v[0], v[1]); }
                *(u32x4*)(BB + ((size_t)(cb * 4 + tile) * 64 + lane) * 8) = (u32x4){w[0], w[1], w[2], w[3]};
            }
#pragma unroll
            for (int kk = 0; kk < 4; ++kk) {
                unsigned w[4];
#pragma unroll
                for (int j2 = 0; j2 < 4; ++j2) { const int kap = 32 * kk + 8 * (lane >> 4) + 2 * j2, pp = kap >> 1, h = lane & 15;
                    w[j2] = pk2(cre[h * 64 + pp], -cim[h * 64 + pp]); }
                *(u32x4*)(CC + ((size_t)(cb * 4 + kk) * 64 + lane) * 8) = (u32x4){w[0], w[1], w[2], w[3]};
            }
            LDS_FENCE();
        }
    }
}

__device__ __forceinline__ void attn_phase(const Args& a, LAS unsigned char* lds, int layer, int G) {
    int tid_ = threadIdx.x; asm volatile("" : "+v"(tid_));
    const int tid = tid_, lane = tid & 63, h = __builtin_amdgcn_readfirstlane(tid >> 6), kvh = h >> 2;
    LAS float* biasT = (LAS float*)lds;
    LAS float* red = (LAS float*)(lds + 10240);
    const float* tab = INP(1);
    for (int e = tid; e < 8 * 320; e += NTHREADS) {
        const int hh = e / 320, ri = e % 320 - 32; float v = -1e30f;
        if (ri >= 0 && ri <= 256) { const int rel = ri - 128, n = rel < 0 ? -rel : rel; int bk = (rel > 0) ? 16 : 0;
            if (n < 8) bk += n; else { int lg = 2 + (31 - __builtin_clz((unsigned)(n * n))); bk += (lg < 15 ? lg : 15); }
            v = tab[bk * 8 + hh] * LOG2E; }
        biasT[e] = v;
    }
    __syncthreads();
    const bf16* proj = (const bf16*)(WSPTR() + WS_PROJ); const bf16* vT = (const bf16*)(WSPTR() + WS_VT); bf16* an = (bf16*)(WSPTR() + WS_MIX); const float* ssq2p = (const float*)(WSPTR() + WS_SSQ2);
    const float sinkv = INP(8)[layer * 8 + h] * LOG2E;
    const int ql = lane & 31, hi = lane >> 5;
    int par = 0;
    for (int ui = blockIdx.x; ui < 1024; ui += G, par ^= 1) {
        const int b = ui >> 7, q0 = (ui & 127) * 32, rowq = b * SEQ + q0;
        const bf16* qp = proj + (size_t)(rowq + ql) * DIN + h * 64 + 8 * hi;
        bf16x8 qf[4];
#pragma unroll
        for (int kk = 0; kk < 4; ++kk) qf[kk] = *(const bf16x8*)(qp + 16 * kk);
        float m = sinkv, lsum = 1.0f;
        f32x16 o0, o1;
#pragma unroll
        for (int r = 0; r < 16; ++r) { o0[r] = 0.f; o1[r] = 0.f; }
        const bf16* vbase = vT + ((size_t)(b * 2 + kvh) * 64 + ql) * SEQ + 4 * hi;
        const bf16* kbase = proj + (size_t)(b * SEQ + ql) * DIN + 512 + kvh * 64 + 8 * hi;
        const int rb = ui & 127, kt_lo = (4 - rb) > 0 ? (4 - rb) : 0, kt_hi = (132 - rb) < 9 ? (132 - rb) : 9;
        bf16x8 kf[4]; s16x4 vf[2][2][2];
#define ATT_LOAD(KF, VF, kt_) do { const int key0_ = q0 - 128 + 32 * (kt_); const bf16* kp_ = kbase + (size_t)key0_ * DIN; \
            _Pragma("unroll") for (int kk = 0; kk < 4; ++kk) KF[kk] = *(const bf16x8*)(kp_ + 16 * kk); \
            _Pragma("unroll") for (int dt = 0; dt < 2; ++dt) _Pragma("unroll") for (int s = 0; s < 2; ++s) { const bf16* vp_ = vbase + (size_t)(32 * dt) * SEQ + key0_ + 16 * s; VF[dt][s][0] = *(const s16x4*)vp_; VF[dt][s][1] = *(const s16x4*)(vp_ + 8); } } while (0)
        bf16x8 kg[4]; s16x4 vg[2][2][2];
#define ATT_TILE(KF, VF, kt_) do { \
            const LAS float* bt = biasT + h * 320 + 32 * (kt_) + 32 - ql + 4 * hi; \
            f32x16 st; \
            _Pragma("unroll") for (int r = 0; r < 16; ++r) st[r] = bt[(r & 3) + 8 * (r >> 2)]; \
            _Pragma("unroll") for (int kk = 0; kk < 4; ++kk) st = __builtin_amdgcn_mfma_f32_32x32x16_bf16(KF[kk], qf[kk], st, 0, 0, 0); \
            float tmax = st[0]; \
            _Pragma("unroll") for (int r = 1; r < 16; ++r) tmax = fmaxf(tmax, st[r]); \
            tmax = fmaxf(tmax, __shfl_xor(tmax, 32)); \
            if (__builtin_amdgcn_ballot_w64(tmax > m) != 0ull) { \
                const float mnew = fmaxf(m, tmax), alpha = __builtin_amdgcn_exp2f(m - mnew); m = mnew; lsum *= alpha; \
                _Pragma("unroll") for (int r = 0; r < 16; ++r) { o0[r] *= alpha; o1[r] *= alpha; } } \
            float ps = 0.f; \
            _Pragma("unroll") for (int r = 0; r < 16; ++r) { st[r] = __builtin_amdgcn_exp2f(st[r] - m); ps += st[r]; } \
            ps += __shfl_xor(ps, 32); lsum += ps; \
            bf16x8 pf[2]; \
            _Pragma("unroll") for (int s = 0; s < 2; ++s) { u32x4 w; w.x = pk2(st[8 * s + 0], st[8 * s + 1]); w.y = pk2(st[8 * s + 2], st[8 * s + 3]); w.z = pk2(st[8 * s + 4], st[8 * s + 5]); w.w = pk2(st[8 * s + 6], st[8 * s + 7]); \
                pf[s] = __builtin_bit_cast(bf16x8, w); } \
            _Pragma("unroll") for (int s = 0; s < 2; ++s) { \
                const bf16x8 v0 = __builtin_shufflevector(VF[0][s][0], VF[0][s][1], 0, 1, 2, 3, 4, 5, 6, 7); \
                const bf16x8 v1 = __builtin_shufflevector(VF[1][s][0], VF[1][s][1], 0, 1, 2, 3, 4, 5, 6, 7); \
                o0 = __builtin_amdgcn_mfma_f32_32x32x16_bf16(v0, pf[s], o0, 0, 0, 0); \
                o1 = __builtin_amdgcn_mfma_f32_32x32x16_bf16(v1, pf[s], o1, 0, 0, 0); } } while (0)
        ATT_LOAD(kf, vf, kt_lo);
        for (int kt = kt_lo; kt < kt_hi; kt += 2) {
            { const int ktn = (kt + 1 < kt_hi) ? kt + 1 : kt; ATT_LOAD(kg, vg, ktn); }
            ATT_TILE(kf, vf, kt);
            if (kt + 1 < kt_hi) {
                { const int ktn = (kt + 2 < kt_hi) ? kt + 2 : kt + 1; ATT_LOAD(kf, vf, ktn); }
                ATT_TILE(kg, vg, kt + 1);
            }
        }
#undef ATT_TILE
#undef ATT_LOAD
        const float inv = 1.0f / lsum;
        float ss = 0.f;
#pragma unroll
        for (int r = 0; r < 16; ++r) { o0[r] *= inv; o1[r] *= inv; ss += o0[r] * o0[r] + o1[r] * o1[r]; }
        ss += __shfl_xor(ss, 32);
        LAS float* rd = red + par * 256;
        if (hi == 0) rd[h * 32 + ql] = ss;
        __syncthreads();
        float tot = 0.f;
#pragma unroll
        for (int hh = 0; hh < 8; ++hh) tot += rd[hh * 32 + ql];
        const f32x4 sq = *(const f32x4*)(ssq2p + ((size_t)hi * NT + rowq + ql) * 4);
        float ts = (sq[0] + sq[1]) + (sq[2] + sq[3]); ts += __shfl_xor(ts, 32);
        const float rstd = __builtin_amdgcn_rsqf(tot * (1.0f / 512.0f) + 1e-6f) * __builtin_amdgcn_sqrtf(ts * (1.0f / 512.0f) + 1e-6f);
        bf16* op = an + (size_t)(rowq + ql) * 1024 + h * 64 + 4 * hi;
#pragma unroll
        for (int g4 = 0; g4 < 4; ++g4) {
            u32x2 w0, w1;
            w0.x = pk2(o0[4 * g4] * rstd, o0[4 * g4 + 1] * rstd); w0.y = pk2(o0[4 * g4 + 2] * rstd, o0[4 * g4 + 3] * rstd);
            w1.x = pk2(o1[4 * g4] * rstd, o1[4 * g4 + 1] * rstd); w1.y = pk2(o1[4 * g4 + 2] * rstd, o1[4 * g4 + 3] * rstd);
            *(u32x2*)(op + 8 * g4) = w0; *(u32x2*)(op + 32 + 8 * g4) = w1;
        }
    }
}

constexpr int XS_STRIDE = 68;
template <bool BWD, int MODE  >
__device__ __forceinline__ void ssm_pass(const bf16* proj, int rowbase, int g, const bf16x8* BBp, const bf16x8* CCp, float ar, float ai, float& sr, float& si,
                                         LAS unsigned* XS, int lane, f32x4* ysc, const float* Dp, bf16* zbuf) {
    bf16x8 bb[4], cc[4];
#pragma unroll
    for (int t = 0; t < 4; ++t) { bb[t] = BBp[t * 64 + lane]; if (MODE > 0) cc[t] = CCp[t * 64 + lane]; }
    const int ql = lane & 31, hi = lane >> 5;
    const bf16* up = proj + (size_t)(rowbase + ql) * DIN + 768 + g * 16 + 8 * hi;
    bf16x8 ucur = *(const bf16x8*)(up + (size_t)(BWD ? 15 : 0) * 32 * DIN);
    float dval = 0.f; if (MODE == 2) dval = Dp[g * 16 + (lane & 15)];
    for (int c = 0; c < 16; ++c) {
        const int ch = BWD ? 15 - c : c;
        bf16x8 unext = ucur;
        if (c < 15) unext = *(const bf16x8*)(up + (size_t)(BWD ? ch - 1 : ch + 1) * 32 * DIN);
        f32x4 y0 = (f32x4){0.f, 0.f, 0.f, 0.f}, y1 = y0; bf16 uvl[8];
        if (MODE == 2) {
            y0 = ysc[(ch * 2 + 0) * 64 + lane]; y1 = ysc[(ch * 2 + 1) * 64 + lane];
#pragma unroll
            for (int q = 0; q < 8; ++q) uvl[q] = proj[(size_t)(rowbase + 32 * ch + 16 * (q >> 2) + 4 * (lane >> 4) + (q & 3)) * DIN + 768 + g * 16 + (lane & 15)];
        }
        f32x16 z16;
#pragma unroll
        for (int r = 0; r < 16; ++r) z16[r] = 0.f;
        const f32x16 x0 = __builtin_amdgcn_mfma_f32_32x32x16_bf16(ucur, bb[0], z16, 0, 0, 0);
        const f32x16 x1 = __builtin_amdgcn_mfma_f32_32x32x16_bf16(ucur, bb[1], z16, 0, 0, 0);
        const f32x16 x2 = __builtin_amdgcn_mfma_f32_32x32x16_bf16(ucur, bb[2], z16, 0, 0, 0);
        const f32x16 x3 = __builtin_amdgcn_mfma_f32_32x32x16_bf16(ucur, bb[3], z16, 0, 0, 0);
#pragma unroll
        for (int r = 0; r < 16; ++r) { const int t = crow(r, hi); XS[t * XS_STRIDE + ql] = pk2(x0[r], x2[r]); XS[t * XS_STRIDE + 32 + ql] = pk2(x1[r], x3[r]); }
        LDS_FENCE();
#pragma unroll
        for (int tt = 0; tt < 32; ++tt) {
            const int t = BWD ? 31 - tt : tt;
            const unsigned v = XS[t * XS_STRIDE + lane];
            const float nr = fmaf(ar, sr, fmaf(-ai, si, bflo(v))), ni = fmaf(ar, si, fmaf(ai, sr, bfhi(v)));
            sr = nr; si = ni;
            if (MODE > 0) XS[t * XS_STRIDE + lane] = pk2(sr, si);
        }
        if (MODE > 0) {
            LDS_FENCE();
            const LAS unsigned char* ab = (const LAS unsigned char*)XS + (lane & 15) * (XS_STRIDE * 4) + (lane >> 4) * 16;
#pragma unroll
            for (int kk = 0; kk < 4; ++kk) {
                const bf16x8 a0 = *(const LAS bf16x8*)(ab + kk * 64), a1 = *(const LAS bf16x8*)(ab + 16 * XS_STRIDE * 4 + kk * 64);
                y0 = __builtin_amdgcn_mfma_f32_16x16x32_bf16(a0, cc[kk], y0, 0, 0, 0);
                y1 = __builtin_amdgcn_mfma_f32_16x16x32_bf16(a1, cc[kk], y1, 0, 0, 0);
            }
            if (MODE == 1) { ysc[(ch * 2 + 0) * 64 + lane] = y0; ysc[(ch * 2 + 1) * 64 + lane] = y1; }
            else {
                const int hcol = g * 16 + (lane & 15);
#pragma unroll
                for (int rt = 0; rt < 2; ++rt)
#pragma unroll
                    for (int i = 0; i < 4; ++i) {
                        const int row = rowbase + 32 * ch + 16 * rt + 4 * (lane >> 4) + i;
                        const float uv = bf2f(uvl[rt * 4 + i]);
                        const float y = (rt ? y1[i] : y0[i]) + dval * uv;
                        const float zz = y * __builtin_amdgcn_rcpf(1.0f + __builtin_amdgcn_exp2f(-2.3022082f * (y + 0.044715f * y * y * y)));
                        zbuf[(size_t)row * 512 + hcol] = (bf16)f2bf(zz);
                    }
            }
            LDS_FENCE();
        }
        ucur = unext;
    }
}

__device__ __forceinline__ void ssm_p1(const Args& a, LAS unsigned char* lds, int layer, int G) {
    int tid_ = threadIdx.x; asm volatile("" : "+v"(tid_));
    const int tid = tid_, lane = tid & 63, wave = __builtin_amdgcn_readfirstlane(tid >> 6);
    LAS unsigned* XS = (LAS unsigned*)(lds + 16384 + wave * (32 * XS_STRIDE * 4));
    const bf16* proj = (const bf16*)(WSPTR() + WS_PROJ);
    const f32x2* AB = (const f32x2*)(WSPTR() + WS_ABAR); f32x2* SE = (f32x2*)(WSPTR() + WS_SEGE);
    const int gw = blockIdx.x * NWAVES + wave, NGW = G * NWAVES;
    for (int wt = gw; wt < 4096; wt += NGW) {
        const int dir = wt & 1, seg = (wt >> 1) & 7, g = (wt >> 4) & 31, b = wt >> 9;
        const int cb = (layer * 2 + dir) * 32 + g;
        const f32x2 ab = AB[cb * 64 + lane];
        float sr = 0.f, si = 0.f;
        const bf16x8* BBp = (const bf16x8*)(WSPTR() + WS_BB) + (size_t)cb * 4 * 64;
        const int rowbase = b * SEQ + seg * 512;
        if (dir) ssm_pass<true, 0>(proj, rowbase, g, BBp, nullptr, ab[0], ab[1], sr, si, XS, lane, nullptr, nullptr, nullptr);
        else     ssm_pass<false, 0>(proj, rowbase, g, BBp, nullptr, ab[0], ab[1], sr, si, XS, lane, nullptr, nullptr, nullptr);
        SE[((size_t)((b * 32 + g) * 2 + dir) * 8 + seg) * 64 + lane] = (f32x2){sr, si};
    }
}
__device__ __forceinline__ void ssm_p3(const Args& a, LAS unsigned char* lds, int layer, int G) {
    int tid_ = threadIdx.x; asm volatile("" : "+v"(tid_));
    const int tid = tid_, lane = tid & 63, wave = __builtin_amdgcn_readfirstlane(tid >> 6);
    LAS unsigned* XS = (LAS unsigned*)(lds + 16384 + wave * (32 * XS_STRIDE * 4));
    const bf16* proj = (const bf16*)(WSPTR() + WS_PROJ); bf16* zbuf = (bf16*)(WSPTR() + WS_Z);
    const f32x2* AB = (const f32x2*)(WSPTR() + WS_ABAR); const f32x2* AP = (const f32x2*)(WSPTR() + WS_APOW); const f32x2* SE = (const f32x2*)(WSPTR() + WS_SEGE);
    const int gw = blockIdx.x * NWAVES + wave, NGW = G * NWAVES;
    (void)gw; (void)NGW;
    for (int wg = blockIdx.x; wg < 256; wg += G) {
        const int wt = wg * 8 + wave, g = (wg & 3) * 8 + wave, seg = (wg >> 2) & 7, b = wg >> 5;
        const int rowbase = b * SEQ + seg * 512;
        f32x4* ysc = (f32x4*)(WSPTR() + WS_YSCR) + (size_t)wt * (16 * 2 * 64);
        {
            const int cb = (layer * 2 + 1) * 32 + g;
            const f32x2 ab = AB[cb * 64 + lane], ap = AP[cb * 64 + lane];
            const f32x2* se = SE + ((size_t)((b * 32 + g) * 2 + 1) * 8) * 64 + lane;
            float sr = 0.f, si = 0.f;
            for (int k = 7; k > seg && !DIAG_NOCARRY; --k) { const f32x2 e = se[k * 64]; const float nr = ap[0] * sr - ap[1] * si + e[0], ni = ap[0] * si + ap[1] * sr + e[1]; sr = nr; si = ni; }
            ssm_pass<true, 1>(proj, rowbase, g, (const bf16x8*)(WSPTR() + WS_BB) + (size_t)cb * 256, (const bf16x8*)(WSPTR() + WS_CC) + (size_t)cb * 256, ab[0], ab[1], sr, si, XS, lane, ysc, nullptr, nullptr);
        }
        {
            const int cb = (layer * 2 + 0) * 32 + g;
            const f32x2 ab = AB[cb * 64 + lane], ap = AP[cb * 64 + lane];
            const f32x2* se = SE + ((size_t)((b * 32 + g) * 2 + 0) * 8) * 64 + lane;
            float sr = 0.f, si = 0.f;
            for (int k = 0; k < seg && !DIAG_NOCARRY; ++k) { const f32x2 e = se[k * 64]; const float nr = ap[0] * sr - ap[1] * si + e[0], ni = ap[0] * si + ap[1] * sr + e[1]; sr = nr; si = ni; }
            ssm_pass<false, 2>(proj, rowbase, g, (const bf16x8*)(WSPTR() + WS_BB) + (size_t)cb * 256, (const bf16x8*)(WSPTR() + WS_CC) + (size_t)cb * 256, ab[0], ab[1], sr, si, XS, lane, ysc, INP(16) + layer * 512, zbuf);
        }
    }
}

__device__ __forceinline__ void final_norm(const Args& a, int G) {
    int tid_ = threadIdx.x; asm volatile("" : "+v"(tid_));
    const int tid = tid_, lane = tid & 63, wave = __builtin_amdgcn_readfirstlane(tid >> 6);
    const int gw = blockIdx.x * NWAVES + wave, NGW = G * NWAVES;
    const float* ssq = (const float*)(WSPTR() + WS_SSQ); const bf16* xb = (const bf16*)(WSPTR() + WS_XB); float* out = OUTPTR();
    const f32x4* gn = (const f32x4*)INP(26) + 2 * lane;
    f32x4 gv[2][2];
#pragma unroll
    for (int j = 0; j < 2; ++j) { gv[j][0] = gn[128 * j]; gv[j][1] = gn[128 * j + 1]; }
    for (int m = gw; m < NT; m += NGW) {
        float s = (lane < 16) ? ssq[((size_t)(lane >> 2) * NT + m) * 4 + (lane & 3)] : 0.f; s = wave_sum(s);
        const float rs = __builtin_amdgcn_rsqf(s * (1.0f / 1024.0f) + 1e-6f);
        const u32x4* xr = (const u32x4*)(xb + (size_t)m * DM) + lane; f32x4* orow = (f32x4*)(out + (size_t)m * DM) + 2 * lane;
#pragma unroll
        for (int j = 0; j < 2; ++j) { const u32x4 w = xr[64 * j];
            orow[128 * j] = (f32x4){bflo(w.x), bfhi(w.x), bflo(w.y), bfhi(w.y)} * rs * gv[j][0];
            orow[128 * j + 1] = (f32x4){bflo(w.z), bfhi(w.z), bflo(w.w), bfhi(w.w)} * rs * gv[j][1]; }
    }
}

#define XB_TMO      128
#define XB_XCNT(j)  (256  + 64 * (j))
#define XB_XSUB(j)  (1280 + 64 * (j))
#define XB_XGEN(j)  (2304 + 64 * (j))
#define XB_TOP      3328
#define XB_TOPGEN   3392
#define XCD_BAR_WORDS 3456
#define XB_SPIN_CAP (1u << 18)

__device__ __forceinline__ unsigned xb_ld(unsigned* p)              { return __hip_atomic_load(p, __ATOMIC_RELAXED, __HIP_MEMORY_SCOPE_AGENT); }
__device__ __forceinline__ unsigned xb_add(unsigned* p, unsigned v) { return __hip_atomic_fetch_add(p, v, __ATOMIC_RELAXED, __HIP_MEMORY_SCOPE_AGENT); }
__device__ __forceinline__ unsigned xb_xcc_id() { return (unsigned)__builtin_amdgcn_s_getreg((3 << 11) | 20) & 0xFu; }
#define XB_SPIN(cond, bar) do { unsigned _sp = 0; while (cond) { __builtin_amdgcn_s_sleep(1); \
    if ((++_sp & 255u) == 0u) { if (xb_ld(&(bar)[XB_TMO])) break; if (_sp > XB_SPIN_CAP) { atomicAdd(&(bar)[XB_TMO], 1u); break; } } } } while (0)

struct XcdBarrier {
    unsigned* bar; unsigned x;
    volatile LAS unsigned* st;
};

__device__ __forceinline__ XcdBarrier xcd_barrier_post(unsigned* bar, volatile LAS unsigned* st) {
    XcdBarrier b; b.bar = bar; b.x = xb_xcc_id(); b.st = st;
    if (threadIdx.x == 0) (void)xb_add(&bar[XB_XCNT(b.x)], 1u);
    return b;
}
__device__ __forceinline__ void xcd_barrier_complete(unsigned* bar, unsigned x, unsigned& nloc, unsigned& nx) {
    const unsigned G = gridDim.x * gridDim.y * gridDim.z;
    unsigned sum, cnt, mine, sp = 0u;
    for (;;) {
        sum = 0u; cnt = 0u; mine = 0u;
#pragma unroll
        for (unsigned j = 0; j < 16; ++j) { const unsigned c = xb_ld(&bar[XB_XCNT(j)]); sum += c; cnt += (c > 0u) ? 1u : 0u; mine = (j == x) ? c : mine; }
        if (sum == G) break;
        __builtin_amdgcn_s_sleep(1);
        if ((++sp & 255u) == 0u) { if (xb_ld(&bar[XB_TMO])) break; if (sp > XB_SPIN_CAP) { atomicAdd(&bar[XB_TMO], 1u); break; } }
    }
    nloc = mine > 0u ? mine : 1u; nx = cnt > 0u ? cnt : 1u;
}

__device__ __forceinline__ void xcd_barrier(const XcdBarrier& b) {
    asm volatile("s_waitcnt vmcnt(0)" ::: "memory");
    __syncthreads();
    if (threadIdx.x == 0) {
        unsigned* bar = b.bar;
        __builtin_amdgcn_s_waitcnt(0);
        unsigned nloc = b.st[0], nx = b.st[1];
        if (nloc == 0u) { xcd_barrier_complete(bar, b.x, nloc, nx); b.st[0] = nloc; b.st[1] = nx; }
        const unsigned old = xb_add(&bar[XB_XSUB(b.x)], 1u);
        const unsigned gen = old / nloc;
        if (old + 1u == (gen + 1u) * nloc) {
            __builtin_amdgcn_fence(__ATOMIC_RELEASE, "agent");
            asm volatile("s_waitcnt vmcnt(0)" ::: "memory");
            const unsigned og = xb_add(&bar[XB_TOP], 1u);
            const unsigned tg = og / nx;
            if (og + 1u == (tg + 1u) * nx) xb_add(&bar[XB_TOPGEN], 1u);
            else XB_SPIN(xb_ld(&bar[XB_TOPGEN]) == tg, bar);
            __builtin_amdgcn_fence(__ATOMIC_ACQUIRE, "agent");
            xb_add(&bar[XB_XGEN(b.x)], 1u);
            asm volatile("s_waitcnt vmcnt(0)" ::: "memory");
        } else {
            XB_SPIN(xb_ld(&bar[XB_XGEN(b.x)]) == gen, bar);
            __builtin_amdgcn_fence(__ATOMIC_ACQUIRE, "agent");
            asm volatile("s_waitcnt vmcnt(0)" ::: "memory");
        }
    }
    __syncthreads();
}

#define GRID_SYNC() do { XcdBarrier xb_; xb_.bar = (unsigned*)(WSPTR() + WS_CTL); xb_.x = xb_xcc_id(); xb_.st = (volatile LAS unsigned*)((LAS unsigned char*)lds_raw + (LDS_BYTES - 64)); xcd_barrier(xb_); } while (0)
__global__ void __launch_bounds__(NTHREADS, 2) hymba_fwd(Args a) {
    extern __shared__ __attribute__((aligned(16))) unsigned char lds_raw[];
    LAS unsigned char* lds = (LAS unsigned char*)lds_raw;
    cg::grid_group grid = cg::this_grid();
    const int G = gridDim.x, bid = blockIdx.x;
    volatile LAS unsigned* misc = (volatile LAS unsigned*)(lds + LDS_BYTES - 64);
    if (threadIdx.x < 16) misc[threadIdx.x] = 0u;
    __syncthreads();
    (void)xcd_barrier_post((unsigned*)(WSPTR() + WS_CTL), misc);
    grid.sync();
#define ws WSPTR()
#define xf OUTPTR()
#define xb ((pg8::bf16_t*)(WSPTR() + WS_XB))
#define ssq ((float*)(WSPTR() + WS_SSQ))
#define ssq2 ((float*)(WSPTR() + WS_SSQ2))
#define Hb ((pg8::bf16_t*)(WSPTR() + WS_H))
#define projb ((pg8::bf16_t*)(WSPTR() + WS_PROJ))
#define vTb ((pg8::bf16_t*)(WSPTR() + WS_VT))
#define mixb ((pg8::bf16_t*)(WSPTR() + WS_MIX))
#define zb ((pg8::bf16_t*)(WSPTR() + WS_Z))

    prologue(a, lds, G);
    GRID_SYNC();
    for (int st = 0; st < 2 * NLAYER; ++st) {
        const int layer = st >> 1, second = st & 1;
        const unsigned char* wl = ws + WS_W + (size_t)layer * W_LAYER;
        {
            pg8::Gemm g{xb, (const pg8::bf16_t*)(wl + (second ? W_GU2 : W_GU1)), NT, 2 * DFF, DM}; pg8::StaticOrder S; S.init(NT, 2 * DFF, G, bid);
            pg8::EpiSwiGLU E{Hb, ssq};
            for (int rep = 0; rep < 1 + DUP_G1; ++rep) {
            pg8::gemm_phase<pg8::EpiSwiGLU, pg8::StaticOrder, true, true>(lds, g, S, E);
            GRID_SYNC(); }
            pg8::Gemm g2{Hb, (const pg8::bf16_t*)(wl + (second ? W_D2 : W_D1)), NT, DM, DFF}; pg8::StaticOrder S2; S2.init(NT, DM, G, bid);
            pg8::EpiResid<false> E2{xb, ssq, nullptr, 0.5f};
            pg8::gemm_phase<pg8::EpiResid<false>, pg8::StaticOrder, true, true>(lds, g2, S2, E2);
            GRID_SYNC();
        }
        if (!second && DIAG_MIXER) {
            {
                pg8::Gemm g{xb, (const pg8::bf16_t*)(wl + W_IN), NT, DIN, DM}; pg8::StaticOrder S; S.init(NT, DIN, G, bid);
                pg8::EpiProj E{projb, vTb, ssq};
                pg8::gemm_phase<pg8::EpiProj, pg8::StaticOrder, true, true>(lds, g, S, E);
                GRID_SYNC();
            }
            for (int rep = 0; rep < N_P1; ++rep) ssm_p1(a, lds, layer, G);
            GRID_SYNC();
            for (int rep = 0; rep < N_P3; ++rep) ssm_p3(a, lds, layer, G);
            GRID_SYNC();
            {
                pg8::Gemm g{zb, (const pg8::bf16_t*)(wl + W_GLU), NT, 512, 512}; pg8::StaticOrder S; S.init(NT, 512, G, bid);
                pg8::EpiGlu E{zb, mixb, INP(18) + layer * 512, ssq2};
                pg8::gemm_phase<pg8::EpiGlu, pg8::StaticOrder, true, true>(lds, g, S, E);
                GRID_SYNC();
            }
            for (int rep = 0; rep < N_ATT; ++rep) attn_phase(a, lds, layer, G);
            GRID_SYNC();
            {
                pg8::Gemm g{mixb, (const pg8::bf16_t*)(wl + W_OA), NT, DM, 1024}; pg8::StaticOrder S; S.init(NT, DM, G, bid);
                pg8::EpiResid<true> E{xb, ssq, ssq2, 1.0f};
                pg8::gemm_phase<pg8::EpiResid<true>, pg8::StaticOrder, true, true>(lds, g, S, E);
                GRID_SYNC();
            }
        }
    }
    final_norm(a, G);
}

#undef ws
#undef xf
#undef xb
#undef ssq
#undef ssq2
#undef Hb
#undef projb
#undef vTb
#undef mixb
#undef zb
extern "C" void kernel_launch(void* const* d_in, const int* in_sizes, int n_in, void* d_out, int out_size, void* d_ws, size_t ws_size, hipStream_t stream) {
    static int grid = 0;
    if (grid == 0) {
        if (n_in != 27 || out_size != NT * DM || ws_size < WS_END) { fprintf(stderr, "kernel_launch: unexpected shapes: n_in %d out %d ws %zu (need %zu)\n", n_in, out_size, ws_size, (size_t)WS_END); grid = -1; return; }
        int dev = 0, cus = 0, per_cu = 0;
        hipGetDevice(&dev); hipDeviceGetAttribute(&cus, hipDeviceAttributeMultiprocessorCount, dev);
        hipFuncSetAttribute((const void*)hymba_fwd, hipFuncAttributeMaxDynamicSharedMemorySize, LDS_BYTES);
        hipOccupancyMaxActiveBlocksPerMultiprocessor(&per_cu, (const void*)hymba_fwd, NTHREADS, LDS_BYTES);
        if (per_cu < 1) { fprintf(stderr, "kernel_launch: occupancy query says %d blocks per CU\n", per_cu); per_cu = 1; }
        (void)hipGetLastError();
        grid = cus * per_cu;
        fprintf(stderr, "kernel_launch: grid %d (%d CUs x %d)\n", grid, cus, per_cu);
    }
    if (grid < 0) return;
    if (hipMemsetAsync((char*)d_ws + WS_CTL, 0, CTL_BYTES, stream) != hipSuccess) { fprintf(stderr, "kernel_launch: memset of the barrier words failed\n"); return; }
    Args a{};
    for (int i = 0; i < 27; ++i) a.in[i] = (const float*)d_in[i];
    a.out = (float*)d_out; a.ws = (unsigned char*)d_ws;
    void* args[] = {&a};
    hipError_t e = hipLaunchCooperativeKernel((const void*)hymba_fwd, dim3(grid), dim3(NTHREADS), args, LDS_BYTES, stream);
    if (e != hipSuccess) fprintf(stderr, "cooperative launch failed: %s (grid %d)\n", hipGetErrorString(e), grid);
}
```

```cpp
#include <hip/hip_runtime.h>
#include <hip/hip_cooperative_groups.h>
#include <cstdio>
#include <cstdint>
namespace cg = cooperative_groups;
namespace pg8 {
#define PG8_LAS __attribute__((address_space(3)))
typedef unsigned short bf16_t;
typedef short bf16x8 __attribute__((ext_vector_type(8)));
typedef float f32x4 __attribute__((ext_vector_type(4)));
typedef unsigned u32x4 __attribute__((ext_vector_type(4)));
constexpr int BM = 256, BK = 64, HALF = 128, HTB = HALF * BK * 2  , STAGE_BYTES = 8 * HTB, NXCD = 8, WGM = 8;

__host__ __device__ __forceinline__ int lds_byte(int r, int c) { const int st = (r >> 4) * 2 + (c >> 5), rr = r & 15, cc = c & 31, ob = rr * 64 + cc * 2; return st * 1024 + (ob ^ (((ob >> 9) & 1) << 5)); }
__host__ __device__ __forceinline__ void stage_rc(int b, int& R, int& C) { const int st = b / 1024, sb = b % 1024, swz = sb ^ (((sb >> 9) & 1) << 5); R = (st >> 1) * 16 + swz / 64; C = (st & 1) * 32 + (swz % 64) / 2; }
__host__ __device__ __forceinline__ int perm32(int rho) { const int n = rho >> 4, i = rho & 15; return 8 * (i >> 2) + 4 * n + (i & 3); }

struct Unit { int pm, pn; };
struct Gemm { const bf16_t* A; const bf16_t* Bt; int M, N, K; };

struct StaticOrder {
    int nM, nN, nwg, G, c;
    __host__ __device__ void init(int M, int N, int G_, int c_) { nM = M / BM; nN = N / BM; nwg = nM * nN; G = G_; c = c_; }
    __host__ __device__ bool next(int i, Unit& u) const {
        const long L = (long)i * G + c; if (L >= nwg) return false;
        int wgid = (int)L; { const int q = nwg / NXCD, r = nwg % NXCD, xcd = wgid % NXCD, off = wgid / NXCD; wgid = (xcd < r ? xcd * (q + 1) : r * (q + 1) + (xcd - r) * q) + off; }
        const int nig = WGM * nN, gid = wgid / nig, fm = gid * WGM, gsz = (nM - fm) < WGM ? (nM - fm) : WGM;
        u.pm = fm + ((wgid % nig) % gsz); u.pn = (wgid % nig) / gsz; return true;
    }
    __device__ __forceinline__ void a_ready(const Unit&) const {}
    __device__ __forceinline__ void done(const Unit&) const {}
};

typedef float f32x2 __attribute__((ext_vector_type(2)));
typedef __bf16 bf16x2_t __attribute__((ext_vector_type(2)));
__device__ __forceinline__ unsigned cvt_pk_bf16(float lo, float hi) { const f32x2 v = {lo, hi}; return __builtin_bit_cast(unsigned, __builtin_convertvector(v, bf16x2_t)); }
typedef unsigned u32x2 __attribute__((ext_vector_type(2)));
constexpr float RMS_EPS = 1e-6f;
__device__ __forceinline__ float bf_lo(unsigned w) { return __uint_as_float(w << 16); }
__device__ __forceinline__ float bf_hi(unsigned w) { return __uint_as_float(w & 0xffff0000u); }
__device__ __forceinline__ float fast_sigmoid(float v) { return __builtin_amdgcn_rcpf(1.0f + __builtin_amdgcn_exp2f(-1.4426950408889634f * v)); }
__device__ __forceinline__ float row_rstd16(const float* ssq, int row, int fq) {
    const f32x4 v = *(const f32x4*)(ssq + ((size_t)fq * 32768 + row) * 4);
    float s = (v[0] + v[1]) + (v[2] + v[3]);
    s += __shfl_xor(s, 16); s += __shfl_xor(s, 32);
    return __builtin_amdgcn_rsqf(s * (1.0f / 1024.0f) + RMS_EPS);
}
__device__ __forceinline__ float row_rstd8(const float* ssq2, int row, int fq) {
    const f32x2 v = *(const f32x2*)(ssq2 + ((size_t)(fq & 1) * 32768 + row) * 4 + 2 * (fq >> 1));
    float s = v[0] + v[1];
    s += __shfl_xor(s, 16); s += __shfl_xor(s, 32);
    return __builtin_amdgcn_rsqf(s * (1.0f / 512.0f) + RMS_EPS);
}

struct RowStatTab { PG8_LAS float* tab; PG8_LAS int* pmt; };
__device__ __forceinline__ int rowstat_slot(int pm) { return (pm >> 3) & 1; }
template <class Sched> __device__ __forceinline__ RowStatTab rowstat_build(PG8_LAS unsigned char* base, const Sched& S, const float* ssq) {
    RowStatTab T; T.tab = (PG8_LAS float*)base; T.pmt = (PG8_LAS int*)(base + 2048);
    Unit u0, u1, u; bool any = S.next(0, u0); u1 = u0;
    for (int i = 1; S.next(i, u); ++i) u1 = u;
    int tid_ = threadIdx.x; asm volatile("" : "+v"(tid_));
    const int g = tid_ >> 8, r = tid_ & 255;
    const int pm = g ? u1.pm : u0.pm, slot = rowstat_slot(pm);
    const bool mine = any && (g == 0 || rowstat_slot(u1.pm) != rowstat_slot(u0.pm));
    if (mine) {
        const int row = pm * BM + r; float s = 0.f;
#pragma unroll
        for (int pn = 0; pn < 4; ++pn) { const f32x4 v = *(const f32x4*)(ssq + ((size_t)pn * 32768 + row) * 4); s += (v[0] + v[1]) + (v[2] + v[3]); }
        T.tab[slot * 256 + r] = __builtin_amdgcn_rsqf(s * (1.0f / 1024.0f) + RMS_EPS);
        if (r == 0) T.pmt[slot] = pm;
    } else if (r == 0) T.pmt[rowstat_slot(u0.pm) ^ 1] = -1;
    asm volatile("s_waitcnt lgkmcnt(0)" ::: "memory"); __builtin_amdgcn_s_barrier(); asm volatile("" ::: "memory");
    return T;
}

struct EpiSwiGLU {
    static constexpr bool PERM = true, AFTER_DRAIN = false, MIDK = false;
    bf16_t* H; const float* ssq; RowStatTab T;
    __device__ __forceinline__ void operator()(const f32x4 (&acc)[2][2][4][2], const Unit& u, int wr, int wc, int fr, int fq) const {
        const int row0 = u.pm * BM + wr * 64 + fr, hc = u.pn * 128 + wc * 32 + 8 * fq;
        float rsv[8];
        const int slot = rowstat_slot(u.pm);
        if (T.pmt[slot] == u.pm) {
#pragma unroll
            for (int i = 0; i < 8; ++i) rsv[i] = T.tab[slot * 256 + wr * 64 + fr + (i >> 2) * HALF + (i & 3) * 16];
        } else {
#pragma unroll
            for (int i = 0; i < 8; ++i) rsv[i] = row_rstd16(ssq, row0 + (i >> 2) * HALF + (i & 3) * 16, fq);
        }
#pragma unroll
        for (int ai = 0; ai < 2; ++ai)
#pragma unroll
            for (int m = 0; m < 4; ++m) {
                const int row = row0 + ai * HALF + m * 16;
                const float rs = rsv[ai * 4 + m], c1 = -1.4426950408889634f * rs, c2 = rs * rs;
                float o[8];
#pragma unroll
                for (int n = 0; n < 2; ++n)
#pragma unroll
                    for (int jp = 0; jp < 2; ++jp) {
                        const f32x2 ag = {acc[ai][0][m][n][2 * jp], acc[ai][0][m][n][2 * jp + 1]}, au = {acc[ai][1][m][n][2 * jp], acc[ai][1][m][n][2 * jp + 1]};
                        const f32x2 e = ag * c1; f32x2 t; t.x = __builtin_amdgcn_exp2f(e.x); t.y = __builtin_amdgcn_exp2f(e.y);
                        const f32x2 dd = t + 1.0f; f32x2 r; r.x = __builtin_amdgcn_rcpf(dd.x); r.y = __builtin_amdgcn_rcpf(dd.y);
                        const f32x2 p = (ag * au) * (r * c2);
                        o[4 * n + 2 * jp] = p.x; o[4 * n + 2 * jp + 1] = p.y;
                    }
                u32x4 w; w.x = cvt_pk_bf16(o[0], o[1]); w.y = cvt_pk_bf16(o[2], o[3]); w.z = cvt_pk_bf16(o[4], o[5]); w.w = cvt_pk_bf16(o[6], o[7]);
                *(u32x4*)(H + (size_t)row * 2816 + hc) = w;
            }
    }
};

template <bool ROWSCALE> struct EpiResid {
    static constexpr bool PERM = true, AFTER_DRAIN = false, MIDK = false;
    bf16_t* xb; float* ssq; const float* ssq2; float scale;
    __device__ __forceinline__ void operator()(const f32x4 (&acc)[2][2][4][2], const Unit& u, int wr, int wc, int fr, int fq) const {
        const int row0 = u.pm * BM + wr * 64 + fr, col0 = u.pn * BM + wc * 32 + 8 * fq;
        float scv[8];
#pragma unroll
        for (int i = 0; i < 8; ++i) scv[i] = ROWSCALE ? row_rstd8(ssq2, row0 + (i >> 2) * HALF + (i & 3) * 16, fq) : scale;
#pragma unroll
        for (int ai = 0; ai < 2; ++ai) {
            u32x4 xv[4][2];
#pragma unroll
            for (int m = 0; m < 4; ++m)
#pragma unroll
                for (int bj = 0; bj < 2; ++bj) xv[m][bj] = *(const u32x4*)(xb + (size_t)(row0 + ai * HALF + m * 16) * 1024 + col0 + bj * HALF);
#pragma unroll
            for (int m = 0; m < 4; ++m) {
                const int row = row0 + ai * HALF + m * 16;
                const float sc = scv[ai * 4 + m];
                float ss = 0.f;
#pragma unroll
                for (int bj = 0; bj < 2; ++bj) {
                    const u32x4 xw = xv[m][bj]; const f32x4 a0 = acc[ai][bj][m][0] * sc, a1 = acc[ai][bj][m][1] * sc;
                    float o[8];
                    o[0] = bf_lo(xw.x) + a0[0]; o[1] = bf_hi(xw.x) + a0[1]; o[2] = bf_lo(xw.y) + a0[2]; o[3] = bf_hi(xw.y) + a0[3];
                    o[4] = bf_lo(xw.z) + a1[0]; o[5] = bf_hi(xw.z) + a1[1]; o[6] = bf_lo(xw.w) + a1[2]; o[7] = bf_hi(xw.w) + a1[3];
#pragma unroll
                    for (int j = 0; j < 8; ++j) ss += o[j] * o[j];
                    u32x4 w; w.x = cvt_pk_bf16(o[0], o[1]); w.y = cvt_pk_bf16(o[2], o[3]); w.z = cvt_pk_bf16(o[4], o[5]); w.w = cvt_pk_bf16(o[6], o[7]);
                    *(u32x4*)(xb + (size_t)row * 1024 + col0 + bj * HALF) = w;
                }
                ss += __shfl_xor(ss, 16); ss += __shfl_xor(ss, 32); if (fq == 0) ssq[((size_t)u.pn * 32768 + row) * 4 + wc] = ss;
            }
        }
    }
};

struct EpiProj {
    static constexpr bool PERM = true, AFTER_DRAIN = false, MIDK = false;
    bf16_t* proj; bf16_t* vT; const float* ssq; RowStatTab T;
    __device__ __forceinline__ void operator()(const f32x4 (&acc)[2][2][4][2], const Unit& u, int wr, int wc, int fr, int fq) const {
        const int row0 = u.pm * BM + wr * 64 + fr;
        float rsv[8];
        const int slot = rowstat_slot(u.pm);
        if (T.pmt[slot] == u.pm) {
#pragma unroll
            for (int i = 0; i < 8; ++i) rsv[i] = T.tab[slot * 256 + wr * 64 + fr + (i >> 2) * HALF + (i & 3) * 16];
        } else {
#pragma unroll
            for (int i = 0; i < 8; ++i) rsv[i] = row_rstd16(ssq, row0 + (i >> 2) * HALF + (i & 3) * 16, fq);
        }
#pragma unroll
        for (int ai = 0; ai < 2; ++ai)
#pragma unroll
            for (int m = 0; m < 4; ++m) {
                const int row = row0 + ai * HALF + m * 16;
                const float rs = rsv[ai * 4 + m];
#pragma unroll
                for (int bj = 0; bj < 2; ++bj) {
                    const f32x4 v0 = acc[ai][bj][m][0] * rs, v1 = acc[ai][bj][m][1] * rs;
                    u32x4 w; w.x = cvt_pk_bf16(v0[0], v0[1]); w.y = cvt_pk_bf16(v0[2], v0[3]); w.z = cvt_pk_bf16(v1[0], v1[1]); w.w = cvt_pk_bf16(v1[2], v1[3]);
                    if (u.pn == 2 && bj == 1) {
                        const int vc = wc * 32 + 8 * fq, b = row >> 12, t = row & 4095;
                        bf16_t* dst = vT + ((size_t)(b * 2 + (vc >> 6)) * 64 + (vc & 63)) * 4096 + t;
                        dst[0 * 4096] = (bf16_t)(w.x & 0xffffu); dst[1 * 4096] = (bf16_t)(w.x >> 16);
                        dst[2 * 4096] = (bf16_t)(w.y & 0xffffu); dst[3 * 4096] = (bf16_t)(w.y >> 16);
                        dst[4 * 4096] = (bf16_t)(w.z & 0xffffu); dst[5 * 4096] = (bf16_t)(w.z >> 16);
                        dst[6 * 4096] = (bf16_t)(w.w & 0xffffu); dst[7 * 4096] = (bf16_t)(w.w >> 16);
                    } else {
                        *(u32x4*)(proj + (size_t)row * 1280 + u.pn * BM + bj * HALF + wc * 32 + 8 * fq) = w;
                    }
                }
            }
    }
};

struct EpiGlu {
    static constexpr bool PERM = true, AFTER_DRAIN = false, MIDK = false;
    const bf16_t* z; bf16_t* s; const float* bglu; float* ssq2;
    __device__ __forceinline__ void operator()(const f32x4 (&acc)[2][2][4][2], const Unit& u, int wr, int wc, int fr, int fq) const {
        const int row0 = u.pm * BM + wr * 64 + fr;
#pragma unroll
        for (int ai = 0; ai < 2; ++ai)
#pragma unroll
            for (int m = 0; m < 4; ++m) {
                const int row = row0 + ai * HALF + m * 16;
                float ss = 0.f;
#pragma unroll
                for (int bj = 0; bj < 2; ++bj) {
                    const int c0 = u.pn * BM + bj * HALF + wc * 32 + 8 * fq;
                    const u32x4 zw = *(const u32x4*)(z + (size_t)row * 512 + c0);
                    const f32x4 b0 = *(const f32x4*)(bglu + c0), b1 = *(const f32x4*)(bglu + c0 + 4);
                    const f32x4 a0 = acc[ai][bj][m][0] + b0, a1 = acc[ai][bj][m][1] + b1;
                    float o[8];
                    o[0] = bf_lo(zw.x) * fast_sigmoid(a0[0]); o[1] = bf_hi(zw.x) * fast_sigmoid(a0[1]);
                    o[2] = bf_lo(zw.y) * fast_sigmoid(a0[2]); o[3] = bf_hi(zw.y) * fast_sigmoid(a0[3]);
                    o[4] = bf_lo(zw.z) * fast_sigmoid(a1[0]); o[5] = bf_hi(zw.z) * fast_sigmoid(a1[1]);
                    o[6] = bf_lo(zw.w) * fast_sigmoid(a1[2]); o[7] = bf_hi(zw.w) * fast_sigmoid(a1[3]);
#pragma unroll
                    for (int j = 0; j < 8; ++j) ss += o[j] * o[j];
                    u32x4 w; w.x = cvt_pk_bf16(o[0], o[1]); w.y = cvt_pk_bf16(o[2], o[3]); w.z = cvt_pk_bf16(o[4], o[5]); w.w = cvt_pk_bf16(o[6], o[7]);
                    *(u32x4*)(s + (size_t)row * 1024 + 512 + c0) = w;
                }
                ss += __shfl_xor(ss, 16); ss += __shfl_xor(ss, 32); if (fq == 0) ssq2[((size_t)u.pn * 32768 + row) * 4 + wc] = ss;
            }
    }
};
template <class Epi, class Sched, bool ALIGN_EPI = false, bool SP2 = false>
__device__ __forceinline__ void gemm_phase(PG8_LAS unsigned char* lds, const Gemm g, const Sched& S, const Epi& E) {
    int tid_ = threadIdx.x; asm volatile("" : "+v"(tid_));
    const int tid = tid_, wid = __builtin_amdgcn_readfirstlane(tid >> 6), lane = tid & 63, wr = wid >> 2, wc = wid & 3, fr = lane & 15, fq = lane >> 4;
    const int K = g.K, nt = K / BK;
    unsigned voffA[2], voffB[2];
#pragma unroll
    for (int i = 0; i < 2; ++i) { int R, C; stage_rc(tid * 16 + i * 8192, R, C); const int Rb = Epi::PERM ? ((R & ~31) + perm32(R & 31)) : R;
        voffA[i] = (unsigned)(R * K + C) * 2u; voffB[i] = (unsigned)(Rb * K + C) * 2u; }
    const size_t kstep = (size_t)(BK * 2);
    const size_t hstep = (size_t)HALF * K * 2;
    const size_t tstep = 2 * hstep;
    const unsigned ldsw = (unsigned)wid * 1024u;
    const int aoff = lds_byte(wr * 64 + fr, fq * 8), boff = lds_byte(wc * 32 + fr, fq * 8);
#define PG8_SA(b, h) (((b) * 2 + (h)) * HTB)
#define PG8_SB(b, h) ((4 + (b) * 2 + (h)) * HTB)
#define PG8_STAGE(bufoff, gbase, voff) do { _Pragma("unroll") for (int _i = 0; _i < 2; ++_i) \
        __builtin_amdgcn_global_load_lds((const unsigned*)((const char*)(gbase) + (voff)[_i]), (PG8_LAS unsigned*)(lds + (bufoff) + ldsw + _i * 8192), 16, 0, 0); } while (0)
#define PG8_LDA(dst, b, h) do { _Pragma("unroll") for (int m = 0; m < 4; ++m) _Pragma("unroll") for (int k = 0; k < 2; ++k) dst[m][k] = *(const PG8_LAS bf16x8*)(lds + PG8_SA(b, h) + aoff + m * 2048 + k * 1024); } while (0)
#define PG8_LDB(dst, b, h) do { _Pragma("unroll") for (int n = 0; n < 2; ++n) _Pragma("unroll") for (int k = 0; k < 2; ++k) dst[n][k] = *(const PG8_LAS bf16x8*)(lds + PG8_SB(b, h) + boff + n * 2048 + k * 1024); } while (0)
#define PG8_MMA(ai, bj, At, Bt) do { __builtin_amdgcn_s_setprio(1); _Pragma("unroll") for (int m = 0; m < 4; ++m) _Pragma("unroll") for (int n = 0; n < 2; ++n) _Pragma("unroll") for (int k = 0; k < 2; ++k) \
        acc[ai][bj][m][n] = __builtin_amdgcn_mfma_f32_16x16x32_bf16(Bt[n][k], At[m][k], acc[ai][bj][m][n], 0, 0, 0); __builtin_amdgcn_s_setprio(0); } while (0)
#define PG8_WAIT_V(n) asm volatile("s_waitcnt vmcnt(" #n ")" ::: "memory")
#define PG8_WAIT_L(n) asm volatile("s_waitcnt lgkmcnt(" #n ")" ::: "memory")
#define PG8_BAR __builtin_amdgcn_s_barrier()
#define PG8_SCHED __builtin_amdgcn_sched_barrier(0)
    Unit cur, nxt; int ui = 0;
    if (!S.next(0, cur)) return;
    f32x4 acc[2][2][4][2];
#pragma unroll
    for (int a = 0; a < 2; ++a)
#pragma unroll
        for (int b = 0; b < 2; ++b)
#pragma unroll
            for (int m = 0; m < 4; ++m)
#pragma unroll
                for (int n = 0; n < 2; ++n) acc[a][b][m][n] = (f32x4){0.f, 0.f, 0.f, 0.f};
    bf16x8 At[4][2], B0[2][2], B1[2][2];
    const char* cA = (const char*)g.A + (size_t)cur.pm * tstep; const char* cB = (const char*)g.Bt + (size_t)cur.pn * tstep;
    S.a_ready(cur);
    if constexpr (SP2) {
        PG8_STAGE(PG8_SB(0, 0), cB, voffB); PG8_STAGE(PG8_SB(0, 1), cB + hstep, voffB); PG8_STAGE(PG8_SA(0, 0), cA, voffA); PG8_STAGE(PG8_SA(0, 1), cA + hstep, voffA);
        if (wr == 1) PG8_BAR;
        PG8_WAIT_V(2); PG8_BAR;
        PG8_STAGE(PG8_SB(1, 0), cB + kstep, voffB); PG8_STAGE(PG8_SA(1, 0), cA + kstep, voffA); PG8_STAGE(PG8_SB(1, 1), cB + hstep + kstep, voffB);
        PG8_WAIT_V(6); PG8_BAR;
    } else {
        PG8_STAGE(PG8_SB(0, 0), cB, voffB); PG8_STAGE(PG8_SA(0, 0), cA, voffA); PG8_STAGE(PG8_SB(0, 1), cB + hstep, voffB); PG8_STAGE(PG8_SA(0, 1), cA + hstep, voffA);
        if (wr == 1) PG8_BAR;
        PG8_WAIT_V(4); PG8_BAR;
        PG8_STAGE(PG8_SB(1, 0), cB + kstep, voffB); PG8_STAGE(PG8_SA(1, 0), cA + kstep, voffA); PG8_STAGE(PG8_SB(1, 1), cB + hstep + kstep, voffB);
        PG8_WAIT_V(6); PG8_BAR;
    }
    for (;;) {
        const bool has_next = S.next(ui + 1, nxt);
        const char* nA = has_next ? (const char*)g.A + (size_t)nxt.pm * tstep : cA; const char* nB = has_next ? (const char*)g.Bt + (size_t)nxt.pn * tstep : cB;
        for (int t = 0; t < nt; t += 2) {
            const bool last = (t == nt - 2);
            const char* a1 = cA + (size_t)(t + 1) * kstep;
            const char* a2 = last ? nA : cA + (size_t)(t + 2) * kstep; const char* b2 = last ? nB : cB + (size_t)(t + 2) * kstep;
            const char* a3 = a2 + kstep; const char* b3 = b2 + kstep;
            if (last && has_next) S.a_ready(nxt);
            if constexpr (SP2) {
            PG8_LDB(B0, 0, 0); PG8_LDB(B1, 0, 1); PG8_SCHED; PG8_LDA(At, 0, 0); PG8_STAGE(PG8_SA(1, 1), a1 + hstep, voffA);
            PG8_WAIT_V(8); PG8_WAIT_L(0); PG8_BAR; PG8_MMA(0, 0, At, B0); PG8_MMA(0, 1, At, B1); PG8_BAR; PG8_SCHED;
            PG8_LDA(At, 0, 1); PG8_STAGE(PG8_SB(0, 0), b2, voffB); PG8_STAGE(PG8_SB(0, 1), b2 + hstep, voffB); PG8_STAGE(PG8_SA(0, 0), a2, voffA);
            PG8_WAIT_V(8); PG8_WAIT_L(0); PG8_BAR; PG8_MMA(1, 0, At, B0); PG8_MMA(1, 1, At, B1); PG8_BAR; PG8_SCHED;
            PG8_LDB(B0, 1, 0); PG8_LDB(B1, 1, 1); PG8_SCHED; PG8_LDA(At, 1, 0); PG8_STAGE(PG8_SA(0, 1), a2 + hstep, voffA);
            PG8_WAIT_V(8); PG8_WAIT_L(0); PG8_BAR; PG8_MMA(0, 0, At, B0); PG8_MMA(0, 1, At, B1); PG8_BAR; PG8_SCHED;
            PG8_LDA(At, 1, 1); PG8_STAGE(PG8_SB(1, 0), b3, voffB); PG8_STAGE(PG8_SB(1, 1), b3 + hstep, voffB); PG8_STAGE(PG8_SA(1, 0), a3, voffA);
            PG8_WAIT_V(8); PG8_WAIT_L(0); PG8_BAR; PG8_MMA(1, 0, At, B0); PG8_MMA(1, 1, At, B1); PG8_BAR; PG8_SCHED;
            } else {
            PG8_LDB(B0, 0, 0); PG8_SCHED; PG8_LDA(At, 0, 0); PG8_STAGE(PG8_SA(1, 1), a1 + hstep, voffA);
            PG8_WAIT_L(8); PG8_BAR; PG8_WAIT_L(0); PG8_MMA(0, 0, At, B0); PG8_BAR; PG8_SCHED;
            PG8_LDB(B1, 0, 1); PG8_STAGE(PG8_SB(0, 0), b2, voffB);
            PG8_BAR; PG8_WAIT_L(0); PG8_MMA(0, 1, At, B1); PG8_BAR;
            PG8_LDA(At, 0, 1); PG8_STAGE(PG8_SA(0, 0), a2, voffA);
            PG8_BAR; PG8_WAIT_L(0); PG8_MMA(1, 0, At, B0); PG8_BAR; PG8_SCHED;
            PG8_STAGE(PG8_SB(0, 1), b2 + hstep, voffB);
            PG8_WAIT_V(6); PG8_BAR; PG8_MMA(1, 1, At, B1); PG8_BAR;
            PG8_LDB(B0, 1, 0); PG8_SCHED; PG8_LDA(At, 1, 0); PG8_STAGE(PG8_SA(0, 1), a2 + hstep, voffA);
            PG8_WAIT_L(8); PG8_BAR; PG8_WAIT_L(0); PG8_MMA(0, 0, At, B0); PG8_BAR; PG8_SCHED;
            PG8_LDB(B1, 1, 1); PG8_STAGE(PG8_SB(1, 0), b3, voffB);
            PG8_BAR; PG8_WAIT_L(0); PG8_MMA(0, 1, At, B1); PG8_BAR;
            PG8_LDA(At, 1, 1); PG8_STAGE(PG8_SA(1, 0), a3, voffA);
            PG8_BAR; PG8_WAIT_L(0); PG8_MMA(1, 0, At, B0); PG8_BAR; PG8_SCHED;
            PG8_STAGE(PG8_SB(1, 1), b3 + hstep, voffB);
            PG8_WAIT_V(6); PG8_BAR; PG8_MMA(1, 1, At, B1); PG8_BAR;
            }
        }
        if constexpr (ALIGN_EPI) { if (wr == 0) PG8_BAR; }
        if constexpr (!Epi::AFTER_DRAIN) { E(acc, cur, wr, wc, fr, fq); S.done(cur); }
        if (!has_next) break;
#pragma unroll
        for (int a = 0; a < 2; ++a)
#pragma unroll
            for (int b = 0; b < 2; ++b)
#pragma unroll
                for (int m = 0; m < 4; ++m)
#pragma unroll
                    for (int n = 0; n < 2; ++n) acc[a][b][m][n] = (f32x4){0.f, 0.f, 0.f, 0.f};
        cur = nxt; cA = nA; cB = nB; ++ui;
        if constexpr (ALIGN_EPI) { if (wr == 1) PG8_BAR; }
    }
    PG8_WAIT_V(0);
    if constexpr (!ALIGN_EPI) { if (wr == 0) PG8_BAR; }
    PG8_BAR;
    if constexpr (Epi::AFTER_DRAIN) { E.fused(acc, cur, wr, wc, fr, fq, lds, wid, lane); S.done(cur); }
#undef PG8_SA
#undef PG8_SB
#undef PG8_STAGE
#undef PG8_LDA
#undef PG8_LDB
#undef PG8_MMA
#undef PG8_WAIT_V
#undef PG8_WAIT_L
#undef PG8_BAR
#undef PG8_SCHED
}
}

#ifndef DIAG_NOCARRY
#define DIAG_NOCARRY 0
#endif
#ifndef N_ATT
#define N_ATT 1
#endif
#ifndef N_P1
#define N_P1 1
#endif
#ifndef N_P3
#define N_P3 1
#endif
#ifndef DUP_G1
#define DUP_G1 0
#endif
#ifndef DIAG_MIXER
#define DIAG_MIXER 1
#endif
#define LAS __attribute__((address_space(3)))
typedef unsigned short bf16;
typedef short bf16x8 __attribute__((ext_vector_type(8)));
typedef short s16x4 __attribute__((ext_vector_type(4)));
typedef float f32x2 __attribute__((ext_vector_type(2)));
typedef float f32x4 __attribute__((ext_vector_type(4)));
typedef float f32x16 __attribute__((ext_vector_type(16)));
typedef unsigned u32x2 __attribute__((ext_vector_type(2)));
typedef unsigned u32x4 __attribute__((ext_vector_type(4)));

constexpr int NT = 32768, SEQ = 4096, DM = 1024, DFF = 2816, DIN = 1280, NLAYER = 4;
constexpr float LOG2E = 1.4426950408889634f;
constexpr int NWAVES = 8, NTHREADS = 512;
constexpr int LDS_BYTES = 147456;
constexpr size_t MiB = 1u << 20;
constexpr size_t W_GU1 = 0, W_D1 = W_GU1 + (size_t)5632 * 1024 * 2, W_IN = W_D1 + (size_t)1024 * 2816 * 2, W_GLU = W_IN + (size_t)1280 * 1024 * 2,
                 W_OA = W_GLU + (size_t)512 * 512 * 2, W_OS = W_OA + (size_t)1024 * 512 * 2, W_GU2 = W_OS + (size_t)1024 * 512 * 2,
                 W_D2 = W_GU2 + (size_t)5632 * 1024 * 2, W_LAYER = W_D2 + (size_t)1024 * 2816 * 2;
static_assert(W_LAYER == 38 * MiB, "weights per layer");
constexpr size_t WS_W = 0, WS_XB = 152 * MiB, WS_BIG = 216 * MiB, WS_H = WS_BIG, WS_PROJ = WS_BIG, WS_MIX = WS_BIG + 80 * MiB, WS_Z = WS_BIG + 144 * MiB,
                 WS_VT = 392 * MiB, WS_YSCR = 400 * MiB, WS_SEGE = 464 * MiB, WS_SSQ = 466 * MiB, WS_SSQ2 = 468 * MiB, WS_ABAR = 469 * MiB, WS_APOW = WS_ABAR + 256 * 1024,
                 WS_BB = 470 * MiB, WS_CC = 471 * MiB, WS_CTL = 472 * MiB, CTL_BYTES = 16384, WS_END = 473 * MiB;

struct Args { const float* in[27]; float* out; unsigned char* ws; };
__device__ __forceinline__ const float* inptr(int k) {
    typedef const float* cfp;
    const __attribute__((address_space(4))) char* kp = (const __attribute__((address_space(4))) char*)__builtin_amdgcn_kernarg_segment_ptr();
    int off = k * 8; asm volatile("" : "+s"(off));
    return *(const __attribute__((address_space(4))) cfp*)(kp + off);
}
#define INP(k) inptr(k)
__device__ __forceinline__ unsigned char* kptr(int off0) {
    typedef unsigned char* ucp;
    const __attribute__((address_space(4))) char* kp = (const __attribute__((address_space(4))) char*)__builtin_amdgcn_kernarg_segment_ptr();
    int off = off0; asm volatile("" : "+s"(off));
    return *(const __attribute__((address_space(4))) ucp*)(kp + off);
}
#define WSPTR() kptr(224)
#define OUTPTR() ((float*)kptr(216))

__device__ __forceinline__ unsigned f2bf(float f) { unsigned u = __builtin_bit_cast(unsigned, f); return (u + 0x7fffu + ((u >> 16) & 1u)) >> 16; }
typedef __bf16 bf16x2_t __attribute__((ext_vector_type(2)));
__device__ __forceinline__ unsigned pk2(float lo, float hi) { const f32x2 v = {lo, hi}; return __builtin_bit_cast(unsigned, __builtin_convertvector(v, bf16x2_t)); }
__device__ __forceinline__ float bflo(unsigned w) { return __uint_as_float(w << 16); }
__device__ __forceinline__ float bfhi(unsigned w) { return __uint_as_float(w & 0xffff0000u); }
__device__ __forceinline__ float bf2f(bf16 v) { return __uint_as_float((unsigned)v << 16); }
#define LDS_FENCE() asm volatile("s_waitcnt lgkmcnt(0)" ::: "memory")
__device__ __forceinline__ float wave_sum(float v) {
#pragma unroll
    for (int o = 1; o < 64; o <<= 1) v += __shfl_xor(v, o);
    return v;
}
__device__ __forceinline__ int crow(int r, int hi) { return (r & 3) + 8 * (r >> 2) + 4 * hi; }

__device__ __forceinline__ void tr_item(const float* W, int ldw, int K, bf16* WT, int k0, int n0, int drow0, const float* gain, float cs, LAS float* scr, int lane) {
    const int r = lane >> 3, q = lane & 7;
    f32x4 v[8];
#pragma unroll
    for (int i = 0; i < 8; ++i) v[i] = *(const f32x4*)(W + (size_t)(k0 + 8 * i + r) * ldw + n0 + 4 * q);
#pragma unroll
    for (int i = 0; i < 8; ++i) { LAS float* s = scr + (8 * i + r) * 33 + 4 * q; s[0] = v[i][0]; s[1] = v[i][1]; s[2] = v[i][2]; s[3] = v[i][3]; }
    const int c = lane & 7;
    f32x4 g0 = (f32x4){cs, cs, cs, cs}, g1 = g0;
    if (gain) { g0 = *(const f32x4*)(gain + k0 + 8 * c) * cs; g1 = *(const f32x4*)(gain + k0 + 8 * c + 4) * cs; }
    LDS_FENCE();
#pragma unroll
    for (int j = 0; j < 4; ++j) { const int n = (lane >> 3) + 8 * j; const LAS float* s = scr + (8 * c) * 33 + n;
        u32x4 o; o.x = pk2(s[0 * 33] * g0[0], s[1 * 33] * g0[1]); o.y = pk2(s[2 * 33] * g0[2], s[3 * 33] * g0[3]); o.z = pk2(s[4 * 33] * g1[0], s[5 * 33] * g1[1]); o.w = pk2(s[6 * 33] * g1[2], s[7 * 33] * g1[3]);
        *(u32x4*)(WT + (size_t)(drow0 + n) * K + k0 + 8 * c) = o; }
    LDS_FENCE();
}
__device__ __forceinline__ void sincos_rr(float th, float& s, float& c) {
    const float k = rintf(th * 0.6366197723675814f);
    float r = fmaf(-k, 1.5707963705062866f, th); r = fmaf(-k, -4.371138828673793e-8f, r);
    const float r2 = r * r;
    const float sp = r + r * r2 * (-1.6666667e-1f + r2 * (8.3333333e-3f + r2 * (-1.9841270e-4f + r2 * 2.7557319e-6f)));
    const float cp = 1.0f + r2 * (-0.5f + r2 * (4.1666667e-2f + r2 * (-1.3888889e-3f + r2 * 2.4801587e-5f)));
    const int q = ((int)k) & 3;
    s = (q == 0) ? sp : (q == 1) ? cp : (q == 2) ? -sp : -cp;
    c = (q == 0) ? cp : (q == 1) ? -sp : (q == 2) ? -cp : sp;
}
__device__ __forceinline__ void prologue(const Args& a, LAS unsigned char* lds, int G) {
    int tid_ = threadIdx.x; asm volatile("" : "+v"(tid_));
    const int tid = tid_, lane = tid & 63, wave = __builtin_amdgcn_readfirstlane(tid >> 6);
    LAS float* scr = (LAS float*)(lds + wave * 16384);
    const int gw = blockIdx.x * NWAVES + wave, NGW = G * NWAVES;
    constexpr int I_GU = 16 * 88, I_D = 44 * 32, I_IN = 16 * 40, I_GLU = 8 * 16, I_O = 8 * 32;
    constexpr int C1 = I_GU, C2 = C1 + I_GU, C3 = C2 + I_D, C4 = C3 + I_IN, C5 = C4 + I_GLU, C6 = C5 + I_O, C7 = C6 + I_O, C8 = C7 + I_GU, C9 = C8 + I_GU, C10 = C9 + I_D;
    for (int it = gw; it < NLAYER * C10; it += NGW) {
        const int l = it / C10; int r = it % C10;
        unsigned char* wl = WSPTR() + WS_W + (size_t)l * W_LAYER;
        const float* W; int ldw, K, nblk; bf16* WT; const float* gain = nullptr; int mode = 0;
        if (r < C1)       { W = INP(3) + (size_t)l * 1024 * 2816; ldw = 2816; K = 1024; nblk = 88; WT = (bf16*)(wl + W_GU1); gain = INP(2) + l * 1024; mode = 1; }
        else if (r < C2)  { r -= C1; W = INP(4) + (size_t)l * 1024 * 2816; ldw = 2816; K = 1024; nblk = 88; WT = (bf16*)(wl + W_GU1); gain = INP(2) + l * 1024; mode = 2; }
        else if (r < C3)  { r -= C2; W = INP(5) + (size_t)l * 2816 * 1024; ldw = 1024; K = 2816; nblk = 32; WT = (bf16*)(wl + W_D1); }
        else if (r < C4)  { r -= C3; W = INP(7) + (size_t)l * 1024 * 1280; ldw = 1280; K = 1024; nblk = 40; WT = (bf16*)(wl + W_IN); gain = INP(6) + l * 1024; mode = 3; }
        else if (r < C5)  { r -= C4; W = INP(17) + (size_t)l * 512 * 512; ldw = 512; K = 512; nblk = 16; WT = (bf16*)(wl + W_GLU); }
        else if (r < C6)  { r -= C5; W = INP(21) + (size_t)l * 1024 * 1024; ldw = 1024; K = 1024; nblk = 32; WT = (bf16*)(wl + W_OA); gain = INP(19) + l * 512; }
        else if (r < C7)  { r -= C6; W = INP(21) + (size_t)l * 1024 * 1024 + (size_t)512 * 1024; ldw = 1024; K = 1024; nblk = 32; WT = (bf16*)(wl + W_OA) + 512; gain = INP(20) + l * 512; }
        else if (r < C8)  { r -= C7; W = INP(23) + (size_t)l * 1024 * 2816; ldw = 2816; K = 1024; nblk = 88; WT = (bf16*)(wl + W_GU2); gain = INP(22) + l * 1024; mode = 1; }
        else if (r < C9)  { r -= C8; W = INP(24) + (size_t)l * 1024 * 2816; ldw = 2816; K = 1024; nblk = 88; WT = (bf16*)(wl + W_GU2); gain = INP(22) + l * 1024; mode = 2; }
        else              { r -= C9; W = INP(25) + (size_t)l * 2816 * 1024; ldw = 1024; K = 2816; nblk = 32; WT = (bf16*)(wl + W_D2); }
        const int kb = r / nblk, nb = r % nblk, k0 = 64 * kb, n0 = 32 * nb;
        int drow0 = n0; float cs = 1.0f;
        if (mode == 1) drow0 = 256 * (n0 >> 7) + (n0 & 127);
        else if (mode == 2) drow0 = 256 * (n0 >> 7) + 128 + (n0 & 127);
        else if (mode == 3 && n0 < 512) cs = 0.125f * LOG2E;
        tr_item(W, ldw, K, WT, k0, n0, drow0, gain, cs, scr, lane);
    }
    {
        const float* x = INP(0); bf16* xb = (bf16*)(WSPTR() + WS_XB); float* ssq = (float*)(WSPTR() + WS_SSQ);
        for (int m = gw; m < NT; m += NGW) {
            const f32x4* xr = (const f32x4*)(x + (size_t)m * DM) + lane; u32x2* brow = (u32x2*)(xb + (size_t)m * DM) + lane;
            float s = 0.f;
#pragma unroll
            for (int j = 0; j < 4; ++j) { const f32x4 v = xr[64 * j]; u32x2 w; w.x = pk2(v[0], v[1]); w.y = pk2(v[2], v[3]); brow[64 * j] = w; s += (v[0] * v[0] + v[1] * v[1]) + (v[2] * v[2] + v[3] * v[3]); }
            s = wave_sum(s);
            if (lane < 16) ssq[((size_t)(lane >> 2) * NT + m) * 4 + (lane & 3)] = (lane == 0) ? s : 0.f;
        }
    }
    {
        f32x2* AB = (f32x2*)(WSPTR() + WS_ABAR); f32x2* AP = (f32x2*)(WSPTR() + WS_APOW); bf16* BB = (bf16*)(WSPTR() + WS_BB); bf16* CC = (bf16*)(WSPTR() + WS_CC);
        for (int cb = gw; cb < NLAYER * 2 * 32; cb += NGW) {
            const int p = lane;
            const float dt = __expf(INP(11)[cb]);
            const float are = INP(9)[cb * 64 + p], aim = INP(10)[cb * 64 + p];
            const float mag = __expf(dt * are); float sn, cs; sincos_rr(dt * aim, sn, cs);
            const float abr = mag * cs, abi = mag * sn;
            const float den = are * are + aim * aim, nr = abr - 1.0f, ni = abi;
            const float kr = (nr * are + ni * aim) / den, ki = (ni * are - nr * aim) / den;
            AB[cb * 64 + p] = (f32x2){abr, abi};
            float pr = abr, pi = abi;
#pragma unroll
            for (int q = 0; q < 9; ++q) { const float t0 = pr * pr - pi * pi, t1 = 2.0f * pr * pi; pr = t0; pi = t1; }
            AP[cb * 64 + p] = (f32x2){pr, pi};
            scr[2 * p] = kr; scr[2 * p + 1] = ki;
            LDS_FENCE();
            const float* bre = INP(12) + (size_t)cb * 64 * 16; const float* bim = INP(13) + (size_t)cb * 64 * 16;
            const float* cre = INP(14) + (size_t)cb * 16 * 64; const float* cim = INP(15) + (size_t)cb * 16 * 64;
#pragma unroll
            for (int tile = 0; tile < 4; ++tile) {
                const int pp = 32 * (tile & 1) + (lane & 31); const float kr2 = scr[2 * pp], ki2 = scr[2 * pp + 1];
                unsigned w[4];
#pragma unroll
                for (int j2 = 0; j2 < 4; ++j2) { float v[2];
#pragma unroll
                    for (int e = 0; e < 2; ++e) { const int h = 8 * (lane >> 5) + 2 * j2 + e; const float br = bre[pp * 16 + h], bi = bim[pp * 16 + h];
                        v[e] = (tile >> 1) ? (kr2 * bi + ki2 * br) : (kr2 * br - ki2 * bi); }
                    w[j2] = pk2(v[0], v[1]); }
                *(u32x4*)(BB + ((size_t)(cb * 4 + tile) * 64 + lane) * 8) = (u32x4){w[0], w[1], w[2], w[3]};
            }
#pragma unroll
            for (int kk = 0; kk < 4; ++kk) {
                unsigned w[4];
#pragma unroll
                for (int j2 = 0; j2 < 4; ++j2) { const int kap = 32 * kk + 8 * (lane >> 4) + 2 * j2, pp = kap >> 1, h = lane & 15;
                    w[j2] = pk2(cre[h * 64 + pp], -cim[h * 64 + pp]); }
                *(u32x4*)(CC + ((size_t)(cb * 4 + kk) * 64 + lane) * 8) = (u32x4){w[0], w[1], w[2], w[3]};
            }
            LDS_FENCE();
        }
    }
}

__device__ __forceinline__ void attn_phase(const Args& a, LAS unsigned char* lds, int layer, int G) {
    int tid_ = threadIdx.x; asm volatile("" : "+v"(tid_));
    const int tid = tid_, lane = tid & 63, h = __builtin_amdgcn_readfirstlane(tid >> 6), kvh = h >> 2;
    LAS float* biasT = (LAS float*)lds;
    LAS float* red = (LAS float*)(lds + 10240);
    const float* tab = INP(1);
    for (int e = tid; e < 8 * 320; e += NTHREADS) {
        const int hh = e / 320, ri = e % 320 - 32; float v = -1e30f;
        if (ri >= 0 && ri <= 256) { const int rel = ri - 128, n = rel < 0 ? -rel : rel; int bk = (rel > 0) ? 16 : 0;
            if (n < 8) bk += n; else { int lg = 2 + (31 - __builtin_clz((unsigned)(n * n))); bk += (lg < 15 ? lg : 15); }
            v = tab[bk * 8 + hh] * LOG2E; }
        biasT[e] = v;
    }
    __syncthreads();
    const bf16* proj = (const bf16*)(WSPTR() + WS_PROJ); const bf16* vT = (const bf16*)(WSPTR() + WS_VT); bf16* an = (bf16*)(WSPTR() + WS_MIX); const float* ssq2p = (const float*)(WSPTR() + WS_SSQ2);
    const float sinkv = INP(8)[layer * 8 + h] * LOG2E;
    const int ql = lane & 31, hi = lane >> 5;
    int par = 0;
    for (int ui = blockIdx.x; ui < 1024; ui += G, par ^= 1) {
        const int b = ui >> 7, q0 = (ui & 127) * 32, rowq = b * SEQ + q0;
        const bf16* qp = proj + (size_t)(rowq + ql) * DIN + h * 64 + 8 * hi;
        bf16x8 qf[4];
#pragma unroll
        for (int kk = 0; kk < 4; ++kk) qf[kk] = *(const bf16x8*)(qp + 16 * kk);
        float m = sinkv, lsum = 1.0f;
        f32x16 o0, o1;
#pragma unroll
        for (int r = 0; r < 16; ++r) { o0[r] = 0.f; o1[r] = 0.f; }
        const bf16* vbase = vT + ((size_t)(b * 2 + kvh) * 64 + ql) * SEQ + 4 * hi;
        const bf16* kbase = proj + (size_t)(b * SEQ + ql) * DIN + 512 + kvh * 64 + 8 * hi;
        const int rb = ui & 127, kt_lo = (4 - rb) > 0 ? (4 - rb) : 0, kt_hi = (132 - rb) < 9 ? (132 - rb) : 9;
        bf16x8 kf[4]; s16x4 vf[2][2][2];
#define ATT_LOAD(KF, VF, kt_) do { const int key0_ = q0 - 128 + 32 * (kt_); const bf16* kp_ = kbase + (size_t)key0_ * DIN; \
            _Pragma("unroll") for (int kk = 0; kk < 4; ++kk) KF[kk] = *(const bf16x8*)(kp_ + 16 * kk); \
            _Pragma("unroll") for (int dt = 0; dt < 2; ++dt) _Pragma("unroll") for (int s = 0; s < 2; ++s) { const bf16* vp_ = vbase + (size_t)(32 * dt) * SEQ + key0_ + 16 * s; VF[dt][s][0] = *(const s16x4*)vp_; VF[dt][s][1] = *(const s16x4*)(vp_ + 8); } } while (0)
        bf16x8 kg[4]; s16x4 vg[2][2][2];
#define ATT_TILE(KF, VF, kt_) do { \
            const LAS float* bt = biasT + h * 320 + 32 * (kt_) + 32 - ql + 4 * hi; \
            f32x16 st; \
            _Pragma("unroll") for (int r = 0; r < 16; ++r) st[r] = bt[(r & 3) + 8 * (r >> 2)]; \
            _Pragma("unroll") for (int kk = 0; kk < 4; ++kk) st = __builtin_amdgcn_mfma_f32_32x32x16_bf16(KF[kk], qf[kk], st, 0, 0, 0); \
            float tmax = st[0]; \
            _Pragma("unroll") for (int r = 1; r < 16; ++r) tmax = fmaxf(tmax, st[r]); \
            tmax = fmaxf(tmax, __shfl_xor(tmax, 32)); \
            if (__builtin_amdgcn_ballot_w64(tmax > m) != 0ull) { \
                const float mnew = fmaxf(m, tmax), alpha = __builtin_amdgcn_exp2f(m - mnew); m = mnew; lsum *= alpha; \
                _Pragma("unroll") for (int r = 0; r < 16; ++r) { o0[r] *= alpha; o1[r] *= alpha; } } \
            float ps = 0.f; \
            _Pragma("unroll") for (int r = 0; r < 16; ++r) { st[r] = __builtin_amdgcn_exp2f(st[r] - m); ps += st[r]; } \
            ps += __shfl_xor(ps, 32); lsum += ps; \
            bf16x8 pf[2]; \
            _Pragma("unroll") for (int s = 0; s < 2; ++s) { u32x4 w; w.x = pk2(st[8 * s + 0], st[8 * s + 1]); w.y = pk2(st[8 * s + 2], st[8 * s + 3]); w.z = pk2(st[8 * s + 4], st[8 * s + 5]); w.w = pk2(st[8 * s + 6], st[8 * s + 7]); \
                pf[s] = __builtin_bit_cast(bf16x8, w); } \
            _Pragma("unroll") for (int s = 0; s < 2; ++s) { \
                const bf16x8 v0 = __builtin_shufflevector(VF[0][s][0], VF[0][s][1], 0, 1, 2, 3, 4, 5, 6, 7); \
                const bf16x8 v1 = __builtin_shufflevector(VF[1][s][0], VF[1][s][1], 0, 1, 2, 3, 4, 5, 6, 7); \
                o0 = __builtin_amdgcn_mfma_f32_32x32x16_bf16(v0, pf[s], o0, 0, 0, 0); \
                o1 = __builtin_amdgcn_mfma_f32_32x32x16_bf16(v1, pf[s], o1, 0, 0, 0); } } while (0)
        ATT_LOAD(kf, vf, kt_lo);
        for (int kt = kt_lo; kt < kt_hi; kt += 2) {
            { const int ktn = (kt + 1 < kt_hi) ? kt + 1 : kt; ATT_LOAD(kg, vg, ktn); }
            ATT_TILE(kf, vf, kt);
            if (kt + 1 < kt_hi) {
                { const int ktn = (kt + 2 < kt_hi) ? kt + 2 : kt + 1; ATT_LOAD(kf, vf, ktn); }
                ATT_TILE(kg, vg, kt + 1);
            }
        }
#undef ATT_TILE
#undef ATT_LOAD
        const float inv = 1.0f / lsum;
        float ss = 0.f;
#pragma unroll
        for (int r = 0; r < 16; ++r) { o0[r] *= inv; o1[r] *= inv; ss += o0[r] * o0[r] + o1[r] * o1[r]; }
        ss += __shfl_xor(ss, 32);
        LAS float* rd = red + par * 256;
        if (hi == 0) rd[h * 32 + ql] = ss;
        __syncthreads();
        float tot = 0.f;
#pragma unroll
        for (int hh = 0; hh < 8; ++hh) tot += rd[hh * 32 + ql];
        const f32x4 sq = *(const f32x4*)(ssq2p + ((size_t)hi * NT + rowq + ql) * 4);
        float ts = (sq[0] + sq[1]) + (sq[2] + sq[3]); ts += __shfl_xor(ts, 32);
        const float rstd = __builtin_amdgcn_rsqf(tot * (1.0f / 512.0f) + 1e-6f) * __builtin_amdgcn_sqrtf(ts * (1.0f / 512.0f) + 1e-6f);
        bf16* op = an + (size_t)(rowq + ql) * 1024 + h * 64 + 4 * hi;
#pragma unroll
        for (int g4 = 0; g4 < 4; ++g4) {
            u32x2 w0, w1;
            w0.x = pk2(o0[4 * g4] * rstd, o0[4 * g4 + 1] * rstd); w0.y = pk2(o0[4 * g4 + 2] * rstd, o0[4 * g4 + 3] * rstd);
            w1.x = pk2(o1[4 * g4] * rstd, o1[4 * g4 + 1] * rstd); w1.y = pk2(o1[4 * g4 + 2] * rstd, o1[4 * g4 + 3] * rstd);
            *(u32x2*)(op + 8 * g4) = w0; *(u32x2*)(op + 32 + 8 * g4) = w1;
        }
    }
}

constexpr int XS_STRIDE = 68;
template <bool BWD, int MODE  >
__device__ __forceinline__ void ssm_pass(const bf16* proj, int rowbase, int g, const bf16x8* BBp, const bf16x8* CCp, float ar, float ai, float& sr, float& si,
                                         LAS unsigned* XS, int lane, f32x4* ysc, const float* Dp, bf16* zbuf) {
    bf16x8 bb[4], cc[4];
#pragma unroll
    for (int t = 0; t < 4; ++t) { bb[t] = BBp[t * 64 + lane]; if (MODE > 0) cc[t] = CCp[t * 64 + lane]; }
    const int ql = lane & 31, hi = lane >> 5;
    const bf16* up = proj + (size_t)(rowbase + ql) * DIN + 768 + g * 16 + 8 * hi;
    bf16x8 ucur = *(const bf16x8*)(up + (size_t)(BWD ? 15 : 0) * 32 * DIN);
    float dval = 0.f; if (MODE == 2) dval = Dp[g * 16 + (lane & 15)];
    for (int c = 0; c < 16; ++c) {
        const int ch = BWD ? 15 - c : c;
        bf16x8 unext = ucur;
        if (c < 15) unext = *(const bf16x8*)(up + (size_t)(BWD ? ch - 1 : ch + 1) * 32 * DIN);
        f32x4 y0 = (f32x4){0.f, 0.f, 0.f, 0.f}, y1 = y0; bf16 uvl[8];
        if (MODE == 2) {
            y0 = ysc[(ch * 2 + 0) * 64 + lane]; y1 = ysc[(ch * 2 + 1) * 64 + lane];
#pragma unroll
            for (int q = 0; q < 8; ++q) uvl[q] = proj[(size_t)(rowbase + 32 * ch + 16 * (q >> 2) + 4 * (lane >> 4) + (q & 3)) * DIN + 768 + g * 16 + (lane & 15)];
        }
        f32x16 z16;
#pragma unroll
        for (int r = 0; r < 16; ++r) z16[r] = 0.f;
        const f32x16 x0 = __builtin_amdgcn_mfma_f32_32x32x16_bf16(ucur, bb[0], z16, 0, 0, 0);
        const f32x16 x1 = __builtin_amdgcn_mfma_f32_32x32x16_bf16(ucur, bb[1], z16, 0, 0, 0);
        const f32x16 x2 = __builtin_amdgcn_mfma_f32_32x32x16_bf16(ucur, bb[2], z16, 0, 0, 0);
        const f32x16 x3 = __builtin_amdgcn_mfma_f32_32x32x16_bf16(ucur, bb[3], z16, 0, 0, 0);
#pragma unroll
        for (int r = 0; r < 16; ++r) { const int t = crow(r, hi); XS[t * XS_STRIDE + ql] = pk2(x0[r], x2[r]); XS[t * XS_STRIDE + 32 + ql] = pk2(x1[r], x3[r]); }
        LDS_FENCE();
#pragma unroll
        for (int tt = 0; tt < 32; ++tt) {
            const int t = BWD ? 31 - tt : tt;
            const unsigned v = XS[t * XS_STRIDE + lane];
            const float nr = fmaf(ar, sr, fmaf(-ai, si, bflo(v))), ni = fmaf(ar, si, fmaf(ai, sr, bfhi(v)));
            sr = nr; si = ni;
            if (MODE > 0) XS[t * XS_STRIDE + lane] = pk2(sr, si);
        }
        if (MODE > 0) {
            LDS_FENCE();
            const LAS unsigned char* ab = (const LAS unsigned char*)XS + (lane & 15) * (XS_STRIDE * 4) + (lane >> 4) * 16;
#pragma unroll
            for (int kk = 0; kk < 4; ++kk) {
                const bf16x8 a0 = *(const LAS bf16x8*)(ab + kk * 64), a1 = *(const LAS bf16x8*)(ab + 16 * XS_STRIDE * 4 + kk * 64);
                y0 = __builtin_amdgcn_mfma_f32_16x16x32_bf16(a0, cc[kk], y0, 0, 0, 0);
                y1 = __builtin_amdgcn_mfma_f32_16x16x32_bf16(a1, cc[kk], y1, 0, 0, 0);
            }
            if (MODE == 1) { ysc[(ch * 2 + 0) * 64 + lane] = y0; ysc[(ch * 2 + 1) * 64 + lane] = y1; }
            else {
                const int hcol = g * 16 + (lane & 15);
#pragma unroll
                for (int rt = 0; rt < 2; ++rt)
#pragma unroll
                    for (int i = 0; i < 4; ++i) {
                        const int row = rowbase + 32 * ch + 16 * rt + 4 * (lane >> 4) + i;
                        const float uv = bf2f(uvl[rt * 4 + i]);
                        const float y = (rt ? y1[i] : y0[i]) + dval * uv;
                        const float zz = y * __builtin_amdgcn_rcpf(1.0f + __builtin_amdgcn_exp2f(-2.3022082f * (y + 0.044715f * y * y * y)));
                        zbuf[(size_t)row * 512 + hcol] = (bf16)f2bf(zz);
                    }
            }
            LDS_FENCE();
        }
        ucur = unext;
    }
}

__device__ __forceinline__ void ssm_p1(const Args& a, LAS unsigned char* lds, int layer, int G) {
    int tid_ = threadIdx.x; asm volatile("" : "+v"(tid_));
    const int tid = tid_, lane = tid & 63, wave = __builtin_amdgcn_readfirstlane(tid >> 6);
    LAS unsigned* XS = (LAS unsigned*)(lds + 16384 + wave * (32 * XS_STRIDE * 4));
    const bf16* proj = (const bf16*)(WSPTR() + WS_PROJ);
    const f32x2* AB = (const f32x2*)(WSPTR() + WS_ABAR); f32x2* SE = (f32x2*)(WSPTR() + WS_SEGE);
    const int gw = blockIdx.x * NWAVES + wave, NGW = G * NWAVES;
    for (int wt = gw; wt < 4096; wt += NGW) {
        const int dir = wt & 1, seg = (wt >> 1) & 7, g = (wt >> 4) & 31, b = wt >> 9;
        const int cb = (layer * 2 + dir) * 32 + g;
        const f32x2 ab = AB[cb * 64 + lane];
        float sr = 0.f, si = 0.f;
        const bf16x8* BBp = (const bf16x8*)(WSPTR() + WS_BB) + (size_t)cb * 4 * 64;
        const int rowbase = b * SEQ + seg * 512;
        if (dir) ssm_pass<true, 0>(proj, rowbase, g, BBp, nullptr, ab[0], ab[1], sr, si, XS, lane, nullptr, nullptr, nullptr);
        else     ssm_pass<false, 0>(proj, rowbase, g, BBp, nullptr, ab[0], ab[1], sr, si, XS, lane, nullptr, nullptr, nullptr);
        SE[((size_t)((b * 32 + g) * 2 + dir) * 8 + seg) * 64 + lane] = (f32x2){sr, si};
    }
}
__device__ __forceinline__ void ssm_p3(const Args& a, LAS unsigned char* lds, int layer, int G) {
    int tid_ = threadIdx.x; asm volatile("" : "+v"(tid_));
    const int tid = tid_, lane = tid & 63, wave = __builtin_amdgcn_readfirstlane(tid >> 6);
    LAS unsigned* XS = (LAS unsigned*)(lds + 16384 + wave * (32 * XS_STRIDE * 4));
    const bf16* proj = (const bf16*)(WSPTR() + WS_PROJ); bf16* zbuf = (bf16*)(WSPTR() + WS_Z);
    const f32x2* AB = (const f32x2*)(WSPTR() + WS_ABAR); const f32x2* AP = (const f32x2*)(WSPTR() + WS_APOW); const f32x2* SE = (const f32x2*)(WSPTR() + WS_SEGE);
    const int gw = blockIdx.x * NWAVES + wave, NGW = G * NWAVES;
    (void)gw; (void)NGW;
    for (int wg = blockIdx.x; wg < 256; wg += G) {
        const int wt = wg * 8 + wave, g = (wg & 3) * 8 + wave, seg = (wg >> 2) & 7, b = wg >> 5;
        const int rowbase = b * SEQ + seg * 512;
        f32x4* ysc = (f32x4*)(WSPTR() + WS_YSCR) + (size_t)wt * (16 * 2 * 64);
        {
            const int cb = (layer * 2 + 1) * 32 + g;
            const f32x2 ab = AB[cb * 64 + lane], ap = AP[cb * 64 + lane];
            const f32x2* se = SE + ((size_t)((b * 32 + g) * 2 + 1) * 8) * 64 + lane;
            float sr = 0.f, si = 0.f;
            for (int k = 7; k > seg && !DIAG_NOCARRY; --k) { const f32x2 e = se[k * 64]; const float nr = ap[0] * sr - ap[1] * si + e[0], ni = ap[0] * si + ap[1] * sr + e[1]; sr = nr; si = ni; }
            ssm_pass<true, 1>(proj, rowbase, g, (const bf16x8*)(WSPTR() + WS_BB) + (size_t)cb * 256, (const bf16x8*)(WSPTR() + WS_CC) + (size_t)cb * 256, ab[0], ab[1], sr, si, XS, lane, ysc, nullptr, nullptr);
        }
        {
            const int cb = (layer * 2 + 0) * 32 + g;
            const f32x2 ab = AB[cb * 64 + lane], ap = AP[cb * 64 + lane];
            const f32x2* se = SE + ((size_t)((b * 32 + g) * 2 + 0) * 8) * 64 + lane;
            float sr = 0.f, si = 0.f;
            for (int k = 0; k < seg && !DIAG_NOCARRY; ++k) { const f32x2 e = se[k * 64]; const float nr = ap[0] * sr - ap[1] * si + e[0], ni = ap[0] * si + ap[1] * sr + e[1]; sr = nr; si = ni; }
            ssm_pass<false, 2>(proj, rowbase, g, (const bf16x8*)(WSPTR() + WS_BB) + (size_t)cb * 256, (const bf16x8*)(WSPTR() + WS_CC) + (size_t)cb * 256, ab[0], ab[1], sr, si, XS, lane, ysc, INP(16) + layer * 512, zbuf);
        }
    }
}

__device__ __forceinline__ void final_norm(const Args& a, int G) {
    int tid_ = threadIdx.x; asm volatile("" : "+v"(tid_));
    const int tid = tid_, lane = tid & 63, wave = __builtin_amdgcn_readfirstlane(tid >> 6);
    const int gw = blockIdx.x * NWAVES + wave, NGW = G * NWAVES;
    const float* ssq = (const float*)(WSPTR() + WS_SSQ); const bf16* xb = (const bf16*)(WSPTR() + WS_XB); float* out = OUTPTR();
    const f32x4* gn = (const f32x4*)INP(26) + 2 * lane;
    f32x4 gv[2][2];
#pragma unroll
    for (int j = 0; j < 2; ++j) { gv[j][0] = gn[128 * j]; gv[j][1] = gn[128 * j + 1]; }
    for (int m = gw; m < NT; m += NGW) {
        float s = (lane < 16) ? ssq[((size_t)(lane >> 2) * NT + m) * 4 + (lane & 3)] : 0.f; s = wave_sum(s);
        const float rs = __builtin_amdgcn_rsqf(s * (1.0f / 1024.0f) + 1e-6f);
        const u32x4* xr = (const u32x4*)(xb + (size_t)m * DM) + lane; f32x4* orow = (f32x4*)(out + (size_t)m * DM) + 2 * lane;
#pragma unroll
        for (int j = 0; j < 2; ++j) { const u32x4 w = xr[64 * j];
            orow[128 * j] = (f32x4){bflo(w.x), bfhi(w.x), bflo(w.y), bfhi(w.y)} * rs * gv[j][0];
            orow[128 * j + 1] = (f32x4){bflo(w.z), bfhi(w.z), bflo(w.w), bfhi(w.w)} * rs * gv[j][1]; }
    }
}

#define XB_TMO      128
#define XB_XCNT(j)  (256  + 64 * (j))
#define XB_XSUB(j)  (1280 + 64 * (j))
#define XB_XGEN(j)  (2304 + 64 * (j))
#define XB_TOP      3328
#define XB_TOPGEN   3392
#define XCD_BAR_WORDS 3456
#define XB_SPIN_CAP (1u << 18)

__device__ __forceinline__ unsigned xb_ld(unsigned* p)              { return __hip_atomic_load(p, __ATOMIC_RELAXED, __HIP_MEMORY_SCOPE_AGENT); }
__device__ __forceinline__ unsigned xb_add(unsigned* p, unsigned v) { return __hip_atomic_fetch_add(p, v, __ATOMIC_RELAXED, __HIP_MEMORY_SCOPE_AGENT); }
__device__ __forceinline__ unsigned xb_xcc_id() { return (unsigned)__builtin_amdgcn_s_getreg((3 << 11) | 20) & 0xFu; }
#define XB_SPIN(cond, bar) do { unsigned _sp = 0; while (cond) { __builtin_amdgcn_s_sleep(1); \
    if ((++_sp & 255u) == 0u) { if (xb_ld(&(bar)[XB_TMO])) break; if (_sp > XB_SPIN_CAP) { atomicAdd(&(bar)[XB_TMO], 1u); break; } } } } while (0)

struct XcdBarrier {
    unsigned* bar; unsigned x;
    volatile LAS unsigned* st;
};

__device__ __forceinline__ XcdBarrier xcd_barrier_post(unsigned* bar, volatile LAS unsigned* st) {
    XcdBarrier b; b.bar = bar; b.x = xb_xcc_id(); b.st = st;
    if (threadIdx.x == 0) (void)xb_add(&bar[XB_XCNT(b.x)], 1u);
    return b;
}
__device__ __forceinline__ void xcd_barrier_complete(unsigned* bar, unsigned x, unsigned& nloc, unsigned& nx) {
    const unsigned G = gridDim.x * gridDim.y * gridDim.z;
    unsigned sum, cnt, mine, sp = 0u;
    for (;;) {
        sum = 0u; cnt = 0u; mine = 0u;
#pragma unroll
        for (unsigned j = 0; j < 16; ++j) { const unsigned c = xb_ld(&bar[XB_XCNT(j)]); sum += c; cnt += (c > 0u) ? 1u : 0u; mine = (j == x) ? c : mine; }
        if (sum == G) break;
        __builtin_amdgcn_s_sleep(1);
        if ((++sp & 255u) == 0u) { if (xb_ld(&bar[XB_TMO])) break; if (sp > XB_SPIN_CAP) { atomicAdd(&bar[XB_TMO], 1u); break; } }
    }
    nloc = mine > 0u ? mine : 1u; nx = cnt > 0u ? cnt : 1u;
}

__device__ __forceinline__ void xcd_barrier(const XcdBarrier& b) {
    asm volatile("s_waitcnt vmcnt(0)" ::: "memory");
    __syncthreads();
    if (threadIdx.x == 0) {
        unsigned* bar = b.bar;
        __builtin_amdgcn_s_waitcnt(0);
        unsigned nloc = b.st[0], nx = b.st[1];
        if (nloc == 0u) { xcd_barrier_complete(bar, b.x, nloc, nx); b.st[0] = nloc; b.st[1] = nx; }
        const unsigned old = xb_add(&bar[XB_XSUB(b.x)], 1u);
        const unsigned gen = old / nloc;
        if (old + 1u == (gen + 1u) * nloc) {
            __builtin_amdgcn_fence(__ATOMIC_RELEASE, "agent");
            asm volatile("s_waitcnt vmcnt(0)" ::: "memory");
            const unsigned og = xb_add(&bar[XB_TOP], 1u);
            const unsigned tg = og / nx;
            if (og + 1u == (tg + 1u) * nx) xb_add(&bar[XB_TOPGEN], 1u);
            else XB_SPIN(xb_ld(&bar[XB_TOPGEN]) == tg, bar);
            __builtin_amdgcn_fence(__ATOMIC_ACQUIRE, "agent");
            xb_add(&bar[XB_XGEN(b.x)], 1u);
            asm volatile("s_waitcnt vmcnt(0)" ::: "memory");
        } else {
            XB_SPIN(xb_ld(&bar[XB_XGEN(b.x)]) == gen, bar);
            __builtin_amdgcn_fence(__ATOMIC_ACQUIRE, "agent");
            asm volatile("s_waitcnt vmcnt(0)" ::: "memory");
        }
    }
    __syncthreads();
}

#define GRID_SYNC() do { XcdBarrier xb_; xb_.bar = (unsigned*)(WSPTR() + WS_CTL); xb_.x = xb_xcc_id(); xb_.st = (volatile LAS unsigned*)((LAS unsigned char*)lds_raw + (LDS_BYTES - 64)); xcd_barrier(xb_); } while (0)
__global__ void __launch_bounds__(NTHREADS, 2) hymba_fwd(Args a) {
    extern __shared__ __attribute__((aligned(16))) unsigned char lds_raw[];
    LAS unsigned char* lds = (LAS unsigned char*)lds_raw;
    cg::grid_group grid = cg::this_grid();
    const int G = gridDim.x, bid = blockIdx.x;
    volatile LAS unsigned* misc = (volatile LAS unsigned*)(lds + LDS_BYTES - 64);
    if (threadIdx.x < 16) misc[threadIdx.x] = 0u;
    __syncthreads();
    (void)xcd_barrier_post((unsigned*)(WSPTR() + WS_CTL), misc);
    grid.sync();
#define ws WSPTR()
#define xf OUTPTR()
#define xb ((pg8::bf16_t*)(WSPTR() + WS_XB))
#define ssq ((float*)(WSPTR() + WS_SSQ))
#define ssq2 ((float*)(WSPTR() + WS_SSQ2))
#define Hb ((pg8::bf16_t*)(WSPTR() + WS_H))
#define projb ((pg8::bf16_t*)(WSPTR() + WS_PROJ))
#define vTb ((pg8::bf16_t*)(WSPTR() + WS_VT))
#define mixb ((pg8::bf16_t*)(WSPTR() + WS_MIX))
#define zb ((pg8::bf16_t*)(WSPTR() + WS_Z))

    prologue(a, lds, G);
    GRID_SYNC();
    for (int st = 0; st < 2 * NLAYER; ++st) {
        const int layer = st >> 1, second = st & 1;
        const unsigned char* wl = ws + WS_W + (size_t)layer * W_LAYER;
        {
            pg8::Gemm g{xb, (const pg8::bf16_t*)(wl + (second ? W_GU2 : W_GU1)), NT, 2 * DFF, DM}; pg8::StaticOrder S; S.init(NT, 2 * DFF, G, bid);
            const pg8::RowStatTab RT = pg8::rowstat_build(lds + pg8::STAGE_BYTES, S, ssq);
            pg8::EpiSwiGLU E{Hb, ssq, RT};
            for (int rep = 0; rep < 1 + DUP_G1; ++rep) {
            pg8::gemm_phase<pg8::EpiSwiGLU, pg8::StaticOrder, true, true>(lds, g, S, E);
            GRID_SYNC(); }
            pg8::Gemm g2{Hb, (const pg8::bf16_t*)(wl + (second ? W_D2 : W_D1)), NT, DM, DFF}; pg8::StaticOrder S2; S2.init(NT, DM, G, bid);
            pg8::EpiResid<false> E2{xb, ssq, nullptr, 0.5f};
            pg8::gemm_phase<pg8::EpiResid<false>, pg8::StaticOrder, true, true>(lds, g2, S2, E2);
            GRID_SYNC();
        }
        if (!second && DIAG_MIXER) {
            {
                pg8::Gemm g{xb, (const pg8::bf16_t*)(wl + W_IN), NT, DIN, DM}; pg8::StaticOrder S; S.init(NT, DIN, G, bid);
                const pg8::RowStatTab RT = pg8::rowstat_build(lds + pg8::STAGE_BYTES, S, ssq);
                pg8::EpiProj E{projb, vTb, ssq, RT};
                pg8::gemm_phase<pg8::EpiProj, pg8::StaticOrder, true, true>(lds, g, S, E);
                GRID_SYNC();
            }
            for (int rep = 0; rep < N_P1; ++rep) ssm_p1(a, lds, layer, G);
            GRID_SYNC();
            for (int rep = 0; rep < N_P3; ++rep) ssm_p3(a, lds, layer, G);
            GRID_SYNC();
            {
                pg8::Gemm g{zb, (const pg8::bf16_t*)(wl + W_GLU), NT, 512, 512}; pg8::StaticOrder S; S.init(NT, 512, G, bid);
                pg8::EpiGlu E{zb, mixb, INP(18) + layer * 512, ssq2};
                pg8::gemm_phase<pg8::EpiGlu, pg8::StaticOrder, true, true>(lds, g, S, E);
                GRID_SYNC();
            }
            for (int rep = 0; rep < N_ATT; ++rep) attn_phase(a, lds, layer, G);
            GRID_SYNC();
            {
                pg8::Gemm g{mixb, (const pg8::bf16_t*)(wl + W_OA), NT, DM, 1024}; pg8::StaticOrder S; S.init(NT, DM, G, bid);
                pg8::EpiResid<true> E{xb, ssq, ssq2, 1.0f};
                pg8::gemm_phase<pg8::EpiResid<true>, pg8::StaticOrder, true, true>(lds, g, S, E);
                GRID_SYNC();
            }
        }
    }
    final_norm(a, G);
    GRID_SYNC();
}

#undef ws
#undef xf
#undef xb
#undef ssq
#undef ssq2
#undef Hb
#undef projb
#undef vTb
#undef mixb
#undef zb
extern "C" void kernel_launch(void* const* d_in, const int* in_sizes, int n_in, void* d_out, int out_size, void* d_ws, size_t ws_size, hipStream_t stream) {
    static int grid = 0;
    if (grid == 0) {
        if (n_in != 27 || out_size != NT * DM || ws_size < WS_END) { fprintf(stderr, "kernel_launch: unexpected shapes: n_in %d out %d ws %zu (need %zu)\n", n_in, out_size, ws_size, (size_t)WS_END); grid = -1; return; }
        int dev = 0, cus = 0, per_cu = 0;
        hipGetDevice(&dev); hipDeviceGetAttribute(&cus, hipDeviceAttributeMultiprocessorCount, dev);
        hipFuncSetAttribute((const void*)hymba_fwd, hipFuncAttributeMaxDynamicSharedMemorySize, LDS_BYTES);
        hipOccupancyMaxActiveBlocksPerMultiprocessor(&per_cu, (const void*)hymba_fwd, NTHREADS, LDS_BYTES);
        if (per_cu < 1) { fprintf(stderr, "kernel_launch: occupancy query says %d blocks per CU\n", per_cu); per_cu = 1; }
        (void)hipGetLastError();
        grid = cus * per_cu;
        fprintf(stderr, "kernel_launch: grid %d (%d CUs x %d)\n", grid, cus, per_cu);
    }
    if (grid < 0) return;
    if (hipMemsetAsync((char*)d_ws + WS_CTL, 0, CTL_BYTES, stream) != hipSuccess) { fprintf(stderr, "kernel_launch: memset of the barrier words failed\n"); return; }
    Args a{};
    for (int i = 0; i < 27; ++i) a.in[i] = (const float*)d_in[i];
    a.out = (float*)d_out; a.ws = (unsigned char*)d_ws;
    void* args[] = {&a};
    hipError_t e = hipLaunchCooperativeKernel((const void*)hymba_fwd, dim3(grid), dim3(NTHREADS), args, LDS_BYTES, stream);
    if (e != hipSuccess) fprintf(stderr, "cooperative launch failed: %s (grid %d)\n", hipGetErrorString(e), grid);
}
```
